# Optimizing an MI355X kernel written in HIP

```python
import jax
import jax.numpy as jnp
from jax import lax
import numpy as np


D_MODEL = 2048
BATCH = 1
SEQ = 16384
DEPTH = 1

HEAD_DIM = 128
ATTN_WIDTH = 3 * D_MODEL // 4
N_ATTN_HEADS = ATTN_WIDTH // HEAD_DIM
ATTN_GROUPS = ((128, 1), (512, 4), (2048, 16))
N_GROUPS = len(ATTN_GROUPS)
HEADS_PER_GROUP = N_ATTN_HEADS // N_GROUPS
ATTN_OUT_WIDTH = HEADS_PER_GROUP * HEAD_DIM
BAND = 128
ROPE_THETA = 10000.0
POOL_WIDTH = D_MODEL // 4
POOL_WINDOWS = (2, 4, 8, 16)
POOL_GROUP = POOL_WIDTH // len(POOL_WINDOWS)
IN_WIDTH = 3 * ATTN_WIDTH + POOL_WIDTH + 2 * D_MODEL
PEER_HEADS = 8
PEER_QUERY_DIM = 256
PEER_HALF = PEER_QUERY_DIM // 2
PEER_N_KEYS = 128
PEER_N_EXPERTS = PEER_N_KEYS * PEER_N_KEYS
PEER_TOPK = 16
PEER_CHUNK = 128
EPS = 1e-6

kernel_name = 'hybrid_dilated_pool_peer_block'


def rms_norm(x, g):
    x32 = x.astype(jnp.float32)
    y = x32 * lax.rsqrt(jnp.mean(x32 * x32, axis=-1, keepdims=True) + EPS)
    return y.astype(x.dtype) * g


def apply_rope(t, pos):
    half = t.shape[-1] // 2
    inv = jnp.power(jnp.float32(ROPE_THETA), -jnp.arange(half, dtype=jnp.float32) / half)
    ang = pos[:, None] * inv[None, :]
    cos = jnp.cos(ang)[None, :, None, :]
    sin = jnp.sin(ang)[None, :, None, :]
    t32 = t.astype(jnp.float32)
    t1, t2 = t32[..., :half], t32[..., half:]
    return jnp.concatenate([t1 * cos - t2 * sin, t2 * cos + t1 * sin], axis=-1).astype(t.dtype)


def dilated_window_attention(q, k, v, dil, steps):
    B, S, H, Dh = q.shape
    L = S // dil
    nb = -(-L // BAND)
    Lp = nb * BAND

    def to_sub(t):
        t = t.reshape(B, L, dil, H, Dh).transpose(0, 2, 1, 3, 4)
        return jnp.pad(t, ((0, 0), (0, 0), (0, Lp - L), (0, 0), (0, 0)))

    def band(t):
        t = jnp.pad(t, ((0, 0), (0, 0), (BAND, 0), (0, 0), (0, 0))).reshape(B, dil, nb + 1, BAND, H, Dh)
        return jnp.concatenate([t[:, :, :-1], t[:, :, 1:]], axis=3)

    qb = to_sub(q).reshape(B, dil, nb, BAND, H, Dh)
    kb = band(to_sub(k))
    vb = band(to_sub(v))
    s = jnp.einsum('brnqhd,brnkhd->brnhqk', qb, kb).astype(jnp.float32) * (Dh ** -0.5)
    qi = jnp.arange(BAND)[:, None]
    kj = jnp.arange(2 * BAND)[None, :]
    dist = qi + BAND - kj
    key_idx = jnp.arange(nb)[:, None, None] * BAND + kj[None] - BAND
    valid = (dist[None] >= 0) & (dist[None] <= steps) & (key_idx >= 0)
    s = jnp.where(valid[None, None, :, None], s, -jnp.inf)
    m = jnp.max(s, axis=-1, keepdims=True)
    p = jnp.exp(s - m)
    denom = jnp.sum(p, axis=-1, keepdims=True)
    o = jnp.einsum('brnhqk,brnkhd->brnqhd', (p / denom).astype(v.dtype), vb)
    lse = (m + jnp.log(denom))[..., 0]
    o = o.reshape(B, dil, Lp, H, Dh)[:, :, :L].transpose(0, 2, 1, 3, 4).reshape(B, S, H, Dh)
    lse = lse.transpose(0, 1, 2, 4, 3).reshape(B, dil, Lp, H)[:, :, :L]
    lse = lse.transpose(0, 2, 1, 3).reshape(B, S, H)
    return o, lse


def dilated_mixture_attention(q, k, v):
    B, S, _, Dh = q.shape
    outs, lses = [], []
    for gi, (window, dil) in enumerate(ATTN_GROUPS):
        hs = slice(gi * HEADS_PER_GROUP, (gi + 1) * HEADS_PER_GROUP)
        o, l = dilated_window_attention(q[:, :, hs], k[:, :, hs], v[:, :, hs], dil, window // dil)
        outs.append(o)
        lses.append(l)
    o = jnp.stack(outs, axis=0).astype(jnp.float32)
    w = jax.nn.softmax(jnp.stack(lses, axis=0), axis=0)[..., None]
    y = jnp.sum(w * o, axis=0).astype(q.dtype)
    return y.reshape(B, S, ATTN_OUT_WIDTH)


def multiscale_pool(p, mix, scale):
    B, S, C = p.shape
    p32 = p.astype(jnp.float32)
    cs = jnp.concatenate([jnp.zeros((B, 1, C), jnp.float32), lax.cumsum(p32, axis=1)], axis=1)
    t = jnp.arange(S)
    outs = []
    for g, w in enumerate(POOL_WINDOWS):
        sl = slice(g * POOL_GROUP, (g + 1) * POOL_GROUP)
        c_g = cs[..., sl]
        lo = jnp.concatenate([jnp.zeros((B, w - 1, POOL_GROUP), jnp.float32), c_g[:, :S - w + 1]], axis=1)
        mean = (c_g[:, 1:] - lo) / jnp.minimum(t + 1, w).astype(jnp.float32)[None, :, None]
        outs.append(mean - p32[..., sl])
    d = jnp.stack(outs, axis=2).astype(p.dtype)
    y = jnp.einsum('bsgc,gcd->bsgd', d, mix).reshape(B, S, C)
    return y * scale


def peer_ffn(xn, w_query, sub_keys, w_down, w_up):
    B, S, D = xn.shape
    q = jnp.einsum('bsd,de->bse', xn, w_query).reshape(B, S, PEER_HEADS, 2, PEER_HALF)
    s = jnp.einsum('bshpd,hpnd->bshpn', q, sub_keys).astype(jnp.float32)
    top_s, top_i = lax.top_k(s, PEER_TOPK)
    cand = top_s[..., 0, :, None] + top_s[..., 1, None, :]
    cand_s, cand_i = lax.top_k(cand.reshape(B, S, PEER_HEADS, PEER_TOPK * PEER_TOPK), PEER_TOPK)
    i1 = jnp.take_along_axis(top_i[..., 0, :], cand_i // PEER_TOPK, axis=-1)
    i2 = jnp.take_along_axis(top_i[..., 1, :], cand_i % PEER_TOPK, axis=-1)
    expert = i1 * PEER_N_KEYS + i2
    gates = jax.nn.softmax(cand_s, axis=-1).astype(xn.dtype)
    n_chunk = (B * S) // PEER_CHUNK
    xs = xn.reshape(n_chunk, PEER_CHUNK, D)
    ids = expert.reshape(n_chunk, PEER_CHUNK, PEER_HEADS * PEER_TOPK)
    gs = gates.reshape(n_chunk, PEER_CHUNK, PEER_HEADS * PEER_TOPK)

    def one_block(args):
        xc, ic, gc = args
        u = jnp.take(w_down, ic, axis=0)
        a = jax.nn.gelu(jnp.einsum('cd,ced->ce', xc, u), approximate=False) * gc
        vv = jnp.take(w_up, ic, axis=0)
        return jnp.einsum('ce,ced->cd', a, vv)

    out = lax.map(one_block, (xs, ids, gs))
    return out.reshape(B, S, D)


def setup_inputs(seed: int = 0) -> dict:
    key = jax.random.key(seed)
    ks = jax.random.split(key, 17)
    f32 = jnp.float32

    def nrm(k, shape, scale):
        return jax.random.normal(k, shape, f32) * scale

    n_pool = len(POOL_WINDOWS)
    return {
        'x': nrm(ks[0], (BATCH, SEQ, D_MODEL), 1.0),
        'c': nrm(ks[1], (BATCH, D_MODEL), 1.0),
        'ada_w': nrm(ks[2], (DEPTH, D_MODEL, 6 * D_MODEL), 0.5 * D_MODEL ** -0.5),
        'ada_b': nrm(ks[3], (DEPTH, 6 * D_MODEL), 0.02),
        'norm1_g': 1.0 + nrm(ks[4], (DEPTH, D_MODEL), 0.02),
        'w_in': nrm(ks[5], (DEPTH, D_MODEL, IN_WIDTH), D_MODEL ** -0.5),
        'pool_mix': nrm(ks[6], (DEPTH, n_pool, POOL_GROUP, POOL_GROUP), POOL_GROUP ** -0.5),
        'pool_scale': 1.0 + nrm(ks[7], (DEPTH, POOL_WIDTH), 0.1),
        'w_attn_branch': nrm(ks[8], (DEPTH, ATTN_OUT_WIDTH, D_MODEL), ATTN_OUT_WIDTH ** -0.5),
        'w_pool_branch': nrm(ks[9], (DEPTH, POOL_WIDTH, D_MODEL), POOL_WIDTH ** -0.5),
        'w_out': nrm(ks[10], (DEPTH, D_MODEL, D_MODEL), D_MODEL ** -0.5),
        'norm2_g': 1.0 + nrm(ks[11], (DEPTH, D_MODEL), 0.02),
        'peer_wq': nrm(ks[12], (DEPTH, D_MODEL, PEER_HEADS * PEER_QUERY_DIM), D_MODEL ** -0.5),
        'peer_keys': nrm(ks[13], (DEPTH, PEER_HEADS, 2, PEER_N_KEYS, PEER_HALF), PEER_HALF ** -0.5),
        'peer_down': nrm(ks[14], (DEPTH, PEER_N_EXPERTS, D_MODEL), D_MODEL ** -0.5),
        'peer_up': nrm(ks[15], (DEPTH, PEER_N_EXPERTS, D_MODEL), PEER_HEADS ** -0.5),
        'final_g': 1.0 + nrm(ks[16], (D_MODEL,), 0.02),
    }


def reference(x, c, ada_w, ada_b, norm1_g, w_in, pool_mix, pool_scale, w_attn_branch, w_pool_branch, w_out, norm2_g, peer_wq, peer_keys, peer_down, peer_up, final_g):
    B, S, D = x.shape
    pos = jnp.arange(S, dtype=jnp.float32)
    h = x
    for layer in range(DEPTH):
        mod = jax.nn.silu(c) @ ada_w[layer] + ada_b[layer]
        shift1, scale1, gate1, shift2, scale2, gate2 = jnp.split(mod[:, None, :], 6, axis=-1)

        xn = rms_norm(h, norm1_g[layer]) * (1.0 + scale1) + shift1
        proj = xn @ w_in[layer]
        q = proj[..., :ATTN_WIDTH].reshape(B, S, N_ATTN_HEADS, HEAD_DIM)
        k = proj[..., ATTN_WIDTH:2 * ATTN_WIDTH].reshape(B, S, N_ATTN_HEADS, HEAD_DIM)
        v = proj[..., 2 * ATTN_WIDTH:3 * ATTN_WIDTH].reshape(B, S, N_ATTN_HEADS, HEAD_DIM)
        off = 3 * ATTN_WIDTH
        p_in = proj[..., off:off + POOL_WIDTH]
        gate_a = jax.nn.sigmoid(proj[..., off + POOL_WIDTH:off + POOL_WIDTH + D])
        gate_b = jax.nn.sigmoid(proj[..., off + POOL_WIDTH + D:])
        q = apply_rope(q, pos)
        k = apply_rope(k, pos)
        attn = dilated_mixture_attention(q, k, v)
        pool = multiscale_pool(p_in, pool_mix[layer], pool_scale[layer])
        merged = gate_a * (attn @ w_attn_branch[layer]) + gate_b * (pool @ w_pool_branch[layer])
        h = h + gate1 * (merged @ w_out[layer])

        xn2 = rms_norm(h, norm2_g[layer]) * (1.0 + scale2) + shift2
        h = h + gate2 * peer_ffn(xn2, peer_wq[layer], peer_keys[layer], peer_down[layer], peer_up[layer])
    return rms_norm(h, final_g)
```

```cpp
#include <hip/hip_runtime.h>
#include <cstdio>
#include <cstdint>
#include <cmath>

constexpr int S = 16384, D = 2048;
constexpr int AW = 1536, NH = 12, HD = 128, AOW = 512, PW = 512, INW = 9216;
constexpr int PH = 8, PK = 16, NKEY = 128, NEXP = 16384;
constexpr float EPS = 1e-6f;

typedef float f32x4 __attribute__((ext_vector_type(4)));

__device__ __forceinline__ float wave_sum(float v) {
#pragma unroll
    for (int o = 1; o < 64; o <<= 1) v += __shfl_xor(v, o);
    return v;
}
__device__ __forceinline__ float wave_max(float v) {
#pragma unroll
    for (int o = 1; o < 64; o <<= 1) v = fmaxf(v, __shfl_xor(v, o));
    return v;
}

__global__ void __launch_bounds__(256) k_mod(const float* c, const float* W, const float* b, float* mod) {
    const int j = blockIdx.x * 256 + threadIdx.x;
    float acc = 0.f;
    for (int i = 0; i < D; ++i) { const float ci = c[i]; const float s = ci / (1.f + expf(-ci)); acc += s * W[(size_t)i * (6 * D) + j]; }
    mod[j] = acc + b[j];
}

__global__ void __launch_bounds__(256) k_rmsmod(const float* x, const float* g, const float* scale, const float* shift, float* out) {
    const int row = blockIdx.x * 4 + (threadIdx.x >> 6), lane = threadIdx.x & 63;
    const f32x4* xr = (const f32x4*)(x + (size_t)row * D) + lane;
    f32x4 v[8]; float s = 0.f;
#pragma unroll
    for (int j = 0; j < 8; ++j) { v[j] = xr[64 * j]; s += v[j].x * v[j].x + v[j].y * v[j].y + v[j].z * v[j].z + v[j].w * v[j].w; }
    const float r = 1.0f / sqrtf(wave_sum(s) * (1.f / D) + EPS);
    f32x4* o = (f32x4*)(out + (size_t)row * D) + lane;
#pragma unroll
    for (int j = 0; j < 8; ++j) {
        const int c0 = 4 * lane + 256 * j;
        const f32x4 gg = *(const f32x4*)(g + c0), sc = *(const f32x4*)(scale + c0), sh = *(const f32x4*)(shift + c0);
        f32x4 y; y.x = v[j].x * r * gg.x * (1.f + sc.x) + sh.x; y.y = v[j].y * r * gg.y * (1.f + sc.y) + sh.y;
        y.z = v[j].z * r * gg.z * (1.f + sc.z) + sh.z; y.w = v[j].w * r * gg.w * (1.f + sc.w) + sh.w;
        o[64 * j] = y;
    }
}

template <class Epi>
__global__ void __launch_bounds__(256) k_sgemm(const float* __restrict__ A, int lda, const float* __restrict__ B, int ldb, int K, Epi epi) {
    __shared__ float As[16][132];
    __shared__ float Bs[16][132];
    const int tid = threadIdx.x, tx = tid & 15, ty = tid >> 4;
    const int row0 = blockIdx.y * 128, col0 = blockIdx.x * 128;
    float acc[8][8];
#pragma unroll
    for (int i = 0; i < 8; ++i)
#pragma unroll
        for (int j = 0; j < 8; ++j) acc[i][j] = 0.f;
    for (int k0 = 0; k0 < K; k0 += 16) {
#pragma unroll
        for (int i = 0; i < 2; ++i) {
            const int r = (tid >> 2) + 64 * i, kc = (tid & 3) * 4;
            const f32x4 a = *(const f32x4*)(A + (size_t)(row0 + r) * lda + k0 + kc);
            As[kc + 0][r] = a.x; As[kc + 1][r] = a.y; As[kc + 2][r] = a.z; As[kc + 3][r] = a.w;
            const int kr = (tid >> 5) + 8 * i, cc = (tid & 31) * 4;
            *(f32x4*)&Bs[kr][cc] = *(const f32x4*)(B + (size_t)(k0 + kr) * ldb + col0 + cc);
        }
        __syncthreads();
#pragma unroll
        for (int k = 0; k < 16; ++k) {
            const f32x4 a0 = *(const f32x4*)&As[k][ty * 4], a1 = *(const f32x4*)&As[k][64 + ty * 4];
            const f32x4 b0 = *(const f32x4*)&Bs[k][tx * 4], b1 = *(const f32x4*)&Bs[k][64 + tx * 4];
            const float a[8] = {a0.x, a0.y, a0.z, a0.w, a1.x, a1.y, a1.z, a1.w};
            const float b[8] = {b0.x, b0.y, b0.z, b0.w, b1.x, b1.y, b1.z, b1.w};
#pragma unroll
            for (int i = 0; i < 8; ++i)
#pragma unroll
                for (int j = 0; j < 8; ++j) acc[i][j] += a[i] * b[j];
        }
        __syncthreads();
    }
#pragma unroll
    for (int i = 0; i < 8; ++i) {
        const int r = row0 + (i < 4 ? ty * 4 + i : 64 + ty * 4 + (i - 4));
        epi(r, col0 + tx * 4, (f32x4){acc[i][0], acc[i][1], acc[i][2], acc[i][3]});
        epi(r, col0 + 64 + tx * 4, (f32x4){acc[i][4], acc[i][5], acc[i][6], acc[i][7]});
    }
}

struct EpiQKVP {
    float *q, *k, *v, *p;
    __device__ void operator()(int r, int c, f32x4 val) const {
        float* dst; int ld, cc;
        if (c < AW) { dst = q; ld = AW; cc = c; } else if (c < 2 * AW) { dst = k; ld = AW; cc = c - AW; }
        else if (c < 3 * AW) { dst = v; ld = AW; cc = c - 2 * AW; } else { dst = p; ld = PW; cc = c - 3 * AW; }
        *(f32x4*)(dst + (size_t)r * ld + cc) = val;
    }
};
struct EpiSigmoid { float* o; int ld;
    __device__ void operator()(int r, int c, f32x4 v) const {
        f32x4 y; y.x = 1.f / (1.f + expf(-v.x)); y.y = 1.f / (1.f + expf(-v.y)); y.z = 1.f / (1.f + expf(-v.z)); y.w = 1.f / (1.f + expf(-v.w));
        *(f32x4*)(o + (size_t)r * ld + c) = y; } };
struct EpiStore { float* o; int ld;
    __device__ void operator()(int r, int c, f32x4 v) const { *(f32x4*)(o + (size_t)r * ld + c) = v; } };
struct EpiScaleCols { float* o; int ld; const float* sc;
    __device__ void operator()(int r, int c, f32x4 v) const { const f32x4 s = *(const f32x4*)(sc + c); *(f32x4*)(o + (size_t)r * ld + c) = v * s; } };
struct EpiGateMul { float* o; const float* gate; int ldg; int accum;
    __device__ void operator()(int r, int c, f32x4 v) const {
        const f32x4 g = *(const f32x4*)(gate + (size_t)r * ldg + c); f32x4* p = (f32x4*)(o + (size_t)r * D + c);
        f32x4 y = g * v; if (accum) y = y + *p; *p = y; } };
struct EpiResid { float* o; const float* x; const float* gate;
    __device__ void operator()(int r, int c, f32x4 v) const {
        const f32x4 g = *(const f32x4*)(gate + c), xx = *(const f32x4*)(x + (size_t)r * D + c); *(f32x4*)(o + (size_t)r * D + c) = xx + g * v; } };

__global__ void __launch_bounds__(256) k_rope(float* buf) {
    const size_t idx = (size_t)blockIdx.x * 256 + threadIdx.x;
    const int dp = idx & 63; const int head = (idx >> 6) % NH; const int t = idx / (64 * NH);
    const float inv = (float)pow(10000.0, -(double)dp / 64.0);
    const float ang = (float)t * inv;
    double rev = (double)ang * 0.15915494309189533577; rev -= rint(rev);
    const float sn = __builtin_amdgcn_sinf((float)rev), cs = __builtin_amdgcn_cosf((float)rev);
    float* p = buf + (size_t)t * AW + head * HD + dp;
    const float t1 = p[0], t2 = p[64];
    p[0] = t1 * cs - t2 * sn; p[64] = t2 * cs + t1 * sn;
}

__global__ void __launch_bounds__(256) k_attn(const float* Q, const float* Kb, const float* V, float* Og, float* Lg) {
    __shared__ float qs[4][128];
    __shared__ float sc[4][192];
    const int w = threadIdx.x >> 6, lane = threadIdx.x & 63;
    const int idx = blockIdx.x * 4 + w; const int head = idx % NH, pos = idx / NH;
    const int g = head >> 2; const int dil = (g == 0) ? 1 : (g == 1 ? 4 : 16);
    const float* qrow = Q + (size_t)pos * AW + head * HD;
    qs[w][lane] = qrow[lane]; qs[w][lane + 64] = qrow[lane + 64];
    __syncthreads();
    float mx = -INFINITY;
    for (int jj = lane; jj < 129; jj += 64) {
        const int kp = pos - jj * dil; float s = -INFINITY;
        if (kp >= 0) {
            const f32x4* kr = (const f32x4*)(Kb + (size_t)kp * AW + head * HD); float d = 0.f;
#pragma unroll 8
            for (int i = 0; i < 32; ++i) { const f32x4 kk = kr[i]; const f32x4 qq = *(const f32x4*)&qs[w][4 * i]; d += kk.x * qq.x + kk.y * qq.y + kk.z * qq.z + kk.w * qq.w; }
            s = d * 0.08838834764831845f;
        }
        sc[w][jj] = s; mx = fmaxf(mx, s);
    }
    mx = wave_max(mx);
    float sm = 0.f;
    for (int jj = lane; jj < 129; jj += 64) { const float s = sc[w][jj]; const float p = (s == -INFINITY) ? 0.f : expf(s - mx); sc[w][jj] = p; sm += p; }
    sm = wave_sum(sm);
    __syncthreads();
    const float invd = 1.f / sm;
    float o0 = 0.f, o1 = 0.f;
    for (int jj = 0; jj < 129; ++jj) {
        const int kp = pos - jj * dil; if (kp < 0) break;
        const float p = sc[w][jj] * invd; const float* vr = V + (size_t)kp * AW + head * HD;
        o0 += p * vr[lane]; o1 += p * vr[lane + 64];
    }
    float* orow = Og + ((size_t)g * S + pos) * AOW + (head & 3) * HD;
    orow[lane] = o0; orow[lane + 64] = o1;
    if (lane == 0) Lg[((size_t)g * S + pos) * 4 + (head & 3)] = mx + logf(sm);
}
__global__ void __launch_bounds__(256) k_merge(const float* Og, const float* Lg, float* attn) {
    const size_t idx = (size_t)blockIdx.x * 256 + threadIdx.x; const int ch = idx & 511; const int pos = idx >> 9; const int j = ch >> 7;
    const float l0 = Lg[((size_t)0 * S + pos) * 4 + j], l1 = Lg[((size_t)1 * S + pos) * 4 + j], l2 = Lg[((size_t)2 * S + pos) * 4 + j];
    const float m = fmaxf(l0, fmaxf(l1, l2)); const float e0 = expf(l0 - m), e1 = expf(l1 - m), e2 = expf(l2 - m); const float inv = 1.f / (e0 + e1 + e2);
    attn[idx] = (e0 * Og[((size_t)0 * S + pos) * AOW + ch] + e1 * Og[((size_t)1 * S + pos) * AOW + ch] + e2 * Og[((size_t)2 * S + pos) * AOW + ch]) * inv;
}
__global__ void __launch_bounds__(256) k_poold(const float* pin, float* dd) {
    const size_t idx = (size_t)blockIdx.x * 256 + threadIdx.x; const int ch = idx & 511; const int pos = idx >> 9; const int g = ch >> 7;
    const int w = 2 << g; const int n = (pos + 1 < w) ? pos + 1 : w; float s = 0.f;
    for (int i = 0; i < n; ++i) s += pin[(size_t)(pos - i) * PW + ch];
    dd[idx] = s / (float)n - pin[idx];
}

__global__ void __launch_bounds__(256) k_scores(const float* pq, const float* keys, float* sc) {
    __shared__ float qs[128];
    const int t = blockIdx.x >> 4; const int hp = blockIdx.x & 15;
    const int n = threadIdx.x & 127; const int half = threadIdx.x >> 7;
    const int tt = t * 2 + half;
    __shared__ float qs2[2][128];
    qs2[half][n] = pq[(size_t)tt * D + hp * 128 + n];
    __syncthreads();
    const f32x4* kr = (const f32x4*)(keys + ((size_t)hp * NKEY + n) * 128); float d = 0.f;
#pragma unroll 8
    for (int i = 0; i < 32; ++i) { const f32x4 kk = kr[i]; const f32x4 qq = *(const f32x4*)&qs2[half][4 * i]; d += kk.x * qq.x + kk.y * qq.y + kk.z * qq.z + kk.w * qq.w; }
    sc[(size_t)tt * D + hp * 128 + n] = d;
    (void)qs;
}

__device__ __forceinline__ unsigned fkey(float f) { const unsigned u = __float_as_uint(f); return (u & 0x80000000u) ? ~u : (u | 0x80000000u); }
__device__ __forceinline__ unsigned long long wave_max_u64(unsigned long long k) {
#pragma unroll
    for (int o = 1; o < 64; o <<= 1) {
        const unsigned lo = __shfl_xor((unsigned)k, o), hi = __shfl_xor((unsigned)(k >> 32), o);
        const unsigned long long other = ((unsigned long long)hi << 32) | lo; k = other > k ? other : k;
    }
    return k;
}
__device__ __forceinline__ void cand_ij(int c, int& i, int& j) {
    const int pre[17] = {0, 16, 24, 29, 33, 36, 38, 40, 42, 43, 44, 45, 46, 47, 48, 49, 50};
    i = 0; j = 0;
#pragma unroll
    for (int r = 0; r < 16; ++r) if (c >= pre[r] && c < pre[r + 1]) { i = r; j = c - pre[r]; }
}
__global__ void __launch_bounds__(256) k_topk(const float* sc, int* tk_idx, float* tk_gate) {
    const int w = threadIdx.x >> 6, lane = threadIdx.x & 63;
    const int th = blockIdx.x * 4 + w; const int t = th >> 3, h = th & 7;
    float ts[2]; int ti[2];
#pragma unroll
    for (int p = 0; p < 2; ++p) {
        const float* row = sc + (size_t)t * D + h * 256 + p * 128;
        float v0 = row[lane], v1 = row[lane + 64];
        float mys = -INFINITY; int myi = 0;
        for (int k = 0; k < PK; ++k) {
            const bool first = v0 >= v1;
            const float bv = first ? v0 : v1; const int bi = first ? lane : lane + 64;
            const unsigned long long key = ((unsigned long long)fkey(bv) << 32) | (unsigned)(127 - bi);
            const unsigned long long best = wave_max_u64(key);
            const int widx = 127 - (int)(best & 0xffffffffu);
            const unsigned bk = (unsigned)(best >> 32); const unsigned bu = (bk & 0x80000000u) ? (bk & 0x7fffffffu) : ~bk;
            const float wv = __uint_as_float(bu);
            if (lane == k) { mys = wv; myi = widx; }
            if (widx == lane) v0 = -INFINITY; if (widx == lane + 64) v1 = -INFINITY;
        }
        ts[p] = mys; ti[p] = myi;
    }
    int ci, cj; cand_ij(lane < 50 ? lane : 0, ci, cj);
    const float a = __shfl(ts[0], ci), b = __shfl(ts[1], cj);
    const int ia = __shfl(ti[0], ci), ib = __shfl(ti[1], cj);
    float cv = (lane < 50) ? a + b : -INFINITY;
    const int flat = ci * 16 + cj;
    float gs = -INFINITY; int ge = 0;
    for (int k = 0; k < PK; ++k) {
        const unsigned long long key = ((unsigned long long)fkey(cv) << 32) | (unsigned)(255 - flat) | ((unsigned long long)0);
        const unsigned long long key2 = (key & 0xffffffff00000000ull) | ((unsigned long long)(255 - flat) << 8) | (unsigned)lane;
        const unsigned long long best = wave_max_u64(lane < 50 ? key2 : 0ull);
        const int wl = (int)(best & 0xffu);
        const float wv = __shfl(cv, wl); const int we = __shfl(ia * NKEY + ib, wl);
        if (lane == k) { gs = wv; ge = we; }
        if (lane == wl) cv = -INFINITY;
    }
    const float m = __shfl(gs, 0);
    float e = (lane < PK) ? expf(gs - m) : 0.f;
    const float sum = wave_sum(e);
    if (lane < PK) { tk_idx[(size_t)t * 128 + h * PK + lane] = ge; tk_gate[(size_t)t * 128 + h * PK + lane] = e / sum; }
}

__global__ void __launch_bounds__(256) k_peer(const float* xn2, const float* h, const float* wd, const float* wu, const int* tk_idx, const float* tk_gate,
                                              const float* gate2, const float* fg, float* out) {
    const int t = blockIdx.x * 4 + (threadIdx.x >> 6), lane = threadIdx.x & 63;
    f32x4 x[8], acc[8];
    const f32x4* xr = (const f32x4*)(xn2 + (size_t)t * D) + lane;
#pragma unroll
    for (int j = 0; j < 8; ++j) { x[j] = xr[64 * j]; acc[j] = (f32x4){0.f, 0.f, 0.f, 0.f}; }
    const int e0 = tk_idx[(size_t)t * 128 + lane], e1 = tk_idx[(size_t)t * 128 + 64 + lane];
    const float g0 = tk_gate[(size_t)t * 128 + lane], g1 = tk_gate[(size_t)t * 128 + 64 + lane];
    for (int k = 0; k < 128; ++k) {
        const int e = __shfl(k < 64 ? e0 : e1, k & 63); const float gt = __shfl(k < 64 ? g0 : g1, k & 63);
        const f32x4* dr = (const f32x4*)(wd + (size_t)e * D) + lane; float d = 0.f;
#pragma unroll
        for (int j = 0; j < 8; ++j) { const f32x4 w = dr[64 * j]; d += w.x * x[j].x + w.y * x[j].y + w.z * x[j].z + w.w * x[j].w; }
        d = wave_sum(d);
        const float a = 0.5f * d * (1.f + erff(d * 0.70710678118654752f)) * gt;
        const f32x4* ur = (const f32x4*)(wu + (size_t)e * D) + lane;
#pragma unroll
        for (int j = 0; j < 8; ++j) acc[j] = acc[j] + ur[64 * j] * a;
    }
    const f32x4* hr = (const f32x4*)(h + (size_t)t * D) + lane; float s = 0.f;
#pragma unroll
    for (int j = 0; j < 8; ++j) { const f32x4 g2 = *(const f32x4*)(gate2 + 4 * lane + 256 * j); acc[j] = hr[64 * j] + g2 * acc[j];
        s += acc[j].x * acc[j].x + acc[j].y * acc[j].y + acc[j].z * acc[j].z + acc[j].w * acc[j].w; }
    const float r = 1.0f / sqrtf(wave_sum(s) * (1.f / D) + EPS);
    f32x4* o = (f32x4*)(out + (size_t)t * D) + lane;
#pragma unroll
    for (int j = 0; j < 8; ++j) { const f32x4 g = *(const f32x4*)(fg + 4 * lane + 256 * j); o[64 * j] = acc[j] * r * g; }
}

extern "C" void kernel_launch(void* const* d_in, const int* in_sizes, int n_in, void* d_out, int out_size, void* d_ws, size_t ws_size, hipStream_t stream) {
    const float* x = (const float*)d_in[0]; const float* c = (const float*)d_in[1]; const float* ada_w = (const float*)d_in[2]; const float* ada_b = (const float*)d_in[3];
    const float* norm1_g = (const float*)d_in[4]; const float* w_in = (const float*)d_in[5]; const float* pool_mix = (const float*)d_in[6]; const float* pool_scale = (const float*)d_in[7];
    const float* w_ab = (const float*)d_in[8]; const float* w_pb = (const float*)d_in[9]; const float* w_out = (const float*)d_in[10]; const float* norm2_g = (const float*)d_in[11];
    const float* wq = (const float*)d_in[12]; const float* keys = (const float*)d_in[13]; const float* wdn = (const float*)d_in[14]; const float* wup = (const float*)d_in[15];
    const float* final_g = (const float*)d_in[16];
    float* out = (float*)d_out; char* ws = (char*)d_ws;
    constexpr size_t MiB = 1u << 20;
    if (ws_size < 530 * MiB) { fprintf(stderr, "kernel_launch: workspace too small (%zu)\n", ws_size); return; }
    float* Q = (float*)(ws); float* Kb = (float*)(ws + 96 * MiB); float* V = (float*)(ws + 192 * MiB); float* PIN = (float*)(ws + 288 * MiB);
    float* ATTN = (float*)(ws + 320 * MiB); float* POOL = (float*)(ws + 352 * MiB); float* MERGED = (float*)(ws + 384 * MiB);
    float* mod = (float*)(ws + 512 * MiB); float* LG = (float*)(ws + 513 * MiB);
    float* XN = out;
    float* OG = MERGED;
    float* DD = (float*)(ws + 480 * MiB);
    float* GAB = (float*)(ws);
    float* H = (float*)(ws);
    float* PQ = (float*)(ws + 128 * MiB);
    float* SC = (float*)(ws + 256 * MiB);
    int* TKI = (int*)(ws + 384 * MiB); float* TKG = (float*)(ws + 392 * MiB);

    k_mod<<<6 * D / 256, 256, 0, stream>>>(c, ada_w, ada_b, mod);
    const float *shift1 = mod, *scale1 = mod + D, *gate1 = mod + 2 * D, *shift2 = mod + 3 * D, *scale2 = mod + 4 * D, *gate2 = mod + 5 * D;
    k_rmsmod<<<S / 4, 256, 0, stream>>>(x, norm1_g, scale1, shift1, XN);
    k_sgemm<EpiQKVP><<<dim3(5120 / 128, S / 128), 256, 0, stream>>>(XN, D, w_in, INW, D, EpiQKVP{Q, Kb, V, PIN});
    k_rope<<<S * NH * 64 / 256, 256, 0, stream>>>(Q);
    k_rope<<<S * NH * 64 / 256, 256, 0, stream>>>(Kb);
    k_attn<<<S * NH / 4, 256, 0, stream>>>(Q, Kb, V, OG, LG);
    k_poold<<<S * PW / 256, 256, 0, stream>>>(PIN, DD);
    k_merge<<<S * AOW / 256, 256, 0, stream>>>(OG, LG, ATTN);
    for (int g = 0; g < 4; ++g)
        k_sgemm<EpiScaleCols><<<dim3(1, S / 128), 256, 0, stream>>>(DD + g * 128, PW, pool_mix + (size_t)g * 128 * 128, 128, 128, EpiScaleCols{POOL + g * 128, PW, pool_scale + g * 128});
    k_sgemm<EpiSigmoid><<<dim3(4096 / 128, S / 128), 256, 0, stream>>>(XN, D, w_in + 5120, INW, D, EpiSigmoid{GAB, 4096});
    k_sgemm<EpiGateMul><<<dim3(D / 128, S / 128), 256, 0, stream>>>(ATTN, AOW, w_ab, D, AOW, EpiGateMul{MERGED, GAB, 4096, 0});
    k_sgemm<EpiGateMul><<<dim3(D / 128, S / 128), 256, 0, stream>>>(POOL, PW, w_pb, D, PW, EpiGateMul{MERGED, GAB + D, 4096, 1});
    k_sgemm<EpiResid><<<dim3(D / 128, S / 128), 256, 0, stream>>>(MERGED, D, w_out, D, D, EpiResid{H, x, gate1});
    k_rmsmod<<<S / 4, 256, 0, stream>>>(H, norm2_g, scale2, shift2, XN);
    k_sgemm<EpiStore><<<dim3(D / 128, S / 128), 256, 0, stream>>>(XN, D, wq, D, D, EpiStore{PQ, D});
    k_scores<<<(S / 2) * 16, 256, 0, stream>>>(PQ, keys, SC);
    k_topk<<<S * PH / 4, 256, 0, stream>>>(SC, TKI, TKG);
    k_peer<<<S / 4, 256, 0, stream>>>(XN, H, wdn, wup, TKI, TKG, gate2, final_g, out);
}
```

```cpp
#include <hip/hip_runtime.h>
#include <cstdio>
#include <cstdint>
#include <cmath>

#ifndef MK_N_LAUNCHES
#define MK_N_LAUNCHES 1
#endif
constexpr int N_PHASES = 11;

namespace pg8 {
#define PG8_LAS __attribute__((address_space(3)))
typedef unsigned short bf16_t;
typedef short bf16x8 __attribute__((ext_vector_type(8)));
typedef float f32x4 __attribute__((ext_vector_type(4)));
typedef unsigned u32x4 __attribute__((ext_vector_type(4)));
constexpr int BM = 256, BK = 64, HALF = 128, HTB = HALF * BK * 2, STAGE_BYTES = 8 * HTB, NXCD = 8, WGM = 8;

__host__ __device__ __forceinline__ int lds_byte(int r, int c) { const int st = (r >> 4) * 2 + (c >> 5), rr = r & 15, cc = c & 31, ob = rr * 64 + cc * 2; return st * 1024 + (ob ^ (((ob >> 9) & 1) << 5)); }
__host__ __device__ __forceinline__ void stage_rc(int b, int& R, int& C) { const int st = b / 1024, sb = b % 1024, swz = sb ^ (((sb >> 9) & 1) << 5); R = (st >> 1) * 16 + swz / 64; C = (st & 1) * 32 + (swz % 64) / 2; }
__host__ __device__ __forceinline__ int perm32(int rho) { const int n = rho >> 4, i = rho & 15; return 8 * (i >> 2) + 4 * n + (i & 3); }

struct Unit { int pm, pn; };
struct Gemm { const bf16_t* A; const bf16_t* Bt; int lda, ldb, M, N, K; int acol_per_pn; };

struct StaticOrder {
    int nM, nN, nwg, G, c;
    __host__ __device__ void init(int M, int N, int G_, int c_) { nM = M / BM; nN = N / BM; nwg = nM * nN; G = G_; c = c_; }
    __host__ __device__ bool next(int i, Unit& u) const {
        const long L = (long)i * G + c; if (L >= nwg) return false;
        int wgid = (int)L; { const int q = nwg / NXCD, r = nwg % NXCD, xcd = wgid % NXCD, off = wgid / NXCD; wgid = (xcd < r ? xcd * (q + 1) : r * (q + 1) + (xcd - r) * q) + off; }
        const int nig = WGM * nN, gid = wgid / nig, fm = gid * WGM, gsz = (nM - fm) < WGM ? (nM - fm) : WGM;
        u.pm = fm + ((wgid % nig) % gsz); u.pn = (wgid % nig) / gsz; return true;
    }
};

template <class Epi>
__device__ __forceinline__ void gemm_phase(PG8_LAS unsigned char* lds, const Gemm g, const StaticOrder& S, const Epi& E) {
    const int tid = threadIdx.x, wid = __builtin_amdgcn_readfirstlane(tid >> 6), lane = tid & 63, wr = wid >> 2, wc = wid & 3, fr = lane & 15, fq = lane >> 4;
    const int K = g.K, nt = K / BK;
    unsigned voffA[2], voffB[2];
#pragma unroll
    for (int i = 0; i < 2; ++i) { int R, C; stage_rc(tid * 16 + i * 8192, R, C); const int Rb = Epi::PERM ? ((R & ~31) + perm32(R & 31)) : R;
        voffA[i] = (unsigned)(R * g.lda + C) * 2u; voffB[i] = (unsigned)(Rb * g.ldb + C) * 2u; }
    const size_t kstep = (size_t)(BK * 2);
    const size_t hstepA = (size_t)HALF * g.lda * 2, hstepB = (size_t)HALF * g.ldb * 2;
    const size_t tstepA = 2 * hstepA, tstepB = 2 * hstepB, cstepA = (size_t)g.acol_per_pn * 2;
    const unsigned ldsw = (unsigned)wid * 1024u;
    const int aoff = lds_byte(wr * 64 + fr, fq * 8), boff = lds_byte(wc * 32 + fr, fq * 8);
#define PG8_SA(b, h) (((b) * 2 + (h)) * HTB)
#define PG8_SB(b, h) ((4 + (b) * 2 + (h)) * HTB)
#define PG8_STAGE(bufoff, gbase, voff) do { _Pragma("unroll") for (int _i = 0; _i < 2; ++_i) \
        __builtin_amdgcn_global_load_lds((const unsigned*)((const char*)(gbase) + (voff)[_i]), (PG8_LAS unsigned*)(lds + (bufoff) + ldsw + _i * 8192), 16, 0, 0); } while (0)
#define PG8_LDA(dst, b, h) do { _Pragma("unroll") for (int m = 0; m < 4; ++m) _Pragma("unroll") for (int k = 0; k < 2; ++k) dst[m][k] = *(const PG8_LAS bf16x8*)(lds + PG8_SA(b, h) + aoff + m * 2048 + k * 1024); } while (0)
#define PG8_LDB(dst, b, h) do { _Pragma("unroll") for (int n = 0; n < 2; ++n) _Pragma("unroll") for (int k = 0; k < 2; ++k) dst[n][k] = *(const PG8_LAS bf16x8*)(lds + PG8_SB(b, h) + boff + n * 2048 + k * 1024); } while (0)
#define PG8_MMA(ai, bj, At, Bt) do { __builtin_amdgcn_s_setprio(1); _Pragma("unroll") for (int m = 0; m < 4; ++m) _Pragma("unroll") for (int n = 0; n < 2; ++n) _Pragma("unroll") for (int k = 0; k < 2; ++k) \
        acc[ai][bj][m][n] = __builtin_amdgcn_mfma_f32_16x16x32_bf16(Bt[n][k], At[m][k], acc[ai][bj][m][n], 0, 0, 0); __builtin_amdgcn_s_setprio(0); } while (0)
#define PG8_WAIT_V(n) asm volatile("s_waitcnt vmcnt(" #n ")" ::: "memory")
#define PG8_WAIT_L(n) asm volatile("s_waitcnt lgkmcnt(" #n ")" ::: "memory")
#define PG8_BAR __builtin_amdgcn_s_barrier()
#define PG8_SCHED __builtin_amdgcn_sched_barrier(0)
    Unit cur, nxt; int ui = 0;
    if (!S.next(0, cur)) return;
    f32x4 acc[2][2][4][2];
#pragma unroll
    for (int a = 0; a < 2; ++a)
#pragma unroll
        for (int b = 0; b < 2; ++b)
#pragma unroll
            for (int m = 0; m < 4; ++m)
#pragma unroll
                for (int n = 0; n < 2; ++n) acc[a][b][m][n] = (f32x4){0.f, 0.f, 0.f, 0.f};
    bf16x8 At[4][2], B0[2][2], B1[2][2];
    const char* cA = (const char*)g.A + (size_t)cur.pm * tstepA + (size_t)cur.pn * cstepA; const char* cB = (const char*)g.Bt + (size_t)cur.pn * tstepB;
    PG8_STAGE(PG8_SB(0, 0), cB, voffB); PG8_STAGE(PG8_SB(0, 1), cB + hstepB, voffB); PG8_STAGE(PG8_SA(0, 0), cA, voffA); PG8_STAGE(PG8_SA(0, 1), cA + hstepA, voffA);
    if (wr == 1) PG8_BAR;
    PG8_WAIT_V(2); PG8_BAR;
    PG8_STAGE(PG8_SB(1, 0), cB + kstep, voffB); PG8_STAGE(PG8_SA(1, 0), cA + kstep, voffA); PG8_STAGE(PG8_SB(1, 1), cB + hstepB + kstep, voffB);
    PG8_WAIT_V(6); PG8_BAR;
    for (;;) {
        const bool has_next = S.next(ui + 1, nxt);
        const char* nA = has_next ? (const char*)g.A + (size_t)nxt.pm * tstepA + (size_t)nxt.pn * cstepA : cA; const char* nB = has_next ? (const char*)g.Bt + (size_t)nxt.pn * tstepB : cB;
        for (int t = 0; t < nt; t += 2) {
            const bool last = (t == nt - 2);
            const char* a1 = cA + (size_t)(t + 1) * kstep;
            const char* a2 = last ? nA : cA + (size_t)(t + 2) * kstep; const char* b2 = last ? nB : cB + (size_t)(t + 2) * kstep;
            const char* a3 = a2 + kstep; const char* b3 = b2 + kstep;
            PG8_LDB(B0, 0, 0); PG8_LDB(B1, 0, 1); PG8_SCHED; PG8_LDA(At, 0, 0); PG8_STAGE(PG8_SA(1, 1), a1 + hstepA, voffA);
            PG8_WAIT_V(8); PG8_WAIT_L(0); PG8_BAR; PG8_MMA(0, 0, At, B0); PG8_MMA(0, 1, At, B1); PG8_BAR; PG8_SCHED;
            PG8_LDA(At, 0, 1); PG8_STAGE(PG8_SB(0, 0), b2, voffB); PG8_STAGE(PG8_SB(0, 1), b2 + hstepB, voffB); PG8_STAGE(PG8_SA(0, 0), a2, voffA);
            PG8_WAIT_V(8); PG8_WAIT_L(0); PG8_BAR; PG8_MMA(1, 0, At, B0); PG8_MMA(1, 1, At, B1); PG8_BAR; PG8_SCHED;
            PG8_LDB(B0, 1, 0); PG8_LDB(B1, 1, 1); PG8_SCHED; PG8_LDA(At, 1, 0); PG8_STAGE(PG8_SA(0, 1), a2 + hstepA, voffA);
            PG8_WAIT_V(8); PG8_WAIT_L(0); PG8_BAR; PG8_MMA(0, 0, At, B0); PG8_MMA(0, 1, At, B1); PG8_BAR; PG8_SCHED;
            PG8_LDA(At, 1, 1); PG8_STAGE(PG8_SB(1, 0), b3, voffB); PG8_STAGE(PG8_SB(1, 1), b3 + hstepB, voffB); PG8_STAGE(PG8_SA(1, 0), a3, voffA);
            PG8_WAIT_V(8); PG8_WAIT_L(0); PG8_BAR; PG8_MMA(1, 0, At, B0); PG8_MMA(1, 1, At, B1); PG8_BAR; PG8_SCHED;
        }
        if (wr == 0) PG8_BAR;
        E(acc, cur, wr, wc, fr, fq);
        if (!has_next) break;
#pragma unroll
        for (int a = 0; a < 2; ++a)
#pragma unroll
            for (int b = 0; b < 2; ++b)
#pragma unroll
                for (int m = 0; m < 4; ++m)
#pragma unroll
                    for (int n = 0; n < 2; ++n) acc[a][b][m][n] = (f32x4){0.f, 0.f, 0.f, 0.f};
        cur = nxt; cA = nA; cB = nB; ++ui;
        if (wr == 1) PG8_BAR;
    }
    PG8_WAIT_V(0);
    PG8_BAR;
#undef PG8_SA
#undef PG8_SB
#undef PG8_STAGE
#undef PG8_LDA
#undef PG8_LDB
#undef PG8_MMA
#undef PG8_WAIT_V
#undef PG8_WAIT_L
#undef PG8_BAR
#undef PG8_SCHED
}
}

constexpr int S = 16384, D = 2048, AW = 1536, NH = 12, HD = 128, AOW = 512, PW = 512, INW = 9216;
constexpr int PH = 8, PK = 16, NKEY = 128;
constexpr float EPS = 1e-6f;
constexpr float QSCALE = 0.08838834764831845f * 1.4426950408889634f;
constexpr int NWAVES = 8;

constexpr size_t MiB = 1u << 20;
constexpr size_t WS_CTL = 0, CTL_ZERO_BYTES = 1 * MiB;
constexpr size_t WS_MOD = 512 * 1024;
constexpr size_t WS_INVF = 1 * MiB;
constexpr size_t WS_WAB = 2 * MiB, WS_WPB = 4 * MiB, WS_MIX = 6 * MiB, WS_KEYS = 7 * MiB, WS_WOUT = 8 * MiB, WS_WQ = 16 * MiB, WS_WIN = 24 * MiB;
constexpr size_t WS_DOWN = 60 * MiB, WS_UP = 124 * MiB;
constexpr size_t WS_XN = 188 * MiB;
constexpr size_t WS_OG = 188 * MiB, WS_LSE = 236 * MiB;
constexpr size_t WS_Q = 252 * MiB, WS_K = 300 * MiB, WS_V = 348 * MiB, WS_PIN = 396 * MiB, WS_GA = 412 * MiB, WS_GB = 476 * MiB;
constexpr size_t WS_DPOOL = 24 * MiB, WS_ATTN = 40 * MiB;
constexpr size_t WS_POOL = 252 * MiB;
constexpr size_t WS_MERGED = 300 * MiB;
constexpr size_t WS_PQ = 412 * MiB;
constexpr size_t WS_SC = 252 * MiB;
constexpr size_t WS_END = 540 * MiB;
constexpr int CW_BAR = 4096;

constexpr int RING_BYTES = 147456;
constexpr int LDSCTL_OFF = RING_BYTES, MISC_OFF = LDSCTL_OFF + 320;
constexpr int LDS_BYTES = RING_BYTES + 1024;

#define GAS __attribute__((address_space(1)))
#define LAS __attribute__((address_space(3)))
typedef unsigned short bf16;
typedef unsigned v4u __attribute__((ext_vector_type(4)));
typedef unsigned v2u __attribute__((ext_vector_type(2)));
typedef float f32x4 __attribute__((ext_vector_type(4)));
typedef float f32x2 __attribute__((ext_vector_type(2)));
typedef short bf16x8 __attribute__((ext_vector_type(8)));
typedef short s16x4 __attribute__((ext_vector_type(4)));
typedef __bf16 bf16x2_t __attribute__((ext_vector_type(2)));
#define LDS_WAIT() asm volatile("s_waitcnt lgkmcnt(0)" ::: "memory")
#define VM_WAIT() asm volatile("s_waitcnt vmcnt(0)" ::: "memory")
__device__ __forceinline__ unsigned pk2(float lo, float hi) { f32x2 v = {lo, hi}; bf16x2_t b = __builtin_convertvector(v, bf16x2_t); return __builtin_bit_cast(unsigned, b); }
__device__ __forceinline__ float bflo(unsigned u) { return __uint_as_float(u << 16); }
__device__ __forceinline__ float bfhi(unsigned u) { return __uint_as_float(u & 0xffff0000u); }
__device__ __forceinline__ float wave_sum(float v) {
#pragma unroll
    for (int o = 1; o < 64; o <<= 1) v += __shfl_xor(v, o);
    return v;
}

#define XB_TMO      128
#define XB_XCNT(j)  (256  + 64 * (j))
#define XB_XSUB(j)  (1280 + 64 * (j))
#define XB_XGEN(j)  (2304 + 64 * (j))
#define XB_TOP      3328
#define XB_TOPGEN   3392
#define XCD_BAR_WORDS 3456
#define XB_SPIN_CAP (1u << 22)
__device__ __forceinline__ unsigned xb_ld(unsigned* p)              { return __hip_atomic_load(p, __ATOMIC_RELAXED, __HIP_MEMORY_SCOPE_AGENT); }
__device__ __forceinline__ unsigned xb_add(unsigned* p, unsigned v) { return __hip_atomic_fetch_add(p, v, __ATOMIC_RELAXED, __HIP_MEMORY_SCOPE_AGENT); }
__device__ __forceinline__ unsigned xb_xcc_id() { return (unsigned)__builtin_amdgcn_s_getreg((3 << 11) | 20) & 0xFu; }
#define XB_SPIN(cond, bar) do { unsigned _sp = 0; while (cond) { __builtin_amdgcn_s_sleep(1); \
    if ((++_sp & 255u) == 0u) { if (xb_ld(&(bar)[XB_TMO])) break; if (_sp > XB_SPIN_CAP) { atomicAdd(&(bar)[XB_TMO], 1u); break; } } } } while (0)
struct XcdBarrier { unsigned* bar; unsigned x; volatile LAS unsigned* st; };
__device__ __forceinline__ XcdBarrier xcd_barrier_post(unsigned* bar, volatile LAS unsigned* st) {
    XcdBarrier b; b.bar = bar; b.x = xb_xcc_id(); b.st = st;
    if (threadIdx.x == 0) (void)xb_add(&bar[XB_XCNT(b.x)], 1u);
    return b;
}
__device__ __forceinline__ void xcd_barrier_complete(unsigned* bar, unsigned x, unsigned& nloc, unsigned& nx) {
    const unsigned G = gridDim.x * gridDim.y * gridDim.z;
    unsigned sum, cnt, mine, sp = 0u;
    for (;;) {
        sum = 0u; cnt = 0u; mine = 0u;
#pragma unroll
        for (unsigned j = 0; j < 16; ++j) { const unsigned c = xb_ld(&bar[XB_XCNT(j)]); sum += c; cnt += (c > 0u) ? 1u : 0u; mine = (j == x) ? c : mine; }
        if (sum == G) break;
        __builtin_amdgcn_s_sleep(1);
        if ((++sp & 255u) == 0u) { if (xb_ld(&bar[XB_TMO])) break; if (sp > XB_SPIN_CAP) { atomicAdd(&bar[XB_TMO], 1u); break; } }
    }
    nloc = mine > 0u ? mine : 1u; nx = cnt > 0u ? cnt : 1u;
}
__device__ __forceinline__ void xcd_barrier(const XcdBarrier& b) {
    asm volatile("s_waitcnt vmcnt(0)" ::: "memory");
    __syncthreads();
    if (threadIdx.x == 0) {
        unsigned* bar = b.bar;
        __builtin_amdgcn_s_waitcnt(0);
        unsigned nloc = b.st[0], nx = b.st[1];
        if (nloc == 0u) { xcd_barrier_complete(bar, b.x, nloc, nx); b.st[0] = nloc; b.st[1] = nx; }
        const unsigned old = xb_add(&bar[XB_XSUB(b.x)], 1u);
        const unsigned gen = old / nloc;
        if (old + 1u == (gen + 1u) * nloc) {
            __builtin_amdgcn_fence(__ATOMIC_RELEASE, "agent");
            asm volatile("s_waitcnt vmcnt(0)" ::: "memory");
            const unsigned og = xb_add(&bar[XB_TOP], 1u);
            const unsigned tg = og / nx;
            if (og + 1u == (tg + 1u) * nx) xb_add(&bar[XB_TOPGEN], 1u);
            else XB_SPIN(xb_ld(&bar[XB_TOPGEN]) == tg, bar);
            __builtin_amdgcn_fence(__ATOMIC_ACQUIRE, "agent");
            xb_add(&bar[XB_XGEN(b.x)], 1u);
            asm volatile("s_waitcnt vmcnt(0)" ::: "memory");
        } else {
            XB_SPIN(xb_ld(&bar[XB_XGEN(b.x)]) == gen, bar);
            __builtin_amdgcn_fence(__ATOMIC_ACQUIRE, "agent");
            asm volatile("s_waitcnt vmcnt(0)" ::: "memory");
        }
    }
    __syncthreads();
}

using pg8::Unit;
__device__ __forceinline__ v4u pack8(const f32x4 a, const f32x4 b) { v4u w; w.x = pk2(a[0], a[1]); w.y = pk2(a[2], a[3]); w.z = pk2(b[0], b[1]); w.w = pk2(b[2], b[3]); return w; }

struct EpiInProj {
    static constexpr bool PERM = true;
    bf16 *Q, *K, *V, *PIN, *GA, *GB; const float* invf;
    __device__ __forceinline__ void operator()(const f32x4 (&acc)[2][2][4][2], const Unit& u, int wr, int wc, int fr, int fq) const {
        const int pn = u.pn, row0 = u.pm * 256 + wr * 64 + fr, cl = wc * 32 + 8 * fq;
        if (pn < 12) {
            bf16* base = pn < 6 ? Q : K; const int ct = (pn < 6 ? pn : pn - 6) * 256; const float qs = pn < 6 ? QSCALE : 1.0f;
            float inv[4];
#pragma unroll
            for (int i = 0; i < 4; ++i) inv[i] = invf[(cl >> 1) + i];
#pragma unroll
            for (int ai = 0; ai < 2; ++ai)
#pragma unroll
                for (int m = 0; m < 4; ++m) {
                    const int row = row0 + ai * 128 + m * 16;
                    float cs[4], sn[4];
#pragma unroll
                    for (int i = 0; i < 4; ++i) { const float ang = (float)row * inv[i]; double rev = (double)ang * 0.15915494309189533577; rev -= rint(rev);
                        sn[i] = __builtin_amdgcn_sinf((float)rev) * qs; cs[i] = __builtin_amdgcn_cosf((float)rev) * qs; }
#pragma unroll
                    for (int bj = 0; bj < 2; ++bj) {
                        const f32x4 v0 = acc[ai][bj][m][0], v1 = acc[ai][bj][m][1]; f32x4 o0, o1;
                        o0[0] = v0[0] * cs[0] - v0[1] * sn[0]; o0[1] = v0[1] * cs[0] + v0[0] * sn[0]; o0[2] = v0[2] * cs[1] - v0[3] * sn[1]; o0[3] = v0[3] * cs[1] + v0[2] * sn[1];
                        o1[0] = v1[0] * cs[2] - v1[1] * sn[2]; o1[1] = v1[1] * cs[2] + v1[0] * sn[2]; o1[2] = v1[2] * cs[3] - v1[3] * sn[3]; o1[3] = v1[3] * cs[3] + v1[2] * sn[3];
                        *(v4u*)(base + (size_t)row * AW + ct + bj * 128 + cl) = pack8(o0, o1);
                    }
                }
        } else if (pn < 20) {
            bf16* base = pn < 18 ? V : PIN; const int ct = (pn < 18 ? pn - 12 : pn - 18) * 256; const int ld = pn < 18 ? AW : PW;
#pragma unroll
            for (int ai = 0; ai < 2; ++ai)
#pragma unroll
                for (int m = 0; m < 4; ++m) { const int row = row0 + ai * 128 + m * 16;
#pragma unroll
                    for (int bj = 0; bj < 2; ++bj) *(v4u*)(base + (size_t)row * ld + ct + bj * 128 + cl) = pack8(acc[ai][bj][m][0], acc[ai][bj][m][1]); }
        } else {
            bf16* base = pn < 28 ? GA : GB; const int ct = (pn < 28 ? pn - 20 : pn - 28) * 256;
#pragma unroll
            for (int ai = 0; ai < 2; ++ai)
#pragma unroll
                for (int m = 0; m < 4; ++m) { const int row = row0 + ai * 128 + m * 16;
#pragma unroll
                    for (int bj = 0; bj < 2; ++bj) { f32x4 a = acc[ai][bj][m][0], b = acc[ai][bj][m][1];
#pragma unroll
                        for (int e = 0; e < 4; ++e) { a[e] = __builtin_amdgcn_rcpf(1.0f + __expf(-a[e])); b[e] = __builtin_amdgcn_rcpf(1.0f + __expf(-b[e])); }
                        *(v4u*)(base + (size_t)row * D + ct + bj * 128 + cl) = pack8(a, b); } }
        }
    }
};
struct EpiBf16 {
    static constexpr bool PERM = true;
    bf16* O; int ld; const float* colscale;
    __device__ __forceinline__ void operator()(const f32x4 (&acc)[2][2][4][2], const Unit& u, int wr, int wc, int fr, int fq) const {
        const int row0 = u.pm * 256 + wr * 64 + fr, col0 = u.pn * 256 + wc * 32 + 8 * fq;
        f32x4 s[2][2];
#pragma unroll
        for (int bj = 0; bj < 2; ++bj)
#pragma unroll
            for (int n = 0; n < 2; ++n) s[bj][n] = colscale ? *(const f32x4*)(colscale + col0 + bj * 128 + 4 * n) : (f32x4){1.f, 1.f, 1.f, 1.f};
#pragma unroll
        for (int ai = 0; ai < 2; ++ai)
#pragma unroll
            for (int m = 0; m < 4; ++m) { const int row = row0 + ai * 128 + m * 16;
#pragma unroll
                for (int bj = 0; bj < 2; ++bj) *(v4u*)(O + (size_t)row * ld + col0 + bj * 128) = pack8(acc[ai][bj][m][0] * s[bj][0], acc[ai][bj][m][1] * s[bj][1]); }
    }
};
struct EpiGate {
    static constexpr bool PERM = true;
    bf16* O; const bf16* G; int accum;
    __device__ __forceinline__ void operator()(const f32x4 (&acc)[2][2][4][2], const Unit& u, int wr, int wc, int fr, int fq) const {
        const int row0 = u.pm * 256 + wr * 64 + fr, col0 = u.pn * 256 + wc * 32 + 8 * fq;
#pragma unroll
        for (int ai = 0; ai < 2; ++ai)
#pragma unroll
            for (int m = 0; m < 4; ++m) { const int row = row0 + ai * 128 + m * 16;
#pragma unroll
                for (int bj = 0; bj < 2; ++bj) { const size_t off = (size_t)row * D + col0 + bj * 128;
                    const v4u g = *(const v4u*)(G + off); f32x4 a = acc[ai][bj][m][0], b = acc[ai][bj][m][1];
                    a[0] *= bflo(g.x); a[1] *= bfhi(g.x); a[2] *= bflo(g.y); a[3] *= bfhi(g.y); b[0] *= bflo(g.z); b[1] *= bfhi(g.z); b[2] *= bflo(g.w); b[3] *= bfhi(g.w);
                    if (accum) { const v4u p = *(const v4u*)(O + off);
                        a[0] += bflo(p.x); a[1] += bfhi(p.x); a[2] += bflo(p.y); a[3] += bfhi(p.y); b[0] += bflo(p.z); b[1] += bfhi(p.z); b[2] += bflo(p.w); b[3] += bfhi(p.w); }
                    *(v4u*)(O + off) = pack8(a, b); } }
    }
};
struct EpiResid {
    static constexpr bool PERM = false;
    float* H; const float* x; const float* gate;
    __device__ __forceinline__ void operator()(const f32x4 (&acc)[2][2][4][2], const Unit& u, int wr, int wc, int fr, int fq) const {
        const int row0 = u.pm * 256 + wr * 64 + fr, col0 = u.pn * 256 + wc * 32 + 4 * fq;
#pragma unroll
        for (int ai = 0; ai < 2; ++ai)
#pragma unroll
            for (int m = 0; m < 4; ++m) { const int row = row0 + ai * 128 + m * 16;
#pragma unroll
                for (int bj = 0; bj < 2; ++bj)
#pragma unroll
                    for (int n = 0; n < 2; ++n) { const int col = col0 + bj * 128 + n * 16; const size_t off = (size_t)row * D + col;
                        const f32x4 g = *(const f32x4*)(gate + col), xx = *(const f32x4*)(x + off); *(f32x4*)(H + off) = xx + g * acc[ai][bj][m][n]; } }
    }
};
struct EpiF32 {
    static constexpr bool PERM = false;
    float* O; int ld;
    __device__ __forceinline__ void operator()(const f32x4 (&acc)[2][2][4][2], const Unit& u, int wr, int wc, int fr, int fq) const {
        const int row0 = u.pm * 256 + wr * 64 + fr, col0 = u.pn * 256 + wc * 32 + 4 * fq;
#pragma unroll
        for (int ai = 0; ai < 2; ++ai)
#pragma unroll
            for (int m = 0; m < 4; ++m) { const int row = row0 + ai * 128 + m * 16;
#pragma unroll
                for (int bj = 0; bj < 2; ++bj)
#pragma unroll
                    for (int n = 0; n < 2; ++n) *(f32x4*)(O + (size_t)row * ld + col0 + bj * 128 + n * 16) = acc[ai][bj][m][n]; }
    }
};

__device__ __forceinline__ void p0_transpose_item(const float* W, int K, int N, bf16* WT, bool ropeperm, LAS float* scr, int item, int lane) {
    const int nblk = N / 32, kb = item / nblk, nb = item % nblk, k0 = 64 * kb, n0 = 32 * nb;
#pragma unroll 8
    for (int i = 0; i < 32; ++i) { const int kk = 2 * i + (lane >> 5); scr[kk * 33 + (lane & 31)] = W[(size_t)(k0 + kk) * N + n0 + (lane & 31)]; }
    LDS_WAIT(); asm volatile("" ::: "memory");
    const int c = lane & 7;
#pragma unroll
    for (int j = 0; j < 4; ++j) { const int n = (lane >> 3) + 8 * j; const LAS float* s = scr + (8 * c) * 33 + n;
        v4u o; o.x = pk2(s[0 * 33], s[1 * 33]); o.y = pk2(s[2 * 33], s[3 * 33]); o.z = pk2(s[4 * 33], s[5 * 33]); o.w = pk2(s[6 * 33], s[7 * 33]);
        int rown = n0 + n; if (ropeperm && rown < 2 * AW) { const int d = rown & 127; rown = (rown & ~127) + 2 * (d & 63) + (d >> 6); }
        *(v4u*)(WT + (size_t)rown * K + k0 + 8 * c) = o; }
    LDS_WAIT(); asm volatile("" ::: "memory");
}
__device__ __forceinline__ void rmsmod_row(const float* xrow, const float* g, const float* scale, const float* shift, bf16* orow, int lane) {
    const f32x4* xr = (const f32x4*)xrow + lane;
    f32x4 v[8]; float s = 0.f;
#pragma unroll
    for (int j = 0; j < 8; ++j) { v[j] = xr[64 * j]; s += (v[j].x * v[j].x + v[j].y * v[j].y) + (v[j].z * v[j].z + v[j].w * v[j].w); }
    const float r = 1.0f / sqrtf(wave_sum(s) * (1.f / D) + EPS);
    v2u* o = (v2u*)orow + lane;
#pragma unroll
    for (int j = 0; j < 8; ++j) { const int c0 = 4 * lane + 256 * j;
        const f32x4 gg = *(const f32x4*)(g + c0), sc = *(const f32x4*)(scale + c0), sh = *(const f32x4*)(shift + c0);
        v2u w; w.x = pk2(v[j].x * r * gg.x * (1.f + sc.x) + sh.x, v[j].y * r * gg.y * (1.f + sc.y) + sh.y); w.y = pk2(v[j].z * r * gg.z * (1.f + sc.z) + sh.z, v[j].w * r * gg.w * (1.f + sc.w) + sh.w);
        o[64 * j] = w; }
}

constexpr int KV_STRIDE = 288;
constexpr int KV_TILE = 256 * KV_STRIDE;
typedef short v4i16_t __attribute__((ext_vector_type(4)));
__device__ __forceinline__ s16x4 vtr(LAS const unsigned char* p) { return __builtin_bit_cast(s16x4, __builtin_amdgcn_ds_read_tr16_b64_v4i16((LAS v4i16_t*)p)); }

__device__ __forceinline__ void attn_unit(LAS unsigned char* lds, int unit, const bf16* Q, const bf16* K, const bf16* V, bf16* OG, float* LSE) {
    const int tid = threadIdx.x, lane = tid & 63, w = __builtin_amdgcn_readfirstlane(tid >> 6), fr = lane & 15, fq = lane >> 4;
    const int g = unit >> 9, rem = unit & 511, j = rem & 3, blk = rem >> 2;
    const int dsh = 2 * g, dil = 1 << dsh;
    const int r = blk & (dil - 1), n = blk >> dsh, head = 4 * g + j;
    LAS unsigned char* Kl = lds; LAS unsigned char* Vl = lds + KV_TILE;
#pragma unroll
    for (int i = 0; i < 8; ++i) {
        const int idx = tid + 512 * i, kr = idx >> 4, ch = idx & 15; const int l = 128 * n - 128 + kr;
        v4u kv = {0u, 0u, 0u, 0u}, vv = {0u, 0u, 0u, 0u};
        if (l >= 0) { const size_t off = (size_t)((l << dsh) + r) * AW + head * HD + ch * 8; kv = *(const v4u*)(K + off); vv = *(const v4u*)(V + off); }
        *(LAS v4u*)(Kl + kr * KV_STRIDE + ch * 16) = kv; *(LAS v4u*)(Vl + kr * KV_STRIDE + ch * 16) = vv;
    }
    const int qpos = ((128 * n + 16 * w + fr) << dsh) + r;
    bf16x8 qf[4];
#pragma unroll
    for (int ks = 0; ks < 4; ++ks) qf[ks] = *(const bf16x8*)(Q + (size_t)qpos * AW + head * HD + 32 * ks + 8 * fq);
    __syncthreads();
    f32x4 st[9];
#pragma unroll
    for (int b = 0; b < 9; ++b) { st[b] = (f32x4){0.f, 0.f, 0.f, 0.f};
#pragma unroll
        for (int ks = 0; ks < 4; ++ks) { const bf16x8 kf = *(LAS const bf16x8*)(Kl + (16 * (w + b) + fr) * KV_STRIDE + 64 * ks + 16 * fq);
            st[b] = __builtin_amdgcn_mfma_f32_16x16x32_bf16(kf, qf[ks], st[b], 0, 0, 0); } }
    float mx = -INFINITY;
#pragma unroll
    for (int b = 0; b < 9; ++b)
#pragma unroll
        for (int e = 0; e < 4; ++e) { const int kk = 16 * b + 4 * fq + e;
            const bool ok = (kk >= fr) && (kk <= fr + 128) && (n > 0 || 16 * w + kk >= 128);
            st[b][e] = ok ? st[b][e] : -INFINITY; mx = fmaxf(mx, st[b][e]); }
    mx = fmaxf(mx, __shfl_xor(mx, 16)); mx = fmaxf(mx, __shfl_xor(mx, 32));
    float sm = 0.f;
#pragma unroll
    for (int b = 0; b < 9; ++b)
#pragma unroll
        for (int e = 0; e < 4; ++e) { const float p = __builtin_amdgcn_exp2f(st[b][e] - mx); st[b][e] = p; sm += p; }
    sm += __shfl_xor(sm, 16); sm += __shfl_xor(sm, 32);
    f32x4 o[8];
#pragma unroll
    for (int dt = 0; dt < 8; ++dt) o[dt] = (f32x4){0.f, 0.f, 0.f, 0.f};
    const int q4 = fr >> 2, p4 = fr & 3;
#pragma unroll
    for (int s = 0; s < 5; ++s) {
        bf16x8 pf; { const unsigned a = pk2(st[2 * s][0], st[2 * s][1]), b = pk2(st[2 * s][2], st[2 * s][3]);
            unsigned c = 0u, d = 0u; if (s < 4) { c = pk2(st[2 * s + 1][0], st[2 * s + 1][1]); d = pk2(st[2 * s + 1][2], st[2 * s + 1][3]); }
            const v4u t = {a, b, c, d}; pf = __builtin_bit_cast(bf16x8, t); }
        LAS const unsigned char* v0 = Vl + (16 * (w + 2 * s) + 4 * fq + q4) * KV_STRIDE + 8 * p4;
#pragma unroll
        for (int dt = 0; dt < 8; ++dt) {
            const s16x4 lo = vtr(v0 + 32 * dt); s16x4 hi = {0, 0, 0, 0}; if (s < 4) hi = vtr(v0 + 16 * KV_STRIDE + 32 * dt);
            const bf16x8 vf = {lo[0], lo[1], lo[2], lo[3], hi[0], hi[1], hi[2], hi[3]};
            o[dt] = __builtin_amdgcn_mfma_f32_16x16x32_bf16(vf, pf, o[dt], 0, 0, 0);
        }
    }
    const float inv = 1.0f / sm;
    bf16* orow = OG + ((size_t)g * S + qpos) * AOW + j * HD + 4 * fq;
#pragma unroll
    for (int dt = 0; dt < 8; ++dt) { v2u wv; wv.x = pk2(o[dt][0] * inv, o[dt][1] * inv); wv.y = pk2(o[dt][2] * inv, o[dt][3] * inv); *(v2u*)(orow + 16 * dt) = wv; }
    if (fq == 0) LSE[((size_t)g * S + qpos) * 4 + j] = mx * 0.6931471805599453f + __logf(sm);
    __syncthreads();
}

__device__ __forceinline__ unsigned fkey(float f) { const unsigned u = __float_as_uint(f); return (u & 0x80000000u) ? ~u : (u | 0x80000000u); }
__device__ __forceinline__ unsigned long long wave_max_u64(unsigned long long k) {
#pragma unroll
    for (int o = 1; o < 64; o <<= 1) {
        const unsigned lo = __shfl_xor((unsigned)k, o), hi = __shfl_xor((unsigned)(k >> 32), o);
        const unsigned long long other = ((unsigned long long)hi << 32) | lo; k = other > k ? other : k;
    }
    return k;
}
__device__ __forceinline__ void cand_ij(int c, int& i, int& j) {
    const int pre[17] = {0, 16, 24, 29, 33, 36, 38, 40, 42, 43, 44, 45, 46, 47, 48, 49, 50};
    i = 0; j = 0;
#pragma unroll
    for (int r = 0; r < 16; ++r) if (c >= pre[r] && c < pre[r + 1]) { i = r; j = c - pre[r]; }
}
__device__ __forceinline__ void topk_head(const float* srow, int lane, LAS int* eid, LAS float* gt) {
    float ts[2]; int ti[2];
#pragma unroll
    for (int p = 0; p < 2; ++p) {
        float v0 = srow[p * 128 + lane], v1 = srow[p * 128 + 64 + lane];
        float mys = -INFINITY; int myi = 0;
        for (int k = 0; k < PK; ++k) {
            const bool first = v0 >= v1; const float bv = first ? v0 : v1; const int bi = first ? lane : lane + 64;
            const unsigned long long best = wave_max_u64(((unsigned long long)fkey(bv) << 32) | (unsigned)(127 - bi));
            const int widx = 127 - (int)(best & 0xffffffffu);
            const unsigned bk = (unsigned)(best >> 32); const float wv = __uint_as_float((bk & 0x80000000u) ? (bk & 0x7fffffffu) : ~bk);
            if (lane == k) { mys = wv; myi = widx; }
            if (widx == lane) v0 = -INFINITY; if (widx == lane + 64) v1 = -INFINITY;
        }
        ts[p] = mys; ti[p] = myi;
    }
    int ci, cj; cand_ij(lane < 50 ? lane : 0, ci, cj);
    const float a = __shfl(ts[0], ci), b = __shfl(ts[1], cj);
    const int ex = __shfl(ti[0], ci) * NKEY + __shfl(ti[1], cj);
    float cv = (lane < 50) ? a + b : -INFINITY; const int flat = ci * 16 + cj;
    float gs = -INFINITY; int ge = 0;
    for (int k = 0; k < PK; ++k) {
        const unsigned long long key = ((unsigned long long)fkey(cv) << 32) | ((unsigned long long)(255 - flat) << 8) | (unsigned)lane;
        const unsigned long long best = wave_max_u64(lane < 50 ? key : 0ull);
        const int wl = (int)(best & 0xffu);
        const float wv = __shfl(cv, wl); const int we = __shfl(ex, wl);
        if (lane == k) { gs = wv; ge = we; }
        if (lane == wl) cv = -INFINITY;
    }
    const float m = __shfl(gs, 0);
    const float e = (lane < PK) ? __expf(gs - m) : 0.f;
    const float sum = wave_sum(e);
    if (lane < PK) { eid[lane] = ge; gt[lane] = e / sum; }
}

struct Args { const float* in[17]; float* out; unsigned char* ws; int ph_lo, ph_hi, li, pad; };

__global__ void __launch_bounds__(NWAVES * 64, 2) mk_fwd(Args args) {
    extern __shared__ __attribute__((aligned(16))) unsigned char lds_raw[];
    LAS unsigned char* lds = (LAS unsigned char*)lds_raw;
    volatile LAS unsigned* MISC = (volatile LAS unsigned*)(lds + MISC_OFF);
    const int tid = threadIdx.x, lane = tid & 63, wave = __builtin_amdgcn_readfirstlane(tid >> 6);
    const int G = gridDim.x, bx = blockIdx.x;
    const int vcu = (G % 8 == 0) ? (bx % 8) * (G / 8) + bx / 8 : bx;
    const int gw = vcu * NWAVES + wave, NGW = G * NWAVES;
    unsigned char* ws = args.ws;
    const float* x = args.in[0]; const float* cvec = args.in[1]; const float* ada_w = args.in[2]; const float* ada_b = args.in[3]; const float* norm1_g = args.in[4];
    const float* w_in = args.in[5]; const float* pool_mix = args.in[6]; const float* pool_scale = args.in[7]; const float* w_ab = args.in[8]; const float* w_pb = args.in[9];
    const float* w_out = args.in[10]; const float* norm2_g = args.in[11]; const float* wq = args.in[12]; const float* keys = args.in[13]; const float* wdn = args.in[14];
    const float* wup = args.in[15]; const float* final_g = args.in[16];
    float* out = args.out;
    float* mod = (float*)(ws + WS_MOD); float* invf = (float*)(ws + WS_INVF);
    bf16* WAB = (bf16*)(ws + WS_WAB); bf16* WPB = (bf16*)(ws + WS_WPB); bf16* MIX = (bf16*)(ws + WS_MIX); bf16* KEYS = (bf16*)(ws + WS_KEYS);
    bf16* WOUT = (bf16*)(ws + WS_WOUT); bf16* WQ = (bf16*)(ws + WS_WQ); bf16* WIN = (bf16*)(ws + WS_WIN); bf16* DOWN = (bf16*)(ws + WS_DOWN); bf16* UP = (bf16*)(ws + WS_UP);
    bf16* XN = (bf16*)(ws + WS_XN); bf16* OG = (bf16*)(ws + WS_OG); float* LSE = (float*)(ws + WS_LSE);
    bf16* Qb = (bf16*)(ws + WS_Q); bf16* Kb = (bf16*)(ws + WS_K); bf16* Vb = (bf16*)(ws + WS_V); bf16* PIN = (bf16*)(ws + WS_PIN); bf16* GA = (bf16*)(ws + WS_GA); bf16* GB = (bf16*)(ws + WS_GB);
    bf16* DPOOL = (bf16*)(ws + WS_DPOOL); bf16* ATTN = (bf16*)(ws + WS_ATTN); bf16* POOL = (bf16*)(ws + WS_POOL); bf16* MERGED = (bf16*)(ws + WS_MERGED);
    bf16* PQ = (bf16*)(ws + WS_PQ); float* SC = (float*)(ws + WS_SC);
    float* H = out;
    const float *shift1 = mod, *scale1 = mod + D, *gate1 = mod + 2 * D, *shift2 = mod + 3 * D, *scale2 = mod + 4 * D, *gate2 = mod + 5 * D;

    for (int u = tid; u < (LDS_BYTES - LDSCTL_OFF) / 4; u += NWAVES * 64) ((LAS unsigned*)(lds + LDSCTL_OFF))[u] = 0u;
    __syncthreads();
    XcdBarrier bar; bar.bar = (unsigned*)(ws + WS_CTL) + CW_BAR; bar.x = 0; bar.st = nullptr;
    if (MK_N_LAUNCHES == 1) bar = xcd_barrier_post((unsigned*)(ws + WS_CTL) + CW_BAR, MISC + 8);
    const int lo = args.ph_lo, hi = args.ph_hi;
#define IN(k) (lo <= (k) && (k) < hi)
#define SEAM(k) do { if (IN(k) && IN((k) + 1)) xcd_barrier(bar); } while (0)

    if (IN(0)) {
        for (int chunk = bx; chunk < 6 * D / 48; chunk += G) {
            LAS float* red = (LAS float*)lds;
            const int cq = tid % 12, rg = tid / 12;
            if (rg < 32) {
                f32x4 a = {0.f, 0.f, 0.f, 0.f};
                const float* wp = ada_w + (size_t)(rg * 64) * (6 * D) + chunk * 48 + 4 * cq;
#pragma unroll 8
                for (int i = 0; i < 64; ++i) { const float ci = cvec[rg * 64 + i]; const float sl = ci / (1.0f + __expf(-ci)); a = a + *(const f32x4*)(wp + (size_t)i * (6 * D)) * sl; }
                *(LAS f32x4*)(red + rg * 48 + 4 * cq) = a;
            }
            __syncthreads();
            if (tid < 48) { float s = 0.f;
#pragma unroll 8
                for (int i = 0; i < 32; ++i) s += red[i * 48 + tid];
                mod[chunk * 48 + tid] = s + ada_b[chunk * 48 + tid]; }
            __syncthreads();
        }
        if (gw == 0) invf[lane] = (float)pow(10000.0, -(double)lane / 64.0);
        LAS float* scr = (LAS float*)(lds + wave * 16384);
        constexpr int I_IN = (D / 64) * (INW / 32), I_B = (AOW / 64) * (D / 32), I_O = (D / 64) * (D / 32);
        constexpr int NT_ITEMS = I_IN + 2 * I_B + 2 * I_O;
        for (int it = gw; it < NT_ITEMS; it += NGW) {
            int r = it;
            if (r < I_IN) { p0_transpose_item(w_in, D, INW, WIN, true, scr, r, lane); continue; } r -= I_IN;
            if (r < I_B) { p0_transpose_item(w_ab, AOW, D, WAB, false, scr, r, lane); continue; } r -= I_B;
            if (r < I_B) { p0_transpose_item(w_pb, PW, D, WPB, false, scr, r, lane); continue; } r -= I_B;
            if (r < I_O) { p0_transpose_item(w_out, D, D, WOUT, false, scr, r, lane); continue; } r -= I_O;
            p0_transpose_item(wq, D, D, WQ, false, scr, r, lane);
        }
        for (int n = gw; n < PW; n += NGW) { const int g = n >> 7, d = n & 127, k0 = 8 * lane; v4u o = {0u, 0u, 0u, 0u};
            if ((k0 >> 7) == g) { const float* p = pool_mix + ((size_t)g * 128 + (k0 & 127)) * 128 + d;
                o.x = pk2(p[0], p[128]); o.y = pk2(p[256], p[384]); o.z = pk2(p[512], p[640]); o.w = pk2(p[768], p[896]); }
            *(v4u*)(MIX + (size_t)n * PW + k0) = o; }
        for (int it = gw; it < PH * 128; it += NGW) { const int rowi = 2 * it + (lane >> 5), h = rowi >> 8, nn = rowi & 255, p = nn >> 7, k0 = 8 * (lane & 31); v4u o = {0u, 0u, 0u, 0u};
            if ((k0 >> 7) == p) { const float* s = keys + (((size_t)h * 2 + p) * NKEY + (nn & 127)) * 128 + (k0 & 127); const f32x4 a = *(const f32x4*)s, b = *(const f32x4*)(s + 4); o = pack8(a, b); }
            *(v4u*)(KEYS + (size_t)rowi * 256 + k0) = o; }
        for (int rowi = gw; rowi < 2 * 16384; rowi += NGW) { const float* src = (rowi < 16384 ? wdn : wup) + (size_t)(rowi & 16383) * D; bf16* dst = (rowi < 16384 ? DOWN : UP) + (size_t)(rowi & 16383) * D;
#pragma unroll
            for (int j = 0; j < 4; ++j) { const f32x4 a = *(const f32x4*)(src + 512 * j + 8 * lane), b = *(const f32x4*)(src + 512 * j + 8 * lane + 4); *(v4u*)(dst + 512 * j + 8 * lane) = pack8(a, b); } }
    }
    SEAM(0);
    if (IN(1)) { for (int m = gw; m < S; m += NGW) rmsmod_row(x + (size_t)m * D, norm1_g, scale1, shift1, XN + (size_t)m * D, lane); }
    SEAM(1);
    if (IN(2)) {
        pg8::Gemm g{XN, WIN, D, D, S, INW, D, 0}; pg8::StaticOrder So; So.init(S, INW, G, bx);
        EpiInProj E{Qb, Kb, Vb, PIN, GA, GB, invf};
        pg8::gemm_phase<EpiInProj>(lds, g, So, E);
    }
    SEAM(2);
    if (IN(3)) {
        for (int u = bx; u < 1536; u += G) attn_unit(lds, u, Qb, Kb, Vb, OG, LSE);
        for (int t = gw; t < S; t += NGW) {
            const int wsz = 2 << (lane >> 4); const int nwin = (t + 1 < wsz) ? t + 1 : wsz;
            float sacc[8] = {0.f, 0.f, 0.f, 0.f, 0.f, 0.f, 0.f, 0.f}; v4u cur = {0u, 0u, 0u, 0u};
            for (int i = 0; i < nwin; ++i) { const v4u p = *(const v4u*)(PIN + (size_t)(t - i) * PW + 8 * lane); if (i == 0) cur = p;
                sacc[0] += bflo(p.x); sacc[1] += bfhi(p.x); sacc[2] += bflo(p.y); sacc[3] += bfhi(p.y); sacc[4] += bflo(p.z); sacc[5] += bfhi(p.z); sacc[6] += bflo(p.w); sacc[7] += bfhi(p.w); }
            const float rn = 1.0f / (float)nwin; v4u o;
            o.x = pk2(sacc[0] * rn - bflo(cur.x), sacc[1] * rn - bfhi(cur.x)); o.y = pk2(sacc[2] * rn - bflo(cur.y), sacc[3] * rn - bfhi(cur.y));
            o.z = pk2(sacc[4] * rn - bflo(cur.z), sacc[5] * rn - bfhi(cur.z)); o.w = pk2(sacc[6] * rn - bflo(cur.w), sacc[7] * rn - bfhi(cur.w));
            *(v4u*)(DPOOL + (size_t)t * PW + 8 * lane) = o;
        }
    }
    SEAM(3);
    if (IN(4)) {
        for (int t = gw; t < S; t += NGW) { const int j = lane >> 4;
            const float l0 = LSE[((size_t)0 * S + t) * 4 + j], l1 = LSE[((size_t)1 * S + t) * 4 + j], l2 = LSE[((size_t)2 * S + t) * 4 + j];
            const float m = fmaxf(l0, fmaxf(l1, l2)); float e0 = __expf(l0 - m), e1 = __expf(l1 - m), e2 = __expf(l2 - m); const float inv = 1.0f / (e0 + e1 + e2); e0 *= inv; e1 *= inv; e2 *= inv;
            const v4u a = *(const v4u*)(OG + ((size_t)0 * S + t) * AOW + 8 * lane), b = *(const v4u*)(OG + ((size_t)1 * S + t) * AOW + 8 * lane), c = *(const v4u*)(OG + ((size_t)2 * S + t) * AOW + 8 * lane);
            v4u o;
            o.x = pk2(e0 * bflo(a.x) + e1 * bflo(b.x) + e2 * bflo(c.x), e0 * bfhi(a.x) + e1 * bfhi(b.x) + e2 * bfhi(c.x));
            o.y = pk2(e0 * bflo(a.y) + e1 * bflo(b.y) + e2 * bflo(c.y), e0 * bfhi(a.y) + e1 * bfhi(b.y) + e2 * bfhi(c.y));
            o.z = pk2(e0 * bflo(a.z) + e1 * bflo(b.z) + e2 * bflo(c.z), e0 * bfhi(a.z) + e1 * bfhi(b.z) + e2 * bfhi(c.z));
            o.w = pk2(e0 * bflo(a.w) + e1 * bflo(b.w) + e2 * bflo(c.w), e0 * bfhi(a.w) + e1 * bfhi(b.w) + e2 * bfhi(c.w));
            *(v4u*)(ATTN + (size_t)t * AOW + 8 * lane) = o; }
        pg8::Gemm g{DPOOL, MIX, PW, PW, S, PW, PW, 0}; pg8::StaticOrder So; So.init(S, PW, G, bx);
        EpiBf16 E{POOL, PW, pool_scale};
        pg8::gemm_phase<EpiBf16>(lds, g, So, E);
    }
    SEAM(4);
    if (IN(5)) {
        pg8::StaticOrder So; So.init(S, D, G, bx);
        { pg8::Gemm g{ATTN, WAB, AOW, AOW, S, D, AOW, 0}; EpiGate E{MERGED, GA, 0}; pg8::gemm_phase<EpiGate>(lds, g, So, E); }
        { pg8::Gemm g{POOL, WPB, PW, PW, S, D, PW, 0}; EpiGate E{MERGED, GB, 1}; pg8::gemm_phase<EpiGate>(lds, g, So, E); }
    }
    SEAM(5);
    if (IN(6)) {
        pg8::Gemm g{MERGED, WOUT, D, D, S, D, D, 0}; pg8::StaticOrder So; So.init(S, D, G, bx);
        EpiResid E{H, x, gate1};
        pg8::gemm_phase<EpiResid>(lds, g, So, E);
    }
    SEAM(6);
    if (IN(7)) { for (int m = gw; m < S; m += NGW) rmsmod_row(H + (size_t)m * D, norm2_g, scale2, shift2, XN + (size_t)m * D, lane); }
    SEAM(7);
    if (IN(8)) {
        pg8::Gemm g{XN, WQ, D, D, S, D, D, 0}; pg8::StaticOrder So; So.init(S, D, G, bx);
        EpiBf16 E{PQ, D, nullptr};
        pg8::gemm_phase<EpiBf16>(lds, g, So, E);
    }
    SEAM(8);
    if (IN(9)) {
        pg8::Gemm g{PQ, KEYS, D, 256, S, D, 256, 256}; pg8::StaticOrder So; So.init(S, D, G, bx);
        EpiF32 E{SC, D};
        pg8::gemm_phase<EpiF32>(lds, g, So, E);
    }
    SEAM(9);
    if (IN(10)) {
        LAS int* eid = (LAS int*)(lds + wave * 1024); LAS float* gt = (LAS float*)(lds + wave * 1024 + 512);
        for (int t = gw; t < S; t += NGW) {
            for (int h = 0; h < PH; ++h) topk_head(SC + (size_t)t * D + h * 256, lane, eid + h * PK, gt + h * PK);
            LDS_WAIT(); asm volatile("" ::: "memory");
            float xv[4][8];
#pragma unroll
            for (int j = 0; j < 4; ++j) { const v4u p = *(const v4u*)(XN + (size_t)t * D + 512 * j + 8 * lane);
                xv[j][0] = bflo(p.x); xv[j][1] = bfhi(p.x); xv[j][2] = bflo(p.y); xv[j][3] = bfhi(p.y); xv[j][4] = bflo(p.z); xv[j][5] = bfhi(p.z); xv[j][6] = bflo(p.w); xv[j][7] = bfhi(p.w); }
            float acc[4][8];
#pragma unroll
            for (int j = 0; j < 4; ++j)
#pragma unroll
                for (int e = 0; e < 8; ++e) acc[j][e] = 0.f;
            for (int k = 0; k < 128; ++k) {
                const int ex = eid[k]; const float gk = gt[k];
                const bf16* dr = DOWN + (size_t)ex * D + 8 * lane; float d = 0.f;
#pragma unroll
                for (int j = 0; j < 4; ++j) { const v4u p = *(const v4u*)(dr + 512 * j);
                    d += bflo(p.x) * xv[j][0] + bfhi(p.x) * xv[j][1] + bflo(p.y) * xv[j][2] + bfhi(p.y) * xv[j][3] + bflo(p.z) * xv[j][4] + bfhi(p.z) * xv[j][5] + bflo(p.w) * xv[j][6] + bfhi(p.w) * xv[j][7]; }
                d = wave_sum(d);
                const float a = 0.5f * d * (1.0f + erff(d * 0.70710678118654752f)) * gk;
                const bf16* ur = UP + (size_t)ex * D + 8 * lane;
#pragma unroll
                for (int j = 0; j < 4; ++j) { const v4u p = *(const v4u*)(ur + 512 * j);
                    acc[j][0] += a * bflo(p.x); acc[j][1] += a * bfhi(p.x); acc[j][2] += a * bflo(p.y); acc[j][3] += a * bfhi(p.y); acc[j][4] += a * bflo(p.z); acc[j][5] += a * bfhi(p.z); acc[j][6] += a * bflo(p.w); acc[j][7] += a * bfhi(p.w); }
            }
            float ss = 0.f;
#pragma unroll
            for (int j = 0; j < 4; ++j) { const int c0 = 512 * j + 8 * lane;
#pragma unroll
                for (int hf = 0; hf < 2; ++hf) { const f32x4 hh = *(const f32x4*)(H + (size_t)t * D + c0 + 4 * hf), g2 = *(const f32x4*)(gate2 + c0 + 4 * hf);
#pragma unroll
                    for (int e = 0; e < 4; ++e) { const float v = hh[e] + g2[e] * acc[j][4 * hf + e]; acc[j][4 * hf + e] = v; ss += v * v; } } }
            const float rr = 1.0f / sqrtf(wave_sum(ss) * (1.f / D) + EPS);
#pragma unroll
            for (int j = 0; j < 4; ++j) { const int c0 = 512 * j + 8 * lane;
#pragma unroll
                for (int hf = 0; hf < 2; ++hf) { const f32x4 fg = *(const f32x4*)(final_g + c0 + 4 * hf); f32x4 o;
#pragma unroll
                    for (int e = 0; e < 4; ++e) o[e] = acc[j][4 * hf + e] * rr * fg[e];
                    *(f32x4*)(out + (size_t)t * D + c0 + 4 * hf) = o; } }
            LDS_WAIT(); asm volatile("" ::: "memory");
        }
    }
#undef IN
#undef SEAM
}

extern "C" void kernel_launch(void* const* d_in, const int* in_sizes, int n_in, void* d_out, int out_size, void* d_ws, size_t ws_size, hipStream_t stream) {
    static int grid = 0;
    if (grid == 0) {
        if (n_in != 17 || out_size != S * D || ws_size < WS_END) { fprintf(stderr, "kernel_launch: unexpected shapes (n_in %d, out %d, ws %zu); nothing launched\n", n_in, out_size, ws_size); grid = -1; return; }
        int dev = 0, cus = 0, per_cu = 0;
        if (hipGetDevice(&dev) != hipSuccess || hipDeviceGetAttribute(&cus, hipDeviceAttributeMultiprocessorCount, dev) != hipSuccess) { grid = -1; return; }
        if (hipFuncSetAttribute((const void*)mk_fwd, hipFuncAttributeMaxDynamicSharedMemorySize, LDS_BYTES) != hipSuccess) { fprintf(stderr, "kernel_launch: hipFuncSetAttribute failed\n"); grid = -1; return; }
        if (hipOccupancyMaxActiveBlocksPerMultiprocessor(&per_cu, (const void*)mk_fwd, NWAVES * 64, LDS_BYTES) != hipSuccess || per_cu < 1) { fprintf(stderr, "kernel_launch: occupancy query says %d blocks per CU\n", per_cu); per_cu = 1; }
        (void)hipGetLastError();
        grid = cus;
    }
    if (grid < 0) return;
    (void)hipMemsetAsync((char*)d_ws + WS_CTL, 0, CTL_ZERO_BYTES, stream);
    Args a{};
    for (int i = 0; i < 17; ++i) a.in[i] = (const float*)d_in[i];
    a.out = (float*)d_out; a.ws = (unsigned char*)d_ws;
    if (MK_N_LAUNCHES == 1) {
        a.ph_lo = 0; a.ph_hi = N_PHASES; a.li = 0;
        void* kargs[] = {&a};
        hipError_t e = hipLaunchCooperativeKernel((const void*)mk_fwd, dim3(grid), dim3(NWAVES * 64), kargs, LDS_BYTES, stream);
        if (e != hipSuccess) fprintf(stderr, "kernel_launch: cooperative launch failed: %s (grid %d)\n", hipGetErrorString(e), grid);
    } else {
        for (int li = 0; li < N_PHASES; ++li) { a.ph_lo = li; a.ph_hi = li + 1; a.li = li; hipLaunchKernelGGL(mk_fwd, dim3(grid), dim3(NWAVES * 64), LDS_BYTES, stream, a); }
    }
}
```

```cpp
#include <hip/hip_runtime.h>
#include <cstdio>
#include <cstdint>
#include <cmath>

#ifndef MK_N_LAUNCHES
#define MK_N_LAUNCHES 1
#endif
constexpr int N_PHASES = 11;
#ifndef PROBE_PHASE
#define PROBE_PHASE -1
#endif
#define REP(k) for (int _rep = 0; _rep < ((PROBE_PHASE == (k)) ? 2 : 1); ++_rep)

namespace pg8 {
#define PG8_LAS __attribute__((address_space(3)))
typedef unsigned short bf16_t;
typedef short bf16x8 __attribute__((ext_vector_type(8)));
typedef float f32x4 __attribute__((ext_vector_type(4)));
typedef unsigned u32x4 __attribute__((ext_vector_type(4)));
constexpr int BM = 256, BK = 64, HALF = 128, HTB = HALF * BK * 2, STAGE_BYTES = 8 * HTB, NXCD = 8, WGM = 8;

__host__ __device__ __forceinline__ int lds_byte(int r, int c) { const int st = (r >> 4) * 2 + (c >> 5), rr = r & 15, cc = c & 31, ob = rr * 64 + cc * 2; return st * 1024 + (ob ^ (((ob >> 9) & 1) << 5)); }
__host__ __device__ __forceinline__ void stage_rc(int b, int& R, int& C) { const int st = b / 1024, sb = b % 1024, swz = sb ^ (((sb >> 9) & 1) << 5); R = (st >> 1) * 16 + swz / 64; C = (st & 1) * 32 + (swz % 64) / 2; }
__host__ __device__ __forceinline__ int perm32(int rho) { const int n = rho >> 4, i = rho & 15; return 8 * (i >> 2) + 4 * n + (i & 3); }

struct Unit { int pm, pn; };
struct Gemm { const bf16_t* A; const bf16_t* Bt; int lda, ldb, M, N, K; int acol_per_pn; };

struct StaticOrder {
    int nM, nN, nwg, G, c;
    __host__ __device__ void init(int M, int N, int G_, int c_) { nM = M / BM; nN = N / BM; nwg = nM * nN; G = G_; c = c_; }
    __host__ __device__ bool next(int i, Unit& u) const {
        const long L = (long)i * G + c; if (L >= nwg) return false;
        int wgid = (int)L; { const int q = nwg / NXCD, r = nwg % NXCD, xcd = wgid % NXCD, off = wgid / NXCD; wgid = (xcd < r ? xcd * (q + 1) : r * (q + 1) + (xcd - r) * q) + off; }
        const int nig = WGM * nN, gid = wgid / nig, fm = gid * WGM, gsz = (nM - fm) < WGM ? (nM - fm) : WGM;
        u.pm = fm + ((wgid % nig) % gsz); u.pn = (wgid % nig) / gsz; return true;
    }
};

template <class Epi>
__device__ __forceinline__ void gemm_phase(PG8_LAS unsigned char* lds, const Gemm g, const StaticOrder& S, const Epi& E) {
    const int tid = threadIdx.x, wid = __builtin_amdgcn_readfirstlane(tid >> 6), lane = tid & 63, wr = wid >> 2, wc = wid & 3, fr = lane & 15, fq = lane >> 4;
    const int K = g.K, nt = K / BK;
    unsigned voffA[2], voffB[2];
#pragma unroll
    for (int i = 0; i < 2; ++i) { int R, C; stage_rc(tid * 16 + i * 8192, R, C); const int Rb = Epi::PERM ? ((R & ~31) + perm32(R & 31)) : R;
        voffA[i] = (unsigned)(R * g.lda + C) * 2u; voffB[i] = (unsigned)(Rb * g.ldb + C) * 2u; }
    const size_t kstep = (size_t)(BK * 2);
    const size_t hstepA = (size_t)HALF * g.lda * 2, hstepB = (size_t)HALF * g.ldb * 2;
    const size_t tstepA = 2 * hstepA, tstepB = 2 * hstepB, cstepA = (size_t)g.acol_per_pn * 2;
    const unsigned ldsw = (unsigned)wid * 1024u;
    const int aoff = lds_byte(wr * 64 + fr, fq * 8), boff = lds_byte(wc * 32 + fr, fq * 8);
#define PG8_SA(b, h) (((b) * 2 + (h)) * HTB)
#define PG8_SB(b, h) ((4 + (b) * 2 + (h)) * HTB)
#define PG8_STAGE(bufoff, gbase, voff) do { _Pragma("unroll") for (int _i = 0; _i < 2; ++_i) \
        __builtin_amdgcn_global_load_lds((const unsigned*)((const char*)(gbase) + (voff)[_i]), (PG8_LAS unsigned*)(lds + (bufoff) + ldsw + _i * 8192), 16, 0, 0); } while (0)
#define PG8_LDA(dst, b, h) do { _Pragma("unroll") for (int m = 0; m < 4; ++m) _Pragma("unroll") for (int k = 0; k < 2; ++k) dst[m][k] = *(const PG8_LAS bf16x8*)(lds + PG8_SA(b, h) + aoff + m * 2048 + k * 1024); } while (0)
#define PG8_LDB(dst, b, h) do { _Pragma("unroll") for (int n = 0; n < 2; ++n) _Pragma("unroll") for (int k = 0; k < 2; ++k) dst[n][k] = *(const PG8_LAS bf16x8*)(lds + PG8_SB(b, h) + boff + n * 2048 + k * 1024); } while (0)
#define PG8_MMA(ai, bj, At, Bt) do { __builtin_amdgcn_s_setprio(1); _Pragma("unroll") for (int m = 0; m < 4; ++m) _Pragma("unroll") for (int n = 0; n < 2; ++n) _Pragma("unroll") for (int k = 0; k < 2; ++k) \
        acc[ai][bj][m][n] = __builtin_amdgcn_mfma_f32_16x16x32_bf16(Bt[n][k], At[m][k], acc[ai][bj][m][n], 0, 0, 0); __builtin_amdgcn_s_setprio(0); } while (0)
#define PG8_WAIT_V(n) asm volatile("s_waitcnt vmcnt(" #n ")" ::: "memory")
#define PG8_WAIT_L(n) asm volatile("s_waitcnt lgkmcnt(" #n ")" ::: "memory")
#define PG8_BAR __builtin_amdgcn_s_barrier()
#define PG8_SCHED __builtin_amdgcn_sched_barrier(0)
    Unit cur, nxt; int ui = 0;
    if (!S.next(0, cur)) return;
    f32x4 acc[2][2][4][2];
#pragma unroll
    for (int a = 0; a < 2; ++a)
#pragma unroll
        for (int b = 0; b < 2; ++b)
#pragma unroll
            for (int m = 0; m < 4; ++m)
#pragma unroll
                for (int n = 0; n < 2; ++n) acc[a][b][m][n] = (f32x4){0.f, 0.f, 0.f, 0.f};
    bf16x8 At[4][2], B0[2][2], B1[2][2];
    const char* cA = (const char*)g.A + (size_t)cur.pm * tstepA + (size_t)cur.pn * cstepA; const char* cB = (const char*)g.Bt + (size_t)cur.pn * tstepB;
    PG8_STAGE(PG8_SB(0, 0), cB, voffB); PG8_STAGE(PG8_SB(0, 1), cB + hstepB, voffB); PG8_STAGE(PG8_SA(0, 0), cA, voffA); PG8_STAGE(PG8_SA(0, 1), cA + hstepA, voffA);
    if (wr == 1) PG8_BAR;
    PG8_WAIT_V(2); PG8_BAR;
    PG8_STAGE(PG8_SB(1, 0), cB + kstep, voffB); PG8_STAGE(PG8_SA(1, 0), cA + kstep, voffA); PG8_STAGE(PG8_SB(1, 1), cB + hstepB + kstep, voffB);
    PG8_WAIT_V(6); PG8_BAR;
    for (;;) {
        const bool has_next = S.next(ui + 1, nxt);
        const char* nA = has_next ? (const char*)g.A + (size_t)nxt.pm * tstepA + (size_t)nxt.pn * cstepA : cA; const char* nB = has_next ? (const char*)g.Bt + (size_t)nxt.pn * tstepB : cB;
        for (int t = 0; t < nt; t += 2) {
            const bool last = (t == nt - 2);
            const char* a1 = cA + (size_t)(t + 1) * kstep;
            const char* a2 = last ? nA : cA + (size_t)(t + 2) * kstep; const char* b2 = last ? nB : cB + (size_t)(t + 2) * kstep;
            const char* a3 = a2 + kstep; const char* b3 = b2 + kstep;
            PG8_LDB(B0, 0, 0); PG8_LDB(B1, 0, 1); PG8_SCHED; PG8_LDA(At, 0, 0); PG8_STAGE(PG8_SA(1, 1), a1 + hstepA, voffA);
            PG8_WAIT_V(8); PG8_WAIT_L(0); PG8_BAR; PG8_MMA(0, 0, At, B0); PG8_MMA(0, 1, At, B1); PG8_BAR; PG8_SCHED;
            PG8_LDA(At, 0, 1); PG8_STAGE(PG8_SB(0, 0), b2, voffB); PG8_STAGE(PG8_SB(0, 1), b2 + hstepB, voffB); PG8_STAGE(PG8_SA(0, 0), a2, voffA);
            PG8_WAIT_V(8); PG8_WAIT_L(0); PG8_BAR; PG8_MMA(1, 0, At, B0); PG8_MMA(1, 1, At, B1); PG8_BAR; PG8_SCHED;
            PG8_LDB(B0, 1, 0); PG8_LDB(B1, 1, 1); PG8_SCHED; PG8_LDA(At, 1, 0); PG8_STAGE(PG8_SA(0, 1), a2 + hstepA, voffA);
            PG8_WAIT_V(8); PG8_WAIT_L(0); PG8_BAR; PG8_MMA(0, 0, At, B0); PG8_MMA(0, 1, At, B1); PG8_BAR; PG8_SCHED;
            PG8_LDA(At, 1, 1); PG8_STAGE(PG8_SB(1, 0), b3, voffB); PG8_STAGE(PG8_SB(1, 1), b3 + hstepB, voffB); PG8_STAGE(PG8_SA(1, 0), a3, voffA);
            PG8_WAIT_V(8); PG8_WAIT_L(0); PG8_BAR; PG8_MMA(1, 0, At, B0); PG8_MMA(1, 1, At, B1); PG8_BAR; PG8_SCHED;
        }
        if (wr == 0) PG8_BAR;
        E(acc, cur, wr, wc, fr, fq);
        if (!has_next) break;
#pragma unroll
        for (int a = 0; a < 2; ++a)
#pragma unroll
            for (int b = 0; b < 2; ++b)
#pragma unroll
                for (int m = 0; m < 4; ++m)
#pragma unroll
                    for (int n = 0; n < 2; ++n) acc[a][b][m][n] = (f32x4){0.f, 0.f, 0.f, 0.f};
        cur = nxt; cA = nA; cB = nB; ++ui;
        if (wr == 1) PG8_BAR;
    }
    PG8_WAIT_V(0);
    PG8_BAR;
#undef PG8_SA
#undef PG8_SB
#undef PG8_STAGE
#undef PG8_LDA
#undef PG8_LDB
#undef PG8_MMA
#undef PG8_WAIT_V
#undef PG8_WAIT_L
#undef PG8_BAR
#undef PG8_SCHED
}
}

constexpr int S = 16384, D = 2048, AW = 1536, NH = 12, HD = 128, AOW = 512, PW = 512, INW = 9216;
constexpr int PH = 8, PK = 16, NKEY = 128;
constexpr float EPS = 1e-6f;
constexpr float QSCALE = 0.08838834764831845f * 1.4426950408889634f;
constexpr int NWAVES = 8;

constexpr size_t MiB = 1u << 20;
constexpr size_t WS_CTL = 0, CTL_ZERO_BYTES = 1 * MiB;
constexpr size_t WS_MOD = 512 * 1024;
constexpr size_t WS_INVF = 1 * MiB;
constexpr size_t WS_DSC = 1 * MiB + 65536, WS_USC = 1 * MiB + 131072;
constexpr size_t WS_WAB = 2 * MiB, WS_WPB = 4 * MiB, WS_MIX = 6 * MiB, WS_KEYS = 7 * MiB, WS_WOUT = 8 * MiB, WS_WQ = 16 * MiB, WS_WIN = 24 * MiB;
constexpr size_t WS_DOWN = 60 * MiB, WS_UP = 124 * MiB;
constexpr size_t WS_XN = 188 * MiB;
constexpr size_t WS_OG = 188 * MiB, WS_LSE = 236 * MiB;
constexpr size_t WS_Q = 252 * MiB, WS_K = 300 * MiB, WS_V = 348 * MiB, WS_PIN = 396 * MiB, WS_GA = 412 * MiB, WS_GB = 476 * MiB;
constexpr size_t WS_DPOOL = 24 * MiB, WS_ATTN = 40 * MiB;
constexpr size_t WS_POOL = 252 * MiB;
constexpr size_t WS_MERGED = 300 * MiB;
constexpr size_t WS_PQ = 412 * MiB;
constexpr size_t WS_SC = 252 * MiB;
constexpr size_t WS_END = 540 * MiB;
constexpr int CW_BAR = 4096;

constexpr int RING_BYTES = 147456;
constexpr int LDSCTL_OFF = RING_BYTES, MISC_OFF = LDSCTL_OFF + 320;
constexpr int LDS_BYTES = RING_BYTES + 1024;

#define GAS __attribute__((address_space(1)))
#define LAS __attribute__((address_space(3)))
typedef unsigned short bf16;
typedef unsigned v4u __attribute__((ext_vector_type(4)));
typedef unsigned v2u __attribute__((ext_vector_type(2)));
typedef float f32x4 __attribute__((ext_vector_type(4)));
typedef float f32x2 __attribute__((ext_vector_type(2)));
typedef short bf16x8 __attribute__((ext_vector_type(8)));
typedef short s16x4 __attribute__((ext_vector_type(4)));
typedef __bf16 bf16x2_t __attribute__((ext_vector_type(2)));
#define LDS_WAIT() asm volatile("s_waitcnt lgkmcnt(0)" ::: "memory")
#define VM_WAIT() asm volatile("s_waitcnt vmcnt(0)" ::: "memory")
__device__ __forceinline__ unsigned pk2(float lo, float hi) { f32x2 v = {lo, hi}; bf16x2_t b = __builtin_convertvector(v, bf16x2_t); return __builtin_bit_cast(unsigned, b); }
__device__ __forceinline__ float bflo(unsigned u) { return __uint_as_float(u << 16); }
__device__ __forceinline__ float bfhi(unsigned u) { return __uint_as_float(u & 0xffff0000u); }
__device__ __forceinline__ float wave_sum(float v) {
#pragma unroll
    for (int o = 1; o < 64; o <<= 1) v += __shfl_xor(v, o);
    return v;
}

#define XB_TMO      128
#define XB_XCNT(j)  (256  + 64 * (j))
#define XB_XSUB(j)  (1280 + 64 * (j))
#define XB_XGEN(j)  (2304 + 64 * (j))
#define XB_TOP      3328
#define XB_TOPGEN   3392
#define XCD_BAR_WORDS 3456
#define XB_SPIN_CAP (1u << 22)
__device__ __forceinline__ unsigned xb_ld(unsigned* p)              { return __hip_atomic_load(p, __ATOMIC_RELAXED, __HIP_MEMORY_SCOPE_AGENT); }
__device__ __forceinline__ unsigned xb_add(unsigned* p, unsigned v) { return __hip_atomic_fetch_add(p, v, __ATOMIC_RELAXED, __HIP_MEMORY_SCOPE_AGENT); }
__device__ __forceinline__ unsigned xb_xcc_id() { return (unsigned)__builtin_amdgcn_s_getreg((3 << 11) | 20) & 0xFu; }
#define XB_SPIN(cond, bar) do { unsigned _sp = 0; while (cond) { __builtin_amdgcn_s_sleep(1); \
    if ((++_sp & 255u) == 0u) { if (xb_ld(&(bar)[XB_TMO])) break; if (_sp > XB_SPIN_CAP) { atomicAdd(&(bar)[XB_TMO], 1u); break; } } } } while (0)
struct XcdBarrier { unsigned* bar; unsigned x; volatile LAS unsigned* st; };
__device__ __forceinline__ XcdBarrier xcd_barrier_post(unsigned* bar, volatile LAS unsigned* st) {
    XcdBarrier b; b.bar = bar; b.x = xb_xcc_id(); b.st = st;
    if (threadIdx.x == 0) (void)xb_add(&bar[XB_XCNT(b.x)], 1u);
    return b;
}
__device__ __forceinline__ void xcd_barrier_complete(unsigned* bar, unsigned x, unsigned& nloc, unsigned& nx) {
    const unsigned G = gridDim.x * gridDim.y * gridDim.z;
    unsigned sum, cnt, mine, sp = 0u;
    for (;;) {
        sum = 0u; cnt = 0u; mine = 0u;
#pragma unroll
        for (unsigned j = 0; j < 16; ++j) { const unsigned c = xb_ld(&bar[XB_XCNT(j)]); sum += c; cnt += (c > 0u) ? 1u : 0u; mine = (j == x) ? c : mine; }
        if (sum == G) break;
        __builtin_amdgcn_s_sleep(1);
        if ((++sp & 255u) == 0u) { if (xb_ld(&bar[XB_TMO])) break; if (sp > XB_SPIN_CAP) { atomicAdd(&bar[XB_TMO], 1u); break; } }
    }
    nloc = mine > 0u ? mine : 1u; nx = cnt > 0u ? cnt : 1u;
}
__device__ __forceinline__ void xcd_barrier(const XcdBarrier& b) {
    asm volatile("s_waitcnt vmcnt(0)" ::: "memory");
    __syncthreads();
    if (threadIdx.x == 0) {
        unsigned* bar = b.bar;
        __builtin_amdgcn_s_waitcnt(0);
        unsigned nloc = b.st[0], nx = b.st[1];
        if (nloc == 0u) { xcd_barrier_complete(bar, b.x, nloc, nx); b.st[0] = nloc; b.st[1] = nx; }
        const unsigned old = xb_add(&bar[XB_XSUB(b.x)], 1u);
        const unsigned gen = old / nloc;
        if (old + 1u == (gen + 1u) * nloc) {
            __builtin_amdgcn_fence(__ATOMIC_RELEASE, "agent");
            asm volatile("s_waitcnt vmcnt(0)" ::: "memory");
            const unsigned og = xb_add(&bar[XB_TOP], 1u);
            const unsigned tg = og / nx;
            if (og + 1u == (tg + 1u) * nx) xb_add(&bar[XB_TOPGEN], 1u);
            else XB_SPIN(xb_ld(&bar[XB_TOPGEN]) == tg, bar);
            __builtin_amdgcn_fence(__ATOMIC_ACQUIRE, "agent");
            xb_add(&bar[XB_XGEN(b.x)], 1u);
            asm volatile("s_waitcnt vmcnt(0)" ::: "memory");
        } else {
            XB_SPIN(xb_ld(&bar[XB_XGEN(b.x)]) == gen, bar);
            __builtin_amdgcn_fence(__ATOMIC_ACQUIRE, "agent");
            asm volatile("s_waitcnt vmcnt(0)" ::: "memory");
        }
    }
    __syncthreads();
}

using pg8::Unit;
__device__ __forceinline__ v4u pack8(const f32x4 a, const f32x4 b) { v4u w; w.x = pk2(a[0], a[1]); w.y = pk2(a[2], a[3]); w.z = pk2(b[0], b[1]); w.w = pk2(b[2], b[3]); return w; }

struct EpiInProj {
    static constexpr bool PERM = true;
    bf16 *Q, *K, *V, *PIN, *GA, *GB; const float* invf;
    __device__ __forceinline__ void operator()(const f32x4 (&acc)[2][2][4][2], const Unit& u, int wr, int wc, int fr, int fq) const {
        const int pn = u.pn, row0 = u.pm * 256 + wr * 64 + fr, cl = wc * 32 + 8 * fq;
        if (pn < 12) {
            bf16* base = pn < 6 ? Q : K; const int ct = (pn < 6 ? pn : pn - 6) * 256; const float qs = pn < 6 ? QSCALE : 1.0f;
            float inv[4];
#pragma unroll
            for (int i = 0; i < 4; ++i) inv[i] = invf[(cl >> 1) + i];
#pragma unroll
            for (int ai = 0; ai < 2; ++ai)
#pragma unroll
                for (int m = 0; m < 4; ++m) {
                    const int row = row0 + ai * 128 + m * 16;
                    float cs[4], sn[4];
#pragma unroll
                    for (int i = 0; i < 4; ++i) { const float ang = (float)row * inv[i]; double rev = (double)ang * 0.15915494309189533577; rev -= rint(rev);
                        sn[i] = __builtin_amdgcn_sinf((float)rev) * qs; cs[i] = __builtin_amdgcn_cosf((float)rev) * qs; }
#pragma unroll
                    for (int bj = 0; bj < 2; ++bj) {
                        const f32x4 v0 = acc[ai][bj][m][0], v1 = acc[ai][bj][m][1]; f32x4 o0, o1;
                        o0[0] = v0[0] * cs[0] - v0[1] * sn[0]; o0[1] = v0[1] * cs[0] + v0[0] * sn[0]; o0[2] = v0[2] * cs[1] - v0[3] * sn[1]; o0[3] = v0[3] * cs[1] + v0[2] * sn[1];
                        o1[0] = v1[0] * cs[2] - v1[1] * sn[2]; o1[1] = v1[1] * cs[2] + v1[0] * sn[2]; o1[2] = v1[2] * cs[3] - v1[3] * sn[3]; o1[3] = v1[3] * cs[3] + v1[2] * sn[3];
                        *(v4u*)(base + (size_t)row * AW + ct + bj * 128 + cl) = pack8(o0, o1);
                    }
                }
        } else if (pn < 20) {
            bf16* base = pn < 18 ? V : PIN; const int ct = (pn < 18 ? pn - 12 : pn - 18) * 256; const int ld = pn < 18 ? AW : PW;
#pragma unroll
            for (int ai = 0; ai < 2; ++ai)
#pragma unroll
                for (int m = 0; m < 4; ++m) { const int row = row0 + ai * 128 + m * 16;
#pragma unroll
                    for (int bj = 0; bj < 2; ++bj) *(v4u*)(base + (size_t)row * ld + ct + bj * 128 + cl) = pack8(acc[ai][bj][m][0], acc[ai][bj][m][1]); }
        } else {
            bf16* base = pn < 28 ? GA : GB; const int ct = (pn < 28 ? pn - 20 : pn - 28) * 256;
#pragma unroll
            for (int ai = 0; ai < 2; ++ai)
#pragma unroll
                for (int m = 0; m < 4; ++m) { const int row = row0 + ai * 128 + m * 16;
#pragma unroll
                    for (int bj = 0; bj < 2; ++bj) { f32x4 a = acc[ai][bj][m][0], b = acc[ai][bj][m][1];
#pragma unroll
                        for (int e = 0; e < 4; ++e) { a[e] = __builtin_amdgcn_rcpf(1.0f + __expf(-a[e])); b[e] = __builtin_amdgcn_rcpf(1.0f + __expf(-b[e])); }
                        *(v4u*)(base + (size_t)row * D + ct + bj * 128 + cl) = pack8(a, b); } }
        }
    }
};
struct EpiBf16 {
    static constexpr bool PERM = true;
    bf16* O; int ld; const float* colscale;
    __device__ __forceinline__ void operator()(const f32x4 (&acc)[2][2][4][2], const Unit& u, int wr, int wc, int fr, int fq) const {
        const int row0 = u.pm * 256 + wr * 64 + fr, col0 = u.pn * 256 + wc * 32 + 8 * fq;
        f32x4 s[2][2];
#pragma unroll
        for (int bj = 0; bj < 2; ++bj)
#pragma unroll
            for (int n = 0; n < 2; ++n) s[bj][n] = colscale ? *(const f32x4*)(colscale + col0 + bj * 128 + 4 * n) : (f32x4){1.f, 1.f, 1.f, 1.f};
#pragma unroll
        for (int ai = 0; ai < 2; ++ai)
#pragma unroll
            for (int m = 0; m < 4; ++m) { const int row = row0 + ai * 128 + m * 16;
#pragma unroll
                for (int bj = 0; bj < 2; ++bj) *(v4u*)(O + (size_t)row * ld + col0 + bj * 128) = pack8(acc[ai][bj][m][0] * s[bj][0], acc[ai][bj][m][1] * s[bj][1]); }
    }
};
struct EpiGate {
    static constexpr bool PERM = true;
    bf16* O; const bf16* G; int accum;
    __device__ __forceinline__ void operator()(const f32x4 (&acc)[2][2][4][2], const Unit& u, int wr, int wc, int fr, int fq) const {
        const int row0 = u.pm * 256 + wr * 64 + fr, col0 = u.pn * 256 + wc * 32 + 8 * fq;
#pragma unroll
        for (int ai = 0; ai < 2; ++ai)
#pragma unroll
            for (int m = 0; m < 4; ++m) { const int row = row0 + ai * 128 + m * 16;
#pragma unroll
                for (int bj = 0; bj < 2; ++bj) { const size_t off = (size_t)row * D + col0 + bj * 128;
                    const v4u g = *(const v4u*)(G + off); f32x4 a = acc[ai][bj][m][0], b = acc[ai][bj][m][1];
                    a[0] *= bflo(g.x); a[1] *= bfhi(g.x); a[2] *= bflo(g.y); a[3] *= bfhi(g.y); b[0] *= bflo(g.z); b[1] *= bfhi(g.z); b[2] *= bflo(g.w); b[3] *= bfhi(g.w);
                    if (accum) { const v4u p = *(const v4u*)(O + off);
                        a[0] += bflo(p.x); a[1] += bfhi(p.x); a[2] += bflo(p.y); a[3] += bfhi(p.y); b[0] += bflo(p.z); b[1] += bfhi(p.z); b[2] += bflo(p.w); b[3] += bfhi(p.w); }
                    *(v4u*)(O + off) = pack8(a, b); } }
    }
};
struct EpiResid {
    static constexpr bool PERM = false;
    float* H; const float* x; const float* gate;
    __device__ __forceinline__ void operator()(const f32x4 (&acc)[2][2][4][2], const Unit& u, int wr, int wc, int fr, int fq) const {
        const int row0 = u.pm * 256 + wr * 64 + fr, col0 = u.pn * 256 + wc * 32 + 4 * fq;
#pragma unroll
        for (int ai = 0; ai < 2; ++ai)
#pragma unroll
            for (int m = 0; m < 4; ++m) { const int row = row0 + ai * 128 + m * 16;
#pragma unroll
                for (int bj = 0; bj < 2; ++bj)
#pragma unroll
                    for (int n = 0; n < 2; ++n) { const int col = col0 + bj * 128 + n * 16; const size_t off = (size_t)row * D + col;
                        const f32x4 g = *(const f32x4*)(gate + col), xx = *(const f32x4*)(x + off); *(f32x4*)(H + off) = xx + g * acc[ai][bj][m][n]; } }
    }
};
struct EpiF32 {
    static constexpr bool PERM = false;
    float* O; int ld;
    __device__ __forceinline__ void operator()(const f32x4 (&acc)[2][2][4][2], const Unit& u, int wr, int wc, int fr, int fq) const {
        const int row0 = u.pm * 256 + wr * 64 + fr, col0 = u.pn * 256 + wc * 32 + 4 * fq;
#pragma unroll
        for (int ai = 0; ai < 2; ++ai)
#pragma unroll
            for (int m = 0; m < 4; ++m) { const int row = row0 + ai * 128 + m * 16;
#pragma unroll
                for (int bj = 0; bj < 2; ++bj)
#pragma unroll
                    for (int n = 0; n < 2; ++n) *(f32x4*)(O + (size_t)row * ld + col0 + bj * 128 + n * 16) = acc[ai][bj][m][n]; }
    }
};

__device__ __forceinline__ void p0_transpose_item(const float* W, int K, int N, bf16* WT, bool ropeperm, LAS float* scr, int item, int lane) {
    const int nblk = N / 32, kb = item / nblk, nb = item % nblk, k0 = 64 * kb, n0 = 32 * nb;
#pragma unroll 8
    for (int i = 0; i < 32; ++i) { const int kk = 2 * i + (lane >> 5); scr[kk * 33 + (lane & 31)] = W[(size_t)(k0 + kk) * N + n0 + (lane & 31)]; }
    LDS_WAIT(); asm volatile("" ::: "memory");
    const int c = lane & 7;
#pragma unroll
    for (int j = 0; j < 4; ++j) { const int n = (lane >> 3) + 8 * j; const LAS float* s = scr + (8 * c) * 33 + n;
        v4u o; o.x = pk2(s[0 * 33], s[1 * 33]); o.y = pk2(s[2 * 33], s[3 * 33]); o.z = pk2(s[4 * 33], s[5 * 33]); o.w = pk2(s[6 * 33], s[7 * 33]);
        int rown = n0 + n; if (ropeperm && rown < 2 * AW) { const int d = rown & 127; rown = (rown & ~127) + 2 * (d & 63) + (d >> 6); }
        *(v4u*)(WT + (size_t)rown * K + k0 + 8 * c) = o; }
    LDS_WAIT(); asm volatile("" ::: "memory");
}
__device__ __forceinline__ void rmsmod_row(const float* xrow, const float* g, const float* scale, const float* shift, bf16* orow, int lane) {
    const f32x4* xr = (const f32x4*)xrow + lane;
    f32x4 v[8]; float s = 0.f;
#pragma unroll
    for (int j = 0; j < 8; ++j) { v[j] = xr[64 * j]; s += (v[j].x * v[j].x + v[j].y * v[j].y) + (v[j].z * v[j].z + v[j].w * v[j].w); }
    const float r = 1.0f / sqrtf(wave_sum(s) * (1.f / D) + EPS);
    v2u* o = (v2u*)orow + lane;
#pragma unroll
    for (int j = 0; j < 8; ++j) { const int c0 = 4 * lane + 256 * j;
        const f32x4 gg = *(const f32x4*)(g + c0), sc = *(const f32x4*)(scale + c0), sh = *(const f32x4*)(shift + c0);
        v2u w; w.x = pk2(v[j].x * r * gg.x * (1.f + sc.x) + sh.x, v[j].y * r * gg.y * (1.f + sc.y) + sh.y); w.y = pk2(v[j].z * r * gg.z * (1.f + sc.z) + sh.z, v[j].w * r * gg.w * (1.f + sc.w) + sh.w);
        o[64 * j] = w; }
}

constexpr int KV_STRIDE = 288;
constexpr int KV_TILE = 256 * KV_STRIDE;
typedef short v4i16_t __attribute__((ext_vector_type(4)));
__device__ __forceinline__ s16x4 vtr(LAS const unsigned char* p) { return __builtin_bit_cast(s16x4, __builtin_amdgcn_ds_read_tr16_b64_v4i16((LAS v4i16_t*)p)); }

__device__ __forceinline__ void attn_unit(LAS unsigned char* lds, int unit, const bf16* Q, const bf16* K, const bf16* V, bf16* OG, float* LSE) {
    const int tid = threadIdx.x, lane = tid & 63, w = __builtin_amdgcn_readfirstlane(tid >> 6), fr = lane & 15, fq = lane >> 4;
    const int g = unit >> 9, rem = unit & 511, j = rem & 3, blk = rem >> 2;
    const int dsh = 2 * g, dil = 1 << dsh;
    const int r = blk & (dil - 1), n = blk >> dsh, head = 4 * g + j;
    LAS unsigned char* Kl = lds; LAS unsigned char* Vl = lds + KV_TILE;
#pragma unroll
    for (int i = 0; i < 8; ++i) {
        const int idx = tid + 512 * i, kr = idx >> 4, ch = idx & 15; const int l = 128 * n - 128 + kr;
        v4u kv = {0u, 0u, 0u, 0u}, vv = {0u, 0u, 0u, 0u};
        if (l >= 0) { const size_t off = (size_t)((l << dsh) + r) * AW + head * HD + ch * 8; kv = *(const v4u*)(K + off); vv = *(const v4u*)(V + off); }
        *(LAS v4u*)(Kl + kr * KV_STRIDE + ch * 16) = kv; *(LAS v4u*)(Vl + kr * KV_STRIDE + ch * 16) = vv;
    }
    const int qpos = ((128 * n + 16 * w + fr) << dsh) + r;
    bf16x8 qf[4];
#pragma unroll
    for (int ks = 0; ks < 4; ++ks) qf[ks] = *(const bf16x8*)(Q + (size_t)qpos * AW + head * HD + 32 * ks + 8 * fq);
    __syncthreads();
    f32x4 st[9];
#pragma unroll
    for (int b = 0; b < 9; ++b) { st[b] = (f32x4){0.f, 0.f, 0.f, 0.f};
#pragma unroll
        for (int ks = 0; ks < 4; ++ks) { const bf16x8 kf = *(LAS const bf16x8*)(Kl + (16 * (w + b) + fr) * KV_STRIDE + 64 * ks + 16 * fq);
            st[b] = __builtin_amdgcn_mfma_f32_16x16x32_bf16(kf, qf[ks], st[b], 0, 0, 0); } }
    float mx = -INFINITY;
#pragma unroll
    for (int b = 0; b < 9; ++b)
#pragma unroll
        for (int e = 0; e < 4; ++e) { const int kk = 16 * b + 4 * fq + e;
            const bool ok = (kk >= fr) && (kk <= fr + 128) && (n > 0 || 16 * w + kk >= 128);
            st[b][e] = ok ? st[b][e] : -INFINITY; mx = fmaxf(mx, st[b][e]); }
    mx = fmaxf(mx, __shfl_xor(mx, 16)); mx = fmaxf(mx, __shfl_xor(mx, 32));
    float sm = 0.f;
#pragma unroll
    for (int b = 0; b < 9; ++b)
#pragma unroll
        for (int e = 0; e < 4; ++e) { const float p = __builtin_amdgcn_exp2f(st[b][e] - mx); st[b][e] = p; sm += p; }
    sm += __shfl_xor(sm, 16); sm += __shfl_xor(sm, 32);
    f32x4 o[8];
#pragma unroll
    for (int dt = 0; dt < 8; ++dt) o[dt] = (f32x4){0.f, 0.f, 0.f, 0.f};
    const int q4 = fr >> 2, p4 = fr & 3;
#pragma unroll
    for (int s = 0; s < 5; ++s) {
        bf16x8 pf; { const unsigned a = pk2(st[2 * s][0], st[2 * s][1]), b = pk2(st[2 * s][2], st[2 * s][3]);
            unsigned c = 0u, d = 0u; if (s < 4) { c = pk2(st[2 * s + 1][0], st[2 * s + 1][1]); d = pk2(st[2 * s + 1][2], st[2 * s + 1][3]); }
            const v4u t = {a, b, c, d}; pf = __builtin_bit_cast(bf16x8, t); }
        LAS const unsigned char* v0 = Vl + (16 * (w + 2 * s) + 4 * fq + q4) * KV_STRIDE + 8 * p4;
#pragma unroll
        for (int dt = 0; dt < 8; ++dt) {
            const s16x4 lo = vtr(v0 + 32 * dt); s16x4 hi = {0, 0, 0, 0}; if (s < 4) hi = vtr(v0 + 16 * KV_STRIDE + 32 * dt);
            const bf16x8 vf = {lo[0], lo[1], lo[2], lo[3], hi[0], hi[1], hi[2], hi[3]};
            o[dt] = __builtin_amdgcn_mfma_f32_16x16x32_bf16(vf, pf, o[dt], 0, 0, 0);
        }
    }
    const float inv = 1.0f / sm;
    bf16* orow = OG + ((size_t)g * S + qpos) * AOW + j * HD + 4 * fq;
#pragma unroll
    for (int dt = 0; dt < 8; ++dt) { v2u wv; wv.x = pk2(o[dt][0] * inv, o[dt][1] * inv); wv.y = pk2(o[dt][2] * inv, o[dt][3] * inv); *(v2u*)(orow + 16 * dt) = wv; }
    if (fq == 0) LSE[((size_t)g * S + qpos) * 4 + j] = mx * 0.6931471805599453f + __logf(sm);
    __syncthreads();
}

__device__ __forceinline__ unsigned okey(float f) { const unsigned u = __float_as_uint(f); return u ^ ((unsigned)((int)u >> 31) | 0x80000000u); }
__device__ __forceinline__ float okey_inv(unsigned k) { return __uint_as_float((k & 0x80000000u) ? (k ^ 0x80000000u) : ~k); }
__device__ __forceinline__ unsigned umed3(unsigned a, unsigned b, unsigned c) { unsigned r; asm("v_med3_u32 %0, %1, %2, %3" : "=v"(r) : "v"(a), "v"(b), "v"(c)); return r; }
__device__ __forceinline__ void ins16k(unsigned (&tk)[16], unsigned key) {
#pragma unroll
    for (int s = 15; s >= 1; --s) tk[s] = umed3(key, tk[s], tk[s - 1]);
    tk[0] = key > tk[0] ? key : tk[0];
}
__device__ __forceinline__ void route8(const float* SC, int tb, int lane, LAS int* eidL, LAS float* gtL, LAS int* lk) {
    const int tl = lane >> 3, h = lane & 7; const float* row = SC + (size_t)(tb + tl) * D + h * 256;
    unsigned k0[16], k1[16];
#pragma unroll
    for (int s = 0; s < 16; ++s) { k0[s] = 0u; k1[s] = 0u; }
#pragma unroll 2
    for (int n4 = 0; n4 < 128; n4 += 4) { const f32x4 v = *(const f32x4*)(row + n4);
#pragma unroll
        for (int e = 0; e < 4; ++e) ins16k(k0, (okey(v[e]) & ~0x7fu) | (unsigned)(127 - n4 - e)); }
#pragma unroll 2
    for (int n4 = 0; n4 < 128; n4 += 4) { const f32x4 v = *(const f32x4*)(row + 128 + n4);
#pragma unroll
        for (int e = 0; e < 4; ++e) ins16k(k1, (okey(v[e]) & ~0x7fu) | (unsigned)(127 - n4 - e)); }
    float a0[16], a1[16];
#pragma unroll
    for (int s = 0; s < 16; ++s) { const int n0 = 127 - (int)(k0[s] & 0x7fu), n1 = 127 - (int)(k1[s] & 0x7fu); lk[s * 64 + lane] = n0; lk[1024 + s * 64 + lane] = n1; a0[s] = row[n0]; a1[s] = row[128 + n1]; }
    unsigned ck[16];
#pragma unroll
    for (int s = 0; s < 16; ++s) ck[s] = 0u;
#pragma unroll
    for (int i = 0; i < 16; ++i)
#pragma unroll
        for (int j = 0; j < 16; ++j) if ((i + 1) * (j + 1) <= 16) ins16k(ck, (okey(a0[i] + a1[j]) & ~0xffu) | (unsigned)(255 - (i * 16 + j)));
    float cs[16]; float mx = -INFINITY;
#pragma unroll
    for (int s = 0; s < 16; ++s) { cs[s] = okey_inv((ck[s] & ~0xffu) | 0x80u); mx = fmaxf(mx, cs[s]); }
    float sum = 0.f;
#pragma unroll
    for (int s = 0; s < 16; ++s) { cs[s] = __expf(cs[s] - mx); sum += cs[s]; }
    const float rs = 1.0f / sum;
#pragma unroll
    for (int s = 0; s < 16; ++s) { const int flat = 255 - (int)(ck[s] & 0xffu); const int i1 = lk[(flat >> 4) * 64 + lane], i2 = lk[1024 + (flat & 15) * 64 + lane];
        eidL[tl * 128 + h * 16 + s] = i1 * NKEY + i2; gtL[tl * 128 + h * 16 + s] = cs[s] * rs; }
}
__device__ __forceinline__ float ub0(unsigned w) { return (float)(w & 0xffu); }
__device__ __forceinline__ float ub1(unsigned w) { return (float)((w >> 8) & 0xffu); }
__device__ __forceinline__ float ub2(unsigned w) { return (float)((w >> 16) & 0xffu); }
__device__ __forceinline__ float ub3(unsigned w) { return (float)(w >> 24); }
__device__ __forceinline__ float dot16(const v4u p, const float (&x)[16]) {
    return (ub0(p.x) * x[0] + ub1(p.x) * x[1] + ub2(p.x) * x[2] + ub3(p.x) * x[3]) + (ub0(p.y) * x[4] + ub1(p.y) * x[5] + ub2(p.y) * x[6] + ub3(p.y) * x[7])
         + (ub0(p.z) * x[8] + ub1(p.z) * x[9] + ub2(p.z) * x[10] + ub3(p.z) * x[11]) + (ub0(p.w) * x[12] + ub1(p.w) * x[13] + ub2(p.w) * x[14] + ub3(p.w) * x[15]);
}
__device__ __forceinline__ void axpy16(float (&a)[16], const v4u p, float c) {
    a[0] += c * ub0(p.x); a[1] += c * ub1(p.x); a[2] += c * ub2(p.x); a[3] += c * ub3(p.x); a[4] += c * ub0(p.y); a[5] += c * ub1(p.y); a[6] += c * ub2(p.y); a[7] += c * ub3(p.y);
    a[8] += c * ub0(p.z); a[9] += c * ub1(p.z); a[10] += c * ub2(p.z); a[11] += c * ub3(p.z); a[12] += c * ub0(p.w); a[13] += c * ub1(p.w); a[14] += c * ub2(p.w); a[15] += c * ub3(p.w);
}
__device__ __forceinline__ float reduce8(const float (&d)[8], int lane) {
    const bool h5 = (lane & 32) != 0, h4 = (lane & 16) != 0, h3 = (lane & 8) != 0;
    float e[4], f[2];
#pragma unroll
    for (int i = 0; i < 4; ++i) { const float keep = h5 ? d[i + 4] : d[i], send = h5 ? d[i] : d[i + 4]; e[i] = keep + __shfl_xor(send, 32); }
#pragma unroll
    for (int i = 0; i < 2; ++i) { const float keep = h4 ? e[i + 2] : e[i], send = h4 ? e[i] : e[i + 2]; f[i] = keep + __shfl_xor(send, 16); }
    float g = (h3 ? f[1] : f[0]) + __shfl_xor(h3 ? f[0] : f[1], 8);
    g += __shfl_xor(g, 4); g += __shfl_xor(g, 2); g += __shfl_xor(g, 1);
    return g;
}
__device__ __forceinline__ float wave_maxf(float v) {
#pragma unroll
    for (int o = 1; o < 64; o <<= 1) v = fmaxf(v, __shfl_xor(v, o));
    return v;
}
__device__ __forceinline__ void quant_row(const float* src, unsigned char* dst, float* scale_out, int lane) {
    f32x4 v[2][4]; float mx = 0.f;
#pragma unroll
    for (int j = 0; j < 2; ++j)
#pragma unroll
        for (int i = 0; i < 4; ++i) { v[j][i] = *(const f32x4*)(src + 1024 * j + 16 * lane + 4 * i);
            mx = fmaxf(mx, fmaxf(fmaxf(fabsf(v[j][i].x), fabsf(v[j][i].y)), fmaxf(fabsf(v[j][i].z), fabsf(v[j][i].w)))); }
    mx = wave_maxf(mx);
    const float inv = mx > 0.f ? 127.0f / mx : 0.f;
#pragma unroll
    for (int j = 0; j < 2; ++j) { v4u o;
#pragma unroll
        for (int i = 0; i < 4; ++i) { const unsigned b0 = (unsigned)((int)rintf(v[j][i].x * inv) + 128), b1 = (unsigned)((int)rintf(v[j][i].y * inv) + 128), b2 = (unsigned)((int)rintf(v[j][i].z * inv) + 128), b3 = (unsigned)((int)rintf(v[j][i].w * inv) + 128);
            o[i] = b0 | (b1 << 8) | (b2 << 16) | (b3 << 24); }
        *(v4u*)(dst + 1024 * j + 16 * lane) = o; }
    if (lane == 0) *scale_out = mx * (1.0f / 127.0f);
}

struct Args { const float* in[17]; float* out; float* hbuf; unsigned char* ws; int ph_lo, ph_hi, li, pad; };

__global__ void __launch_bounds__(NWAVES * 64, 2) mk_fwd(Args args) {
    extern __shared__ __attribute__((aligned(16))) unsigned char lds_raw[];
    LAS unsigned char* lds = (LAS unsigned char*)lds_raw;
    volatile LAS unsigned* MISC = (volatile LAS unsigned*)(lds + MISC_OFF);
    const int tid = threadIdx.x, lane = tid & 63, wave = __builtin_amdgcn_readfirstlane(tid >> 6);
    const int G = gridDim.x, bx = blockIdx.x;
    const int vcu = (G % 8 == 0) ? (bx % 8) * (G / 8) + bx / 8 : bx;
    const int gw = vcu * NWAVES + wave, NGW = G * NWAVES;
    unsigned char* ws = args.ws;
    const float* x = args.in[0]; const float* cvec = args.in[1]; const float* ada_w = args.in[2]; const float* ada_b = args.in[3]; const float* norm1_g = args.in[4];
    const float* w_in = args.in[5]; const float* pool_mix = args.in[6]; const float* pool_scale = args.in[7]; const float* w_ab = args.in[8]; const float* w_pb = args.in[9];
    const float* w_out = args.in[10]; const float* norm2_g = args.in[11]; const float* wq = args.in[12]; const float* keys = args.in[13]; const float* wdn = args.in[14];
    const float* wup = args.in[15]; const float* final_g = args.in[16];
    float* out = args.out;
    float* mod = (float*)(ws + WS_MOD); float* invf = (float*)(ws + WS_INVF);
    bf16* WAB = (bf16*)(ws + WS_WAB); bf16* WPB = (bf16*)(ws + WS_WPB); bf16* MIX = (bf16*)(ws + WS_MIX); bf16* KEYS = (bf16*)(ws + WS_KEYS);
    bf16* WOUT = (bf16*)(ws + WS_WOUT); bf16* WQ = (bf16*)(ws + WS_WQ); bf16* WIN = (bf16*)(ws + WS_WIN); unsigned char* DOWN = ws + WS_DOWN; unsigned char* UP = ws + WS_UP; float* DSC = (float*)(ws + WS_DSC); float* USC = (float*)(ws + WS_USC);
    bf16* XN = (bf16*)(ws + WS_XN); bf16* OG = (bf16*)(ws + WS_OG); float* LSE = (float*)(ws + WS_LSE);
    bf16* Qb = (bf16*)(ws + WS_Q); bf16* Kb = (bf16*)(ws + WS_K); bf16* Vb = (bf16*)(ws + WS_V); bf16* PIN = (bf16*)(ws + WS_PIN); bf16* GA = (bf16*)(ws + WS_GA); bf16* GB = (bf16*)(ws + WS_GB);
    bf16* DPOOL = (bf16*)(ws + WS_DPOOL); bf16* ATTN = (bf16*)(ws + WS_ATTN); bf16* POOL = (bf16*)(ws + WS_POOL); bf16* MERGED = (bf16*)(ws + WS_MERGED);
    bf16* PQ = (bf16*)(ws + WS_PQ); float* SC = (float*)(ws + WS_SC);
    float* H = args.hbuf;
    const float *shift1 = mod, *scale1 = mod + D, *gate1 = mod + 2 * D, *shift2 = mod + 3 * D, *scale2 = mod + 4 * D, *gate2 = mod + 5 * D;

    for (int u = tid; u < (LDS_BYTES - LDSCTL_OFF) / 4; u += NWAVES * 64) ((LAS unsigned*)(lds + LDSCTL_OFF))[u] = 0u;
    __syncthreads();
    XcdBarrier bar; bar.bar = (unsigned*)(ws + WS_CTL) + CW_BAR; bar.x = 0; bar.st = nullptr;
    if (MK_N_LAUNCHES == 1) bar = xcd_barrier_post((unsigned*)(ws + WS_CTL) + CW_BAR, MISC + 8);
    const int lo = args.ph_lo, hi = args.ph_hi;
#define IN(k) (lo <= (k) && (k) < hi)
#define SEAM(k) do { if (IN(k) && IN((k) + 1)) xcd_barrier(bar); } while (0)

    if (IN(0)) REP(0) {
        for (int chunk = bx; chunk < 6 * D / 48; chunk += G) {
            LAS float* red = (LAS float*)lds;
            const int cq = tid % 12, rg = tid / 12;
            if (rg < 32) {
                f32x4 a = {0.f, 0.f, 0.f, 0.f};
                const float* wp = ada_w + (size_t)(rg * 64) * (6 * D) + chunk * 48 + 4 * cq;
#pragma unroll 8
                for (int i = 0; i < 64; ++i) { const float ci = cvec[rg * 64 + i]; const float sl = ci / (1.0f + __expf(-ci)); a = a + *(const f32x4*)(wp + (size_t)i * (6 * D)) * sl; }
                *(LAS f32x4*)(red + rg * 48 + 4 * cq) = a;
            }
            __syncthreads();
            if (tid < 48) { float s = 0.f;
#pragma unroll 8
                for (int i = 0; i < 32; ++i) s += red[i * 48 + tid];
                mod[chunk * 48 + tid] = s + ada_b[chunk * 48 + tid]; }
            __syncthreads();
        }
        if (gw == 0) invf[lane] = (float)pow(10000.0, -(double)lane / 64.0);
        LAS float* scr = (LAS float*)(lds + wave * 16384);
        constexpr int I_IN = (D / 64) * (INW / 32), I_B = (AOW / 64) * (D / 32), I_O = (D / 64) * (D / 32);
        constexpr int NT_ITEMS = I_IN + 2 * I_B + 2 * I_O;
        for (int it = gw; it < NT_ITEMS; it += NGW) {
            int r = it;
            if (r < I_IN) { p0_transpose_item(w_in, D, INW, WIN, true, scr, r, lane); continue; } r -= I_IN;
            if (r < I_B) { p0_transpose_item(w_ab, AOW, D, WAB, false, scr, r, lane); continue; } r -= I_B;
            if (r < I_B) { p0_transpose_item(w_pb, PW, D, WPB, false, scr, r, lane); continue; } r -= I_B;
            if (r < I_O) { p0_transpose_item(w_out, D, D, WOUT, false, scr, r, lane); continue; } r -= I_O;
            p0_transpose_item(wq, D, D, WQ, false, scr, r, lane);
        }
        for (int n = gw; n < PW; n += NGW) { const int g = n >> 7, d = n & 127, k0 = 8 * lane; v4u o = {0u, 0u, 0u, 0u};
            if ((k0 >> 7) == g) { const float* p = pool_mix + ((size_t)g * 128 + (k0 & 127)) * 128 + d;
                o.x = pk2(p[0], p[128]); o.y = pk2(p[256], p[384]); o.z = pk2(p[512], p[640]); o.w = pk2(p[768], p[896]); }
            *(v4u*)(MIX + (size_t)n * PW + k0) = o; }
        for (int it = gw; it < PH * 128; it += NGW) { const int rowi = 2 * it + (lane >> 5), h = rowi >> 8, nn = rowi & 255, p = nn >> 7, k0 = 8 * (lane & 31); v4u o = {0u, 0u, 0u, 0u};
            if ((k0 >> 7) == p) { const float* s = keys + (((size_t)h * 2 + p) * NKEY + (nn & 127)) * 128 + (k0 & 127); const f32x4 a = *(const f32x4*)s, b = *(const f32x4*)(s + 4); o = pack8(a, b); }
            *(v4u*)(KEYS + (size_t)rowi * 256 + k0) = o; }
        for (int rowi = gw; rowi < 2 * 16384; rowi += NGW) { const int e = rowi & 16383;
            if (rowi < 16384) quant_row(wdn + (size_t)e * D, DOWN + (size_t)e * D, DSC + e, lane); else quant_row(wup + (size_t)e * D, UP + (size_t)e * D, USC + e, lane); }
    }
    SEAM(0);
    if (IN(1)) REP(1) { for (int m = gw; m < S; m += NGW) rmsmod_row(x + (size_t)m * D, norm1_g, scale1, shift1, XN + (size_t)m * D, lane); }
    SEAM(1);
    if (IN(2)) REP(2) {
        pg8::Gemm g{XN, WIN, D, D, S, INW, D, 0}; pg8::StaticOrder So; So.init(S, INW, G, bx);
        EpiInProj E{Qb, Kb, Vb, PIN, GA, GB, invf};
        pg8::gemm_phase<EpiInProj>(lds, g, So, E);
    }
    SEAM(2);
    if (IN(3)) REP(3) {
        for (int u = bx; u < 1536; u += G) attn_unit(lds, u, Qb, Kb, Vb, OG, LSE);
        for (int t = gw; t < S; t += NGW) {
            const int wsz = 2 << (lane >> 4); const int nwin = (t + 1 < wsz) ? t + 1 : wsz;
            float sacc[8] = {0.f, 0.f, 0.f, 0.f, 0.f, 0.f, 0.f, 0.f}; v4u cur = {0u, 0u, 0u, 0u};
            for (int i = 0; i < nwin; ++i) { const v4u p = *(const v4u*)(PIN + (size_t)(t - i) * PW + 8 * lane); if (i == 0) cur = p;
                sacc[0] += bflo(p.x); sacc[1] += bfhi(p.x); sacc[2] += bflo(p.y); sacc[3] += bfhi(p.y); sacc[4] += bflo(p.z); sacc[5] += bfhi(p.z); sacc[6] += bflo(p.w); sacc[7] += bfhi(p.w); }
            const float rn = 1.0f / (float)nwin; v4u o;
            o.x = pk2(sacc[0] * rn - bflo(cur.x), sacc[1] * rn - bfhi(cur.x)); o.y = pk2(sacc[2] * rn - bflo(cur.y), sacc[3] * rn - bfhi(cur.y));
            o.z = pk2(sacc[4] * rn - bflo(cur.z), sacc[5] * rn - bfhi(cur.z)); o.w = pk2(sacc[6] * rn - bflo(cur.w), sacc[7] * rn - bfhi(cur.w));
            *(v4u*)(DPOOL + (size_t)t * PW + 8 * lane) = o;
        }
    }
    SEAM(3);
    if (IN(4)) REP(4) {
        for (int t = gw; t < S; t += NGW) { const int j = lane >> 4;
            const float l0 = LSE[((size_t)0 * S + t) * 4 + j], l1 = LSE[((size_t)1 * S + t) * 4 + j], l2 = LSE[((size_t)2 * S + t) * 4 + j];
            const float m = fmaxf(l0, fmaxf(l1, l2)); float e0 = __expf(l0 - m), e1 = __expf(l1 - m), e2 = __expf(l2 - m); const float inv = 1.0f / (e0 + e1 + e2); e0 *= inv; e1 *= inv; e2 *= inv;
            const v4u a = *(const v4u*)(OG + ((size_t)0 * S + t) * AOW + 8 * lane), b = *(const v4u*)(OG + ((size_t)1 * S + t) * AOW + 8 * lane), c = *(const v4u*)(OG + ((size_t)2 * S + t) * AOW + 8 * lane);
            v4u o;
            o.x = pk2(e0 * bflo(a.x) + e1 * bflo(b.x) + e2 * bflo(c.x), e0 * bfhi(a.x) + e1 * bfhi(b.x) + e2 * bfhi(c.x));
            o.y = pk2(e0 * bflo(a.y) + e1 * bflo(b.y) + e2 * bflo(c.y), e0 * bfhi(a.y) + e1 * bfhi(b.y) + e2 * bfhi(c.y));
            o.z = pk2(e0 * bflo(a.z) + e1 * bflo(b.z) + e2 * bflo(c.z), e0 * bfhi(a.z) + e1 * bfhi(b.z) + e2 * bfhi(c.z));
            o.w = pk2(e0 * bflo(a.w) + e1 * bflo(b.w) + e2 * bflo(c.w), e0 * bfhi(a.w) + e1 * bfhi(b.w) + e2 * bfhi(c.w));
            *(v4u*)(ATTN + (size_t)t * AOW + 8 * lane) = o; }
        pg8::Gemm g{DPOOL, MIX, PW, PW, S, PW, PW, 0}; pg8::StaticOrder So; So.init(S, PW, G, bx);
        EpiBf16 E{POOL, PW, pool_scale};
        pg8::gemm_phase<EpiBf16>(lds, g, So, E);
    }
    SEAM(4);
    if (IN(5)) REP(5) {
        pg8::StaticOrder So; So.init(S, D, G, bx);
        { pg8::Gemm g{ATTN, WAB, AOW, AOW, S, D, AOW, 0}; EpiGate E{MERGED, GA, 0}; pg8::gemm_phase<EpiGate>(lds, g, So, E); }
        { pg8::Gemm g{POOL, WPB, PW, PW, S, D, PW, 0}; EpiGate E{MERGED, GB, 1}; pg8::gemm_phase<EpiGate>(lds, g, So, E); }
    }
    SEAM(5);
    if (IN(6)) REP(6) {
        pg8::Gemm g{MERGED, WOUT, D, D, S, D, D, 0}; pg8::StaticOrder So; So.init(S, D, G, bx);
        EpiResid E{H, x, gate1};
        pg8::gemm_phase<EpiResid>(lds, g, So, E);
    }
    SEAM(6);
    if (IN(7)) REP(7) { for (int m = gw; m < S; m += NGW) rmsmod_row(H + (size_t)m * D, norm2_g, scale2, shift2, XN + (size_t)m * D, lane); }
    SEAM(7);
    if (IN(8)) REP(8) {
        pg8::Gemm g{XN, WQ, D, D, S, D, D, 0}; pg8::StaticOrder So; So.init(S, D, G, bx);
        EpiBf16 E{PQ, D, nullptr};
        pg8::gemm_phase<EpiBf16>(lds, g, So, E);
    }
    SEAM(8);
    if (IN(9)) REP(9) {
        pg8::Gemm g{PQ, KEYS, D, 256, S, D, 256, 256}; pg8::StaticOrder So; So.init(S, D, G, bx);
        EpiF32 E{SC, D};
        pg8::gemm_phase<EpiF32>(lds, g, So, E);
    }
    SEAM(9);
    if (IN(10)) {
        LAS int* eidL = (LAS int*)(lds + wave * 16384); LAS float* gtL = (LAS float*)(lds + wave * 16384 + 4096); LAS int* lk = (LAS int*)(lds + wave * 16384 + 8192);
        for (int tb = 8 * gw; tb < S; tb += 8 * NGW) {
            route8(SC, tb, lane, eidL, gtL, lk);
            LDS_WAIT(); asm volatile("" ::: "memory");
            for (int tl = 0; tl < 8; ++tl) {
                const int t = tb + tl; LAS int* eid = eidL + tl * 128; LAS float* gt = gtL + tl * 128;
                float xv[2][16]; float xs = 0.f;
#pragma unroll
                for (int j = 0; j < 2; ++j)
#pragma unroll
                    for (int hh = 0; hh < 2; ++hh) { const v4u p = *(const v4u*)(XN + (size_t)t * D + 1024 * j + 16 * lane + 8 * hh);
                        xv[j][8 * hh + 0] = bflo(p.x); xv[j][8 * hh + 1] = bfhi(p.x); xv[j][8 * hh + 2] = bflo(p.y); xv[j][8 * hh + 3] = bfhi(p.y);
                        xv[j][8 * hh + 4] = bflo(p.z); xv[j][8 * hh + 5] = bfhi(p.z); xv[j][8 * hh + 6] = bflo(p.w); xv[j][8 * hh + 7] = bfhi(p.w); }
#pragma unroll
                for (int j = 0; j < 2; ++j)
#pragma unroll
                    for (int b = 0; b < 16; ++b) xs += xv[j][b];
                const float x128 = 128.0f * wave_sum(xs);
                const int rid = ((lane >> 5) & 1) * 4 + ((lane >> 4) & 1) * 2 + ((lane >> 3) & 1);
                for (int kb = 0; kb < 128; kb += 8) {
                    v4u buf[8][2];
#pragma unroll
                    for (int i = 0; i < 8; ++i) { const int ex = __builtin_amdgcn_readfirstlane(eid[kb + i]); const unsigned char* rp = DOWN + (size_t)ex * D + 16 * lane; buf[i][0] = *(const v4u*)rp; buf[i][1] = *(const v4u*)(rp + 1024); }
                    float dd[8];
#pragma unroll
                    for (int i = 0; i < 8; ++i) dd[i] = dot16(buf[i][0], xv[0]) + dot16(buf[i][1], xv[1]);
                    const float tot = reduce8(dd, lane);
                    const int kk = kb + rid, ex = eid[kk];
                    const float u = DSC[ex] * (tot - x128);
                    const float a = 0.5f * u * (1.0f + erff(u * 0.70710678118654752f)) * gt[kk] * USC[ex];
                    if ((lane & 7) == 0) gt[kk] = a;
                }
                LDS_WAIT(); asm volatile("" ::: "memory");
                float acc[2][16]; float csum = 0.f;
#pragma unroll
                for (int j = 0; j < 2; ++j)
#pragma unroll
                    for (int b = 0; b < 16; ++b) acc[j][b] = 0.f;
                for (int kb = 0; kb < 128; kb += 8) {
                    v4u buf[8][2]; float cc[8];
#pragma unroll
                    for (int i = 0; i < 8; ++i) { const int ex = __builtin_amdgcn_readfirstlane(eid[kb + i]); const unsigned char* rp = UP + (size_t)ex * D + 16 * lane; buf[i][0] = *(const v4u*)rp; buf[i][1] = *(const v4u*)(rp + 1024); cc[i] = gt[kb + i]; }
#pragma unroll
                    for (int i = 0; i < 8; ++i) { csum += cc[i]; axpy16(acc[0], buf[i][0], cc[i]); axpy16(acc[1], buf[i][1], cc[i]); }
                }
                const float off = 128.0f * csum;
                float ss = 0.f;
#pragma unroll
                for (int j = 0; j < 2; ++j)
#pragma unroll
                    for (int q = 0; q < 4; ++q) { const int c0 = 1024 * j + 16 * lane + 4 * q; const f32x4 hh = *(const f32x4*)(H + (size_t)t * D + c0), g2 = *(const f32x4*)(gate2 + c0);
#pragma unroll
                        for (int e = 0; e < 4; ++e) { const float v = hh[e] + g2[e] * (acc[j][4 * q + e] - off); acc[j][4 * q + e] = v; ss += v * v; } }
                const float rr = 1.0f / sqrtf(wave_sum(ss) * (1.f / D) + EPS);
#pragma unroll
                for (int j = 0; j < 2; ++j)
#pragma unroll
                    for (int q = 0; q < 4; ++q) { const int c0 = 1024 * j + 16 * lane + 4 * q; const f32x4 fg = *(const f32x4*)(final_g + c0); f32x4 o;
#pragma unroll
                        for (int e = 0; e < 4; ++e) o[e] = acc[j][4 * q + e] * rr * fg[e];
                        *(f32x4*)(out + (size_t)t * D + c0) = o; }
            }
            LDS_WAIT(); asm volatile("" ::: "memory");
        }
    }
#undef IN
#undef SEAM
}

extern "C" void kernel_launch(void* const* d_in, const int* in_sizes, int n_in, void* d_out, int out_size, void* d_ws, size_t ws_size, hipStream_t stream) {
    static int grid = 0;
    if (grid == 0) {
        if (n_in != 17 || out_size != S * D || ws_size < WS_END) { fprintf(stderr, "kernel_launch: unexpected shapes (n_in %d, out %d, ws %zu); nothing launched\n", n_in, out_size, ws_size); grid = -1; return; }
        int dev = 0, cus = 0, per_cu = 0;
        if (hipGetDevice(&dev) != hipSuccess || hipDeviceGetAttribute(&cus, hipDeviceAttributeMultiprocessorCount, dev) != hipSuccess) { grid = -1; return; }
        if (hipFuncSetAttribute((const void*)mk_fwd, hipFuncAttributeMaxDynamicSharedMemorySize, LDS_BYTES) != hipSuccess) { fprintf(stderr, "kernel_launch: hipFuncSetAttribute failed\n"); grid = -1; return; }
        if (hipOccupancyMaxActiveBlocksPerMultiprocessor(&per_cu, (const void*)mk_fwd, NWAVES * 64, LDS_BYTES) != hipSuccess || per_cu < 1) { fprintf(stderr, "kernel_launch: occupancy query says %d blocks per CU\n", per_cu); per_cu = 1; }
        (void)hipGetLastError();
        grid = cus;
    }
    if (grid < 0) return;
    (void)hipMemsetAsync((char*)d_ws + WS_CTL, 0, CTL_ZERO_BYTES, stream);
    Args a{};
    for (int i = 0; i < 17; ++i) a.in[i] = (const float*)d_in[i];
    a.out = (float*)d_out; a.hbuf = (float*)d_out; a.ws = (unsigned char*)d_ws;
    if (MK_N_LAUNCHES == 1) {
        a.ph_lo = 0; a.ph_hi = N_PHASES; a.li = 0;
        void* kargs[] = {&a};
        hipError_t e = hipLaunchCooperativeKernel((const void*)mk_fwd, dim3(grid), dim3(NWAVES * 64), kargs, LDS_BYTES, stream);
        if (e != hipSuccess) fprintf(stderr, "kernel_launch: cooperative launch failed: %s (grid %d)\n", hipGetErrorString(e), grid);
    } else {
        for (int li = 0; li < N_PHASES; ++li) { a.ph_lo = li; a.ph_hi = li + 1; a.li = li;
#ifdef DUP_PHASE
            if (li == DUP_PHASE) { Args b = a; if (li == 10) b.out = (float*)((char*)d_ws + 412 * MiB); hipLaunchKernelGGL(mk_fwd, dim3(grid), dim3(NWAVES * 64), LDS_BYTES, stream, b); }
#endif
            hipLaunchKernelGGL(mk_fwd, dim3(grid), dim3(NWAVES * 64), LDS_BYTES, stream, a); }
    }
}
```

```cpp
#include <hip/hip_runtime.h>
#include <cstdio>
#include <cstdint>
#include <cmath>

#ifndef MK_N_LAUNCHES
#define MK_N_LAUNCHES 1
#endif
constexpr int N_PHASES = 11;
#ifndef PROBE_PHASE
#define PROBE_PHASE -1
#endif
#define REP(k) for (int _rep = 0; _rep < ((PROBE_PHASE == (k)) ? 2 : 1); ++_rep)

namespace pg8 {
#define PG8_LAS __attribute__((address_space(3)))
typedef unsigned short bf16_t;
typedef short bf16x8 __attribute__((ext_vector_type(8)));
typedef float f32x4 __attribute__((ext_vector_type(4)));
typedef unsigned u32x4 __attribute__((ext_vector_type(4)));
constexpr int BM = 256, BK = 64, HALF = 128, HTB = HALF * BK * 2, STAGE_BYTES = 8 * HTB, NXCD = 8, WGM = 8;

__host__ __device__ __forceinline__ int lds_byte(int r, int c) { const int st = (r >> 4) * 2 + (c >> 5), rr = r & 15, cc = c & 31, ob = rr * 64 + cc * 2; return st * 1024 + (ob ^ (((ob >> 9) & 1) << 5)); }
__host__ __device__ __forceinline__ void stage_rc(int b, int& R, int& C) { const int st = b / 1024, sb = b % 1024, swz = sb ^ (((sb >> 9) & 1) << 5); R = (st >> 1) * 16 + swz / 64; C = (st & 1) * 32 + (swz % 64) / 2; }
__host__ __device__ __forceinline__ int perm32(int rho) { const int n = rho >> 4, i = rho & 15; return 8 * (i >> 2) + 4 * n + (i & 3); }

struct Unit { int pm, pn; };
struct Gemm { const bf16_t* A; const bf16_t* Bt; int lda, ldb, M, N, K; int acol_per_pn; };

struct StaticOrder {
    int nM, nN, nwg, G, c;
    __host__ __device__ void init(int M, int N, int G_, int c_) { nM = M / BM; nN = N / BM; nwg = nM * nN; G = G_; c = c_; }
    __host__ __device__ bool next(int i, Unit& u) const {
        const long L = (long)i * G + c; if (L >= nwg) return false;
        int wgid = (int)L; { const int q = nwg / NXCD, r = nwg % NXCD, xcd = wgid % NXCD, off = wgid / NXCD; wgid = (xcd < r ? xcd * (q + 1) : r * (q + 1) + (xcd - r) * q) + off; }
        const int nig = WGM * nN, gid = wgid / nig, fm = gid * WGM, gsz = (nM - fm) < WGM ? (nM - fm) : WGM;
        u.pm = fm + ((wgid % nig) % gsz); u.pn = (wgid % nig) / gsz; return true;
    }
};

template <class Epi>
__device__ __forceinline__ void gemm_phase(PG8_LAS unsigned char* lds, const Gemm g, const StaticOrder& S, const Epi& E) {
    const int tid = threadIdx.x, wid = __builtin_amdgcn_readfirstlane(tid >> 6), lane = tid & 63, wr = wid >> 2, wc = wid & 3, fr = lane & 15, fq = lane >> 4;
    const int K = g.K, nt = K / BK;
    unsigned voffA[2], voffB[2];
#pragma unroll
    for (int i = 0; i < 2; ++i) { int R, C; stage_rc(tid * 16 + i * 8192, R, C); const int Rb = Epi::PERM ? ((R & ~31) + perm32(R & 31)) : R;
        voffA[i] = (unsigned)(R * g.lda + C) * 2u; voffB[i] = (unsigned)(Rb * g.ldb + C) * 2u; }
    const size_t kstep = (size_t)(BK * 2);
    const size_t hstepA = (size_t)HALF * g.lda * 2, hstepB = (size_t)HALF * g.ldb * 2;
    const size_t tstepA = 2 * hstepA, tstepB = 2 * hstepB, cstepA = (size_t)g.acol_per_pn * 2;
    const unsigned ldsw = (unsigned)wid * 1024u;
    const int aoff = lds_byte(wr * 64 + fr, fq * 8), boff = lds_byte(wc * 32 + fr, fq * 8);
#define PG8_SA(b, h) (((b) * 2 + (h)) * HTB)
#define PG8_SB(b, h) ((4 + (b) * 2 + (h)) * HTB)
#define PG8_STAGE(bufoff, gbase, voff) do { _Pragma("unroll") for (int _i = 0; _i < 2; ++_i) \
        __builtin_amdgcn_global_load_lds((const unsigned*)((const char*)(gbase) + (voff)[_i]), (PG8_LAS unsigned*)(lds + (bufoff) + ldsw + _i * 8192), 16, 0, 0); } while (0)
#define PG8_LDA(dst, b, h) do { _Pragma("unroll") for (int m = 0; m < 4; ++m) _Pragma("unroll") for (int k = 0; k < 2; ++k) dst[m][k] = *(const PG8_LAS bf16x8*)(lds + PG8_SA(b, h) + aoff + m * 2048 + k * 1024); } while (0)
#define PG8_LDB(dst, b, h) do { _Pragma("unroll") for (int n = 0; n < 2; ++n) _Pragma("unroll") for (int k = 0; k < 2; ++k) dst[n][k] = *(const PG8_LAS bf16x8*)(lds + PG8_SB(b, h) + boff + n * 2048 + k * 1024); } while (0)
#define PG8_MMA(ai, bj, At, Bt) do { __builtin_amdgcn_s_setprio(1); _Pragma("unroll") for (int m = 0; m < 4; ++m) _Pragma("unroll") for (int n = 0; n < 2; ++n) _Pragma("unroll") for (int k = 0; k < 2; ++k) \
        acc[ai][bj][m][n] = __builtin_amdgcn_mfma_f32_16x16x32_bf16(Bt[n][k], At[m][k], acc[ai][bj][m][n], 0, 0, 0); __builtin_amdgcn_s_setprio(0); } while (0)
#define PG8_WAIT_V(n) asm volatile("s_waitcnt vmcnt(" #n ")" ::: "memory")
#define PG8_WAIT_L(n) asm volatile("s_waitcnt lgkmcnt(" #n ")" ::: "memory")
#define PG8_BAR __builtin_amdgcn_s_barrier()
#define PG8_SCHED __builtin_amdgcn_sched_barrier(0)
    Unit cur, nxt; int ui = 0;
    if (!S.next(0, cur)) return;
    f32x4 acc[2][2][4][2];
#pragma unroll
    for (int a = 0; a < 2; ++a)
#pragma unroll
        for (int b = 0; b < 2; ++b)
#pragma unroll
            for (int m = 0; m < 4; ++m)
#pragma unroll
                for (int n = 0; n < 2; ++n) acc[a][b][m][n] = (f32x4){0.f, 0.f, 0.f, 0.f};
    bf16x8 At[4][2], B0[2][2], B1[2][2];
    const char* cA = (const char*)g.A + (size_t)cur.pm * tstepA + (size_t)cur.pn * cstepA; const char* cB = (const char*)g.Bt + (size_t)cur.pn * tstepB;
    PG8_STAGE(PG8_SB(0, 0), cB, voffB); PG8_STAGE(PG8_SB(0, 1), cB + hstepB, voffB); PG8_STAGE(PG8_SA(0, 0), cA, voffA); PG8_STAGE(PG8_SA(0, 1), cA + hstepA, voffA);
    if (wr == 1) PG8_BAR;
    PG8_WAIT_V(2); PG8_BAR;
    PG8_STAGE(PG8_SB(1, 0), cB + kstep, voffB); PG8_STAGE(PG8_SA(1, 0), cA + kstep, voffA); PG8_STAGE(PG8_SB(1, 1), cB + hstepB + kstep, voffB);
    PG8_WAIT_V(6); PG8_BAR;
    for (;;) {
        const bool has_next = S.next(ui + 1, nxt);
        const char* nA = has_next ? (const char*)g.A + (size_t)nxt.pm * tstepA + (size_t)nxt.pn * cstepA : cA; const char* nB = has_next ? (const char*)g.Bt + (size_t)nxt.pn * tstepB : cB;
        for (int t = 0; t < nt; t += 2) {
            const bool last = (t == nt - 2);
            const char* a1 = cA + (size_t)(t + 1) * kstep;
            const char* a2 = last ? nA : cA + (size_t)(t + 2) * kstep; const char* b2 = last ? nB : cB + (size_t)(t + 2) * kstep;
            const char* a3 = a2 + kstep; const char* b3 = b2 + kstep;
            PG8_LDB(B0, 0, 0); PG8_LDB(B1, 0, 1); PG8_SCHED; PG8_LDA(At, 0, 0); PG8_STAGE(PG8_SA(1, 1), a1 + hstepA, voffA);
            PG8_WAIT_V(8); PG8_WAIT_L(0); PG8_BAR; PG8_MMA(0, 0, At, B0); PG8_MMA(0, 1, At, B1); PG8_BAR; PG8_SCHED;
            PG8_LDA(At, 0, 1); PG8_STAGE(PG8_SB(0, 0), b2, voffB); PG8_STAGE(PG8_SB(0, 1), b2 + hstepB, voffB); PG8_STAGE(PG8_SA(0, 0), a2, voffA);
            PG8_WAIT_V(8); PG8_WAIT_L(0); PG8_BAR; PG8_MMA(1, 0, At, B0); PG8_MMA(1, 1, At, B1); PG8_BAR; PG8_SCHED;
            PG8_LDB(B0, 1, 0); PG8_LDB(B1, 1, 1); PG8_SCHED; PG8_LDA(At, 1, 0); PG8_STAGE(PG8_SA(0, 1), a2 + hstepA, voffA);
            PG8_WAIT_V(8); PG8_WAIT_L(0); PG8_BAR; PG8_MMA(0, 0, At, B0); PG8_MMA(0, 1, At, B1); PG8_BAR; PG8_SCHED;
            PG8_LDA(At, 1, 1); PG8_STAGE(PG8_SB(1, 0), b3, voffB); PG8_STAGE(PG8_SB(1, 1), b3 + hstepB, voffB); PG8_STAGE(PG8_SA(1, 0), a3, voffA);
            PG8_WAIT_V(8); PG8_WAIT_L(0); PG8_BAR; PG8_MMA(1, 0, At, B0); PG8_MMA(1, 1, At, B1); PG8_BAR; PG8_SCHED;
        }
        if (wr == 0) PG8_BAR;
        E(acc, cur, wr, wc, fr, fq);
        if (!has_next) break;
#pragma unroll
        for (int a = 0; a < 2; ++a)
#pragma unroll
            for (int b = 0; b < 2; ++b)
#pragma unroll
                for (int m = 0; m < 4; ++m)
#pragma unroll
                    for (int n = 0; n < 2; ++n) acc[a][b][m][n] = (f32x4){0.f, 0.f, 0.f, 0.f};
        cur = nxt; cA = nA; cB = nB; ++ui;
        if (wr == 1) PG8_BAR;
    }
    PG8_WAIT_V(0);
    PG8_BAR;
#undef PG8_SA
#undef PG8_SB
#undef PG8_STAGE
#undef PG8_LDA
#undef PG8_LDB
#undef PG8_MMA
#undef PG8_WAIT_V
#undef PG8_WAIT_L
#undef PG8_BAR
#undef PG8_SCHED
}
}

constexpr int S = 16384, D = 2048, AW = 1536, NH = 12, HD = 128, AOW = 512, PW = 512, INW = 9216;
constexpr int PH = 8, PK = 16, NKEY = 128;
constexpr float EPS = 1e-6f;
constexpr float QSCALE = 0.08838834764831845f * 1.4426950408889634f;
constexpr int NWAVES = 8;

constexpr size_t MiB = 1u << 20;
constexpr size_t WS_CTL = 0, CTL_ZERO_BYTES = 1 * MiB;
constexpr size_t WS_MOD = 512 * 1024;
constexpr size_t WS_INVF = 1 * MiB;
constexpr size_t WS_DSC = 1 * MiB + 65536, WS_USC = 1 * MiB + 131072;
constexpr size_t WS_WAB = 2 * MiB, WS_WPB = 4 * MiB, WS_MIX = 6 * MiB, WS_KEYS = 7 * MiB, WS_WOUT = 8 * MiB, WS_WQ = 16 * MiB, WS_WIN = 24 * MiB;
constexpr size_t WS_DOWN = 60 * MiB, WS_UP = 124 * MiB;
constexpr size_t WS_XN = 188 * MiB;
constexpr size_t WS_OG = 188 * MiB, WS_LSE = 236 * MiB;
constexpr size_t WS_Q = 252 * MiB, WS_K = 300 * MiB, WS_V = 348 * MiB, WS_PIN = 396 * MiB, WS_GA = 412 * MiB, WS_GB = 476 * MiB;
constexpr size_t WS_DPOOL = 24 * MiB, WS_ATTN = 40 * MiB;
constexpr size_t WS_POOL = 252 * MiB;
constexpr size_t WS_MERGED = 300 * MiB;
constexpr size_t WS_PQ = 412 * MiB;
constexpr size_t WS_SC = 252 * MiB;
constexpr size_t WS_END = 540 * MiB;
constexpr int CW_BAR = 4096;

constexpr int RING_BYTES = 147456;
constexpr int LDSCTL_OFF = RING_BYTES, MISC_OFF = LDSCTL_OFF + 320;
constexpr int LDS_BYTES = RING_BYTES + 1024;

#define GAS __attribute__((address_space(1)))
#define LAS __attribute__((address_space(3)))
typedef unsigned short bf16;
typedef unsigned v4u __attribute__((ext_vector_type(4)));
typedef unsigned v2u __attribute__((ext_vector_type(2)));
typedef float f32x4 __attribute__((ext_vector_type(4)));
typedef float f32x2 __attribute__((ext_vector_type(2)));
typedef short bf16x8 __attribute__((ext_vector_type(8)));
typedef short s16x4 __attribute__((ext_vector_type(4)));
typedef __bf16 bf16x2_t __attribute__((ext_vector_type(2)));
#define LDS_WAIT() asm volatile("s_waitcnt lgkmcnt(0)" ::: "memory")
#define VM_WAIT() asm volatile("s_waitcnt vmcnt(0)" ::: "memory")
__device__ __forceinline__ unsigned pk2(float lo, float hi) { f32x2 v = {lo, hi}; bf16x2_t b = __builtin_convertvector(v, bf16x2_t); return __builtin_bit_cast(unsigned, b); }
__device__ __forceinline__ float bflo(unsigned u) { return __uint_as_float(u << 16); }
__device__ __forceinline__ float bfhi(unsigned u) { return __uint_as_float(u & 0xffff0000u); }
__device__ __forceinline__ float wave_sum(float v) {
#pragma unroll
    for (int o = 1; o < 64; o <<= 1) v += __shfl_xor(v, o);
    return v;
}

#define XB_TMO      128
#define XB_XCNT(j)  (256  + 64 * (j))
#define XB_XSUB(j)  (1280 + 64 * (j))
#define XB_XGEN(j)  (2304 + 64 * (j))
#define XB_TOP      3328
#define XB_TOPGEN   3392
#define XCD_BAR_WORDS 3456
#define XB_SPIN_CAP (1u << 22)
__device__ __forceinline__ unsigned xb_ld(unsigned* p)              { return __hip_atomic_load(p, __ATOMIC_RELAXED, __HIP_MEMORY_SCOPE_AGENT); }
__device__ __forceinline__ unsigned xb_add(unsigned* p, unsigned v) { return __hip_atomic_fetch_add(p, v, __ATOMIC_RELAXED, __HIP_MEMORY_SCOPE_AGENT); }
__device__ __forceinline__ unsigned xb_xcc_id() { return (unsigned)__builtin_amdgcn_s_getreg((3 << 11) | 20) & 0xFu; }
#define XB_SPIN(cond, bar) do { unsigned _sp = 0; while (cond) { __builtin_amdgcn_s_sleep(1); \
    if ((++_sp & 255u) == 0u) { if (xb_ld(&(bar)[XB_TMO])) break; if (_sp > XB_SPIN_CAP) { atomicAdd(&(bar)[XB_TMO], 1u); break; } } } } while (0)
struct XcdBarrier { unsigned* bar; unsigned x; volatile LAS unsigned* st; };
__device__ __forceinline__ XcdBarrier xcd_barrier_post(unsigned* bar, volatile LAS unsigned* st) {
    XcdBarrier b; b.bar = bar; b.x = xb_xcc_id(); b.st = st;
    if (threadIdx.x == 0) (void)xb_add(&bar[XB_XCNT(b.x)], 1u);
    return b;
}
__device__ __forceinline__ void xcd_barrier_complete(unsigned* bar, unsigned x, unsigned& nloc, unsigned& nx) {
    const unsigned G = gridDim.x * gridDim.y * gridDim.z;
    unsigned sum, cnt, mine, sp = 0u;
    for (;;) {
        sum = 0u; cnt = 0u; mine = 0u;
#pragma unroll
        for (unsigned j = 0; j < 16; ++j) { const unsigned c = xb_ld(&bar[XB_XCNT(j)]); sum += c; cnt += (c > 0u) ? 1u : 0u; mine = (j == x) ? c : mine; }
        if (sum == G) break;
        __builtin_amdgcn_s_sleep(1);
        if ((++sp & 255u) == 0u) { if (xb_ld(&bar[XB_TMO])) break; if (sp > XB_SPIN_CAP) { atomicAdd(&bar[XB_TMO], 1u); break; } }
    }
    nloc = mine > 0u ? mine : 1u; nx = cnt > 0u ? cnt : 1u;
}
__device__ __forceinline__ void xcd_barrier(const XcdBarrier& b) {
    asm volatile("s_waitcnt vmcnt(0)" ::: "memory");
    __syncthreads();
    if (threadIdx.x == 0) {
        unsigned* bar = b.bar;
        __builtin_amdgcn_s_waitcnt(0);
        unsigned nloc = b.st[0], nx = b.st[1];
        if (nloc == 0u) { xcd_barrier_complete(bar, b.x, nloc, nx); b.st[0] = nloc; b.st[1] = nx; }
        const unsigned old = xb_add(&bar[XB_XSUB(b.x)], 1u);
        const unsigned gen = old / nloc;
        if (old + 1u == (gen + 1u) * nloc) {
            __builtin_amdgcn_fence(__ATOMIC_RELEASE, "agent");
            asm volatile("s_waitcnt vmcnt(0)" ::: "memory");
            const unsigned og = xb_add(&bar[XB_TOP], 1u);
            const unsigned tg = og / nx;
            if (og + 1u == (tg + 1u) * nx) xb_add(&bar[XB_TOPGEN], 1u);
            else XB_SPIN(xb_ld(&bar[XB_TOPGEN]) == tg, bar);
            __builtin_amdgcn_fence(__ATOMIC_ACQUIRE, "agent");
            xb_add(&bar[XB_XGEN(b.x)], 1u);
            asm volatile("s_waitcnt vmcnt(0)" ::: "memory");
        } else {
            XB_SPIN(xb_ld(&bar[XB_XGEN(b.x)]) == gen, bar);
            __builtin_amdgcn_fence(__ATOMIC_ACQUIRE, "agent");
            asm volatile("s_waitcnt vmcnt(0)" ::: "memory");
        }
    }
    __syncthreads();
}

using pg8::Unit;
__device__ __forceinline__ v4u pack8(const f32x4 a, const f32x4 b) { v4u w; w.x = pk2(a[0], a[1]); w.y = pk2(a[2], a[3]); w.z = pk2(b[0], b[1]); w.w = pk2(b[2], b[3]); return w; }

struct EpiInProj {
    static constexpr bool PERM = true;
    bf16 *Q, *K, *V, *PIN, *GA, *GB; const float* invf;
    __device__ __forceinline__ void operator()(const f32x4 (&acc)[2][2][4][2], const Unit& u, int wr, int wc, int fr, int fq) const {
        const int pn = u.pn, row0 = u.pm * 256 + wr * 64 + fr, cl = wc * 32 + 8 * fq;
        if (pn < 12) {
            bf16* base = pn < 6 ? Q : K; const int ct = (pn < 6 ? pn : pn - 6) * 256; const float qs = pn < 6 ? QSCALE : 1.0f;
            float inv[4];
#pragma unroll
            for (int i = 0; i < 4; ++i) inv[i] = invf[(cl >> 1) + i];
#pragma unroll
            for (int ai = 0; ai < 2; ++ai)
#pragma unroll
                for (int m = 0; m < 4; ++m) {
                    const int row = row0 + ai * 128 + m * 16;
                    float cs[4], sn[4];
#pragma unroll
                    for (int i = 0; i < 4; ++i) { const float ang = (float)row * inv[i]; double rev = (double)ang * 0.15915494309189533577; rev -= rint(rev);
                        sn[i] = __builtin_amdgcn_sinf((float)rev) * qs; cs[i] = __builtin_amdgcn_cosf((float)rev) * qs; }
#pragma unroll
                    for (int bj = 0; bj < 2; ++bj) {
                        const f32x4 v0 = acc[ai][bj][m][0], v1 = acc[ai][bj][m][1]; f32x4 o0, o1;
                        o0[0] = v0[0] * cs[0] - v0[1] * sn[0]; o0[1] = v0[1] * cs[0] + v0[0] * sn[0]; o0[2] = v0[2] * cs[1] - v0[3] * sn[1]; o0[3] = v0[3] * cs[1] + v0[2] * sn[1];
                        o1[0] = v1[0] * cs[2] - v1[1] * sn[2]; o1[1] = v1[1] * cs[2] + v1[0] * sn[2]; o1[2] = v1[2] * cs[3] - v1[3] * sn[3]; o1[3] = v1[3] * cs[3] + v1[2] * sn[3];
                        *(v4u*)(base + (size_t)row * AW + ct + bj * 128 + cl) = pack8(o0, o1);
                    }
                }
        } else if (pn < 20) {
            bf16* base = pn < 18 ? V : PIN; const int ct = (pn < 18 ? pn - 12 : pn - 18) * 256; const int ld = pn < 18 ? AW : PW;
#pragma unroll
            for (int ai = 0; ai < 2; ++ai)
#pragma unroll
                for (int m = 0; m < 4; ++m) { const int row = row0 + ai * 128 + m * 16;
#pragma unroll
                    for (int bj = 0; bj < 2; ++bj) *(v4u*)(base + (size_t)row * ld + ct + bj * 128 + cl) = pack8(acc[ai][bj][m][0], acc[ai][bj][m][1]); }
        } else {
            bf16* base = pn < 28 ? GA : GB; const int ct = (pn < 28 ? pn - 20 : pn - 28) * 256;
#pragma unroll
            for (int ai = 0; ai < 2; ++ai)
#pragma unroll
                for (int m = 0; m < 4; ++m) { const int row = row0 + ai * 128 + m * 16;
#pragma unroll
                    for (int bj = 0; bj < 2; ++bj) { f32x4 a = acc[ai][bj][m][0], b = acc[ai][bj][m][1];
#pragma unroll
                        for (int e = 0; e < 4; ++e) { a[e] = __builtin_amdgcn_rcpf(1.0f + __expf(-a[e])); b[e] = __builtin_amdgcn_rcpf(1.0f + __expf(-b[e])); }
                        *(v4u*)(base + (size_t)row * D + ct + bj * 128 + cl) = pack8(a, b); } }
        }
    }
};
struct EpiBf16 {
    static constexpr bool PERM = true;
    bf16* O; int ld; const float* colscale;
    __device__ __forceinline__ void operator()(const f32x4 (&acc)[2][2][4][2], const Unit& u, int wr, int wc, int fr, int fq) const {
        const int row0 = u.pm * 256 + wr * 64 + fr, col0 = u.pn * 256 + wc * 32 + 8 * fq;
        f32x4 s[2][2];
#pragma unroll
        for (int bj = 0; bj < 2; ++bj)
#pragma unroll
            for (int n = 0; n < 2; ++n) s[bj][n] = colscale ? *(const f32x4*)(colscale + col0 + bj * 128 + 4 * n) : (f32x4){1.f, 1.f, 1.f, 1.f};
#pragma unroll
        for (int ai = 0; ai < 2; ++ai)
#pragma unroll
            for (int m = 0; m < 4; ++m) { const int row = row0 + ai * 128 + m * 16;
#pragma unroll
                for (int bj = 0; bj < 2; ++bj) *(v4u*)(O + (size_t)row * ld + col0 + bj * 128) = pack8(acc[ai][bj][m][0] * s[bj][0], acc[ai][bj][m][1] * s[bj][1]); }
    }
};
struct EpiGate {
    static constexpr bool PERM = true;
    bf16* O; const bf16* G; int accum;
    __device__ __forceinline__ void operator()(const f32x4 (&acc)[2][2][4][2], const Unit& u, int wr, int wc, int fr, int fq) const {
        const int row0 = u.pm * 256 + wr * 64 + fr, col0 = u.pn * 256 + wc * 32 + 8 * fq;
#pragma unroll
        for (int ai = 0; ai < 2; ++ai)
#pragma unroll
            for (int m = 0; m < 4; ++m) { const int row = row0 + ai * 128 + m * 16;
#pragma unroll
                for (int bj = 0; bj < 2; ++bj) { const size_t off = (size_t)row * D + col0 + bj * 128;
                    const v4u g = *(const v4u*)(G + off); f32x4 a = acc[ai][bj][m][0], b = acc[ai][bj][m][1];
                    a[0] *= bflo(g.x); a[1] *= bfhi(g.x); a[2] *= bflo(g.y); a[3] *= bfhi(g.y); b[0] *= bflo(g.z); b[1] *= bfhi(g.z); b[2] *= bflo(g.w); b[3] *= bfhi(g.w);
                    if (accum) { const v4u p = *(const v4u*)(O + off);
                        a[0] += bflo(p.x); a[1] += bfhi(p.x); a[2] += bflo(p.y); a[3] += bfhi(p.y); b[0] += bflo(p.z); b[1] += bfhi(p.z); b[2] += bflo(p.w); b[3] += bfhi(p.w); }
                    *(v4u*)(O + off) = pack8(a, b); } }
    }
};
struct EpiResid {
    static constexpr bool PERM = false;
    float* H; const float* x; const float* gate;
    __device__ __forceinline__ void operator()(const f32x4 (&acc)[2][2][4][2], const Unit& u, int wr, int wc, int fr, int fq) const {
        const int row0 = u.pm * 256 + wr * 64 + fr, col0 = u.pn * 256 + wc * 32 + 4 * fq;
#pragma unroll
        for (int ai = 0; ai < 2; ++ai)
#pragma unroll
            for (int m = 0; m < 4; ++m) { const int row = row0 + ai * 128 + m * 16;
#pragma unroll
                for (int bj = 0; bj < 2; ++bj)
#pragma unroll
                    for (int n = 0; n < 2; ++n) { const int col = col0 + bj * 128 + n * 16; const size_t off = (size_t)row * D + col;
                        const f32x4 g = *(const f32x4*)(gate + col), xx = *(const f32x4*)(x + off); *(f32x4*)(H + off) = xx + g * acc[ai][bj][m][n]; } }
    }
};
struct EpiF32 {
    static constexpr bool PERM = false;
    float* O; int ld;
    __device__ __forceinline__ void operator()(const f32x4 (&acc)[2][2][4][2], const Unit& u, int wr, int wc, int fr, int fq) const {
        const int row0 = u.pm * 256 + wr * 64 + fr, col0 = u.pn * 256 + wc * 32 + 4 * fq;
#pragma unroll
        for (int ai = 0; ai < 2; ++ai)
#pragma unroll
            for (int m = 0; m < 4; ++m) { const int row = row0 + ai * 128 + m * 16;
#pragma unroll
                for (int bj = 0; bj < 2; ++bj)
#pragma unroll
                    for (int n = 0; n < 2; ++n) *(f32x4*)(O + (size_t)row * ld + col0 + bj * 128 + n * 16) = acc[ai][bj][m][n]; }
    }
};

__device__ __forceinline__ void p0_transpose_item(const float* W, int K, int N, bf16* WT, bool ropeperm, LAS float* scr, int item, int lane) {
    const int nblk = N / 32, kb = item / nblk, nb = item % nblk, k0 = 64 * kb, n0 = 32 * nb;
#pragma unroll 8
    for (int i = 0; i < 32; ++i) { const int kk = 2 * i + (lane >> 5); scr[kk * 33 + (lane & 31)] = W[(size_t)(k0 + kk) * N + n0 + (lane & 31)]; }
    LDS_WAIT(); asm volatile("" ::: "memory");
    const int c = lane & 7;
#pragma unroll
    for (int j = 0; j < 4; ++j) { const int n = (lane >> 3) + 8 * j; const LAS float* s = scr + (8 * c) * 33 + n;
        v4u o; o.x = pk2(s[0 * 33], s[1 * 33]); o.y = pk2(s[2 * 33], s[3 * 33]); o.z = pk2(s[4 * 33], s[5 * 33]); o.w = pk2(s[6 * 33], s[7 * 33]);
        int rown = n0 + n; if (ropeperm && rown < 2 * AW) { const int d = rown & 127; rown = (rown & ~127) + 2 * (d & 63) + (d >> 6); }
        *(v4u*)(WT + (size_t)rown * K + k0 + 8 * c) = o; }
    LDS_WAIT(); asm volatile("" ::: "memory");
}
__device__ __forceinline__ void rmsmod_row(const float* xrow, const float* g, const float* scale, const float* shift, bf16* orow, int lane) {
    const f32x4* xr = (const f32x4*)xrow + lane;
    f32x4 v[8]; float s = 0.f;
#pragma unroll
    for (int j = 0; j < 8; ++j) { v[j] = xr[64 * j]; s += (v[j].x * v[j].x + v[j].y * v[j].y) + (v[j].z * v[j].z + v[j].w * v[j].w); }
    const float r = 1.0f / sqrtf(wave_sum(s) * (1.f / D) + EPS);
    v2u* o = (v2u*)orow + lane;
#pragma unroll
    for (int j = 0; j < 8; ++j) { const int c0 = 4 * lane + 256 * j;
        const f32x4 gg = *(const f32x4*)(g + c0), sc = *(const f32x4*)(scale + c0), sh = *(const f32x4*)(shift + c0);
        v2u w; w.x = pk2(v[j].x * r * gg.x * (1.f + sc.x) + sh.x, v[j].y * r * gg.y * (1.f + sc.y) + sh.y); w.y = pk2(v[j].z * r * gg.z * (1.f + sc.z) + sh.z, v[j].w * r * gg.w * (1.f + sc.w) + sh.w);
        o[64 * j] = w; }
}

constexpr int KV_STRIDE = 288;
constexpr int KV_TILE = 256 * KV_STRIDE;
typedef short v4i16_t __attribute__((ext_vector_type(4)));
__device__ __forceinline__ s16x4 vtr(LAS const unsigned char* p) { return __builtin_bit_cast(s16x4, __builtin_amdgcn_ds_read_tr16_b64_v4i16((LAS v4i16_t*)p)); }

__device__ __forceinline__ void attn_unit(LAS unsigned char* lds, int unit, const bf16* Q, const bf16* K, const bf16* V, bf16* OG, float* LSE) {
    const int tid = threadIdx.x, lane = tid & 63, w = __builtin_amdgcn_readfirstlane(tid >> 6), fr = lane & 15, fq = lane >> 4;
    const int g = unit >> 9, rem = unit & 511, j = rem & 3, blk = rem >> 2;
    const int dsh = 2 * g, dil = 1 << dsh;
    const int r = blk & (dil - 1), n = blk >> dsh, head = 4 * g + j;
    LAS unsigned char* Kl = lds; LAS unsigned char* Vl = lds + KV_TILE;
    {
        v4u kreg[8], vreg[8];
#pragma unroll
        for (int i = 0; i < 8; ++i) { const int idx = tid + 512 * i, kr = idx >> 4, ch = idx & 15; const int l = 128 * n - 128 + kr, lc = l < 0 ? 0 : l;
            const size_t off = (size_t)((lc << dsh) + r) * AW + head * HD + ch * 8; kreg[i] = *(const v4u*)(K + off); vreg[i] = *(const v4u*)(V + off); }
#pragma unroll
        for (int i = 0; i < 8; ++i) { const int idx = tid + 512 * i, kr = idx >> 4, ch = idx & 15; const bool ok = (128 * n - 128 + kr) >= 0; const v4u z = {0u, 0u, 0u, 0u};
            *(LAS v4u*)(Kl + kr * KV_STRIDE + ch * 16) = ok ? kreg[i] : z; *(LAS v4u*)(Vl + kr * KV_STRIDE + ch * 16) = ok ? vreg[i] : z; }
    }
    const int qpos = ((128 * n + 16 * w + fr) << dsh) + r;
    bf16x8 qf[4];
#pragma unroll
    for (int ks = 0; ks < 4; ++ks) qf[ks] = *(const bf16x8*)(Q + (size_t)qpos * AW + head * HD + 32 * ks + 8 * fq);
    __syncthreads();
    f32x4 st[9];
#pragma unroll
    for (int b = 0; b < 9; ++b) { st[b] = (f32x4){0.f, 0.f, 0.f, 0.f};
#pragma unroll
        for (int ks = 0; ks < 4; ++ks) { const bf16x8 kf = *(LAS const bf16x8*)(Kl + (16 * (w + b) + fr) * KV_STRIDE + 64 * ks + 16 * fq);
            st[b] = __builtin_amdgcn_mfma_f32_16x16x32_bf16(kf, qf[ks], st[b], 0, 0, 0); } }
    float mx = -INFINITY;
#pragma unroll
    for (int b = 0; b < 9; ++b)
#pragma unroll
        for (int e = 0; e < 4; ++e) { const int kk = 16 * b + 4 * fq + e;
            const bool ok = (kk >= fr) && (kk <= fr + 128) && (n > 0 || 16 * w + kk >= 128);
            st[b][e] = ok ? st[b][e] : -INFINITY; mx = fmaxf(mx, st[b][e]); }
    mx = fmaxf(mx, __shfl_xor(mx, 16)); mx = fmaxf(mx, __shfl_xor(mx, 32));
    float sm = 0.f;
#pragma unroll
    for (int b = 0; b < 9; ++b)
#pragma unroll
        for (int e = 0; e < 4; ++e) { const float p = __builtin_amdgcn_exp2f(st[b][e] - mx); st[b][e] = p; sm += p; }
    sm += __shfl_xor(sm, 16); sm += __shfl_xor(sm, 32);
    f32x4 o[8];
#pragma unroll
    for (int dt = 0; dt < 8; ++dt) o[dt] = (f32x4){0.f, 0.f, 0.f, 0.f};
    const int q4 = fr >> 2, p4 = fr & 3;
#pragma unroll
    for (int s = 0; s < 5; ++s) {
        bf16x8 pf; { const unsigned a = pk2(st[2 * s][0], st[2 * s][1]), b = pk2(st[2 * s][2], st[2 * s][3]);
            unsigned c = 0u, d = 0u; if (s < 4) { c = pk2(st[2 * s + 1][0], st[2 * s + 1][1]); d = pk2(st[2 * s + 1][2], st[2 * s + 1][3]); }
            const v4u t = {a, b, c, d}; pf = __builtin_bit_cast(bf16x8, t); }
        LAS const unsigned char* v0 = Vl + (16 * (w + 2 * s) + 4 * fq + q4) * KV_STRIDE + 8 * p4;
#pragma unroll
        for (int dt = 0; dt < 8; ++dt) {
            const s16x4 lo = vtr(v0 + 32 * dt); s16x4 hi = {0, 0, 0, 0}; if (s < 4) hi = vtr(v0 + 16 * KV_STRIDE + 32 * dt);
            const bf16x8 vf = {lo[0], lo[1], lo[2], lo[3], hi[0], hi[1], hi[2], hi[3]};
            o[dt] = __builtin_amdgcn_mfma_f32_16x16x32_bf16(vf, pf, o[dt], 0, 0, 0);
        }
    }
    const float inv = 1.0f / sm;
    bf16* orow = OG + ((size_t)g * S + qpos) * AOW + j * HD + 4 * fq;
#pragma unroll
    for (int dt = 0; dt < 8; ++dt) { v2u wv; wv.x = pk2(o[dt][0] * inv, o[dt][1] * inv); wv.y = pk2(o[dt][2] * inv, o[dt][3] * inv); *(v2u*)(orow + 16 * dt) = wv; }
    if (fq == 0) LSE[((size_t)g * S + qpos) * 4 + j] = mx * 0.6931471805599453f + __logf(sm);
    __syncthreads();
}

__device__ __forceinline__ unsigned okey(float f) { const unsigned u = __float_as_uint(f); return u ^ ((unsigned)((int)u >> 31) | 0x80000000u); }
__device__ __forceinline__ float okey_inv(unsigned k) { return __uint_as_float((k & 0x80000000u) ? (k ^ 0x80000000u) : ~k); }
__device__ __forceinline__ unsigned umed3(unsigned a, unsigned b, unsigned c) { unsigned r; asm("v_med3_u32 %0, %1, %2, %3" : "=v"(r) : "v"(a), "v"(b), "v"(c)); return r; }
__device__ __forceinline__ void ins16k(unsigned (&tk)[16], unsigned key) {
#pragma unroll
    for (int s = 15; s >= 1; --s) tk[s] = umed3(key, tk[s], tk[s - 1]);
    tk[0] = key > tk[0] ? key : tk[0];
}
__device__ __forceinline__ void route8(const float* SC, int tb, int lane, LAS int* eidL, LAS float* gtL, LAS int* lk) {
    const int tl = lane >> 3, h = lane & 7; const float* row = SC + (size_t)(tb + tl) * D + h * 256;
    unsigned k0[16], k1[16];
#pragma unroll
    for (int s = 0; s < 16; ++s) { k0[s] = 0u; k1[s] = 0u; }
#pragma unroll 2
    for (int n4 = 0; n4 < 128; n4 += 4) { const f32x4 v = *(const f32x4*)(row + n4);
#pragma unroll
        for (int e = 0; e < 4; ++e) ins16k(k0, (okey(v[e]) & ~0x7fu) | (unsigned)(127 - n4 - e)); }
#pragma unroll 2
    for (int n4 = 0; n4 < 128; n4 += 4) { const f32x4 v = *(const f32x4*)(row + 128 + n4);
#pragma unroll
        for (int e = 0; e < 4; ++e) ins16k(k1, (okey(v[e]) & ~0x7fu) | (unsigned)(127 - n4 - e)); }
    float a0[16], a1[16];
#pragma unroll
    for (int s = 0; s < 16; ++s) { const int n0 = 127 - (int)(k0[s] & 0x7fu), n1 = 127 - (int)(k1[s] & 0x7fu); lk[s * 64 + lane] = n0; lk[1024 + s * 64 + lane] = n1; a0[s] = row[n0]; a1[s] = row[128 + n1]; }
    unsigned ck[16];
#pragma unroll
    for (int s = 0; s < 16; ++s) ck[s] = 0u;
#pragma unroll
    for (int i = 0; i < 16; ++i)
#pragma unroll
        for (int j = 0; j < 16; ++j) if ((i + 1) * (j + 1) <= 16) ins16k(ck, (okey(a0[i] + a1[j]) & ~0xffu) | (unsigned)(255 - (i * 16 + j)));
    float cs[16]; float mx = -INFINITY;
#pragma unroll
    for (int s = 0; s < 16; ++s) { cs[s] = okey_inv((ck[s] & ~0xffu) | 0x80u); mx = fmaxf(mx, cs[s]); }
    float sum = 0.f;
#pragma unroll
    for (int s = 0; s < 16; ++s) { cs[s] = __expf(cs[s] - mx); sum += cs[s]; }
    const float rs = 1.0f / sum;
#pragma unroll
    for (int s = 0; s < 16; ++s) { const int flat = 255 - (int)(ck[s] & 0xffu); const int i1 = lk[(flat >> 4) * 64 + lane], i2 = lk[1024 + (flat & 15) * 64 + lane];
        eidL[tl * 128 + h * 16 + s] = i1 * NKEY + i2; gtL[tl * 128 + h * 16 + s] = cs[s] * rs; }
}
constexpr int QB = 6, NDW = 6;
constexpr int ROWB = D * QB / 8;
constexpr float QMAXV = 7.5f;
typedef unsigned u32x6 __attribute__((ext_vector_type(6)));
typedef float f32x32 __attribute__((ext_vector_type(32)));
struct QRow { v4u a; v2u b; };
__device__ __forceinline__ QRow qrow_load(const unsigned char* rp, int lane) { QRow r; r.a = *(const v4u*)(rp + 16 * lane); r.b = *(const v2u*)(rp + 1024 + 8 * lane); return r; }
__device__ __forceinline__ f32x32 qrow_dec(const QRow& r) { const u32x6 v = {r.a.x, r.a.y, r.a.z, r.a.w, r.b.x, r.b.y}; return __builtin_amdgcn_cvt_scalef32_pk32_f32_fp6(v, 1.0f); }
__device__ __forceinline__ float qdot(const QRow& r, const float (&x)[32]) { const f32x32 v = qrow_dec(r); float s0 = 0.f, s1 = 0.f, s2 = 0.f, s3 = 0.f;
#pragma unroll
    for (int i = 0; i < 32; i += 4) { s0 += v[i] * x[i]; s1 += v[i + 1] * x[i + 1]; s2 += v[i + 2] * x[i + 2]; s3 += v[i + 3] * x[i + 3]; }
    return (s0 + s1) + (s2 + s3); }
__device__ __forceinline__ void qaxpy(float (&a)[32], const QRow& r, float c) { const f32x32 v = qrow_dec(r);
#pragma unroll
    for (int i = 0; i < 32; ++i) a[i] += c * v[i]; }
__device__ __forceinline__ float reduce8(const float (&d)[8], int lane) {
    const bool h5 = (lane & 32) != 0, h4 = (lane & 16) != 0, h3 = (lane & 8) != 0;
    float e[4], f[2];
#pragma unroll
    for (int i = 0; i < 4; ++i) { const float keep = h5 ? d[i + 4] : d[i], send = h5 ? d[i] : d[i + 4]; e[i] = keep + __shfl_xor(send, 32); }
#pragma unroll
    for (int i = 0; i < 2; ++i) { const float keep = h4 ? e[i + 2] : e[i], send = h4 ? e[i] : e[i + 2]; f[i] = keep + __shfl_xor(send, 16); }
    float g = (h3 ? f[1] : f[0]) + __shfl_xor(h3 ? f[0] : f[1], 8);
    g += __shfl_xor(g, 4); g += __shfl_xor(g, 2); g += __shfl_xor(g, 1);
    return g;
}
__device__ __forceinline__ float wave_maxf(float v) {
#pragma unroll
    for (int o = 1; o < 64; o <<= 1) v = fmaxf(v, __shfl_xor(v, o));
    return v;
}
__device__ __forceinline__ unsigned fp6_code(float y) {
    const float a = fabsf(y);
    const float c = a < 2.0f ? 8.0f * a : (a < 4.0f ? 8.0f + 4.0f * a : 16.0f + 2.0f * a);
    int code = (int)rintf(c); code = code > 31 ? 31 : code;
    return (unsigned)code | (y < 0.f ? 32u : 0u);
}
template <int I> struct QPack { static __device__ __forceinline__ void put(unsigned (&w)[NDW], const float (&v)[32], float inv) {
    constexpr int bit = QB * I, dw = bit >> 5, sh = bit & 31;
    const unsigned f = fp6_code(v[I] * inv);
    w[dw] |= f << sh; if constexpr (sh + QB > 32) w[dw + 1 < NDW ? dw + 1 : dw] |= f >> (32 - sh);
    QPack<I - 1>::put(w, v, inv); } };
template <> struct QPack<-1> { static __device__ __forceinline__ void put(unsigned (&)[NDW], const float (&)[32], float) {} };
__device__ __forceinline__ void quant_row(const float* src, unsigned char* dst, float* scale_out, int lane) {
    float v[32]; float mx = 0.f;
#pragma unroll
    for (int i = 0; i < 8; ++i) { const f32x4 t = *(const f32x4*)(src + 32 * lane + 4 * i); v[4 * i] = t.x; v[4 * i + 1] = t.y; v[4 * i + 2] = t.z; v[4 * i + 3] = t.w;
        mx = fmaxf(mx, fmaxf(fmaxf(fabsf(t.x), fabsf(t.y)), fmaxf(fabsf(t.z), fabsf(t.w)))); }
    mx = wave_maxf(mx);
    const float inv = mx > 0.f ? QMAXV / mx : 0.f;
    unsigned w[NDW];
#pragma unroll
    for (int i = 0; i < NDW; ++i) w[i] = 0u;
    QPack<31>::put(w, v, inv);
    const v4u a = {w[0], w[1], w[2], w[3]}; *(v4u*)(dst + 16 * lane) = a;
    const v2u t = {w[4], w[5]}; *(v2u*)(dst + 1024 + 8 * lane) = t;
    if (lane == 0) *scale_out = mx * (1.0f / QMAXV);
}

struct Args { const float* in[17]; float* out; float* hbuf; unsigned char* ws; int ph_lo, ph_hi, li, pad; };

__global__ void __launch_bounds__(NWAVES * 64, 2) mk_fwd(Args args) {
    extern __shared__ __attribute__((aligned(16))) unsigned char lds_raw[];
    LAS unsigned char* lds = (LAS unsigned char*)lds_raw;
    volatile LAS unsigned* MISC = (volatile LAS unsigned*)(lds + MISC_OFF);
    const int tid = threadIdx.x, lane = tid & 63, wave = __builtin_amdgcn_readfirstlane(tid >> 6);
    const int G = gridDim.x, bx = blockIdx.x;
    const int vcu = (G % 8 == 0) ? (bx % 8) * (G / 8) + bx / 8 : bx;
    const int gw = vcu * NWAVES + wave, NGW = G * NWAVES;
    unsigned char* ws = args.ws;
    const float* x = args.in[0]; const float* cvec = args.in[1]; const float* ada_w = args.in[2]; const float* ada_b = args.in[3]; const float* norm1_g = args.in[4];
    const float* w_in = args.in[5]; const float* pool_mix = args.in[6]; const float* pool_scale = args.in[7]; const float* w_ab = args.in[8]; const float* w_pb = args.in[9];
    const float* w_out = args.in[10]; const float* norm2_g = args.in[11]; const float* wq = args.in[12]; const float* keys = args.in[13]; const float* wdn = args.in[14];
    const float* wup = args.in[15]; const float* final_g = args.in[16];
    float* out = args.out;
    float* mod = (float*)(ws + WS_MOD); float* invf = (float*)(ws + WS_INVF);
    bf16* WAB = (bf16*)(ws + WS_WAB); bf16* WPB = (bf16*)(ws + WS_WPB); bf16* MIX = (bf16*)(ws + WS_MIX); bf16* KEYS = (bf16*)(ws + WS_KEYS);
    bf16* WOUT = (bf16*)(ws + WS_WOUT); bf16* WQ = (bf16*)(ws + WS_WQ); bf16* WIN = (bf16*)(ws + WS_WIN); unsigned char* DOWN = ws + WS_DOWN; unsigned char* UP = ws + WS_UP; float* DSC = (float*)(ws + WS_DSC); float* USC = (float*)(ws + WS_USC);
    bf16* XN = (bf16*)(ws + WS_XN); bf16* OG = (bf16*)(ws + WS_OG); float* LSE = (float*)(ws + WS_LSE);
    bf16* Qb = (bf16*)(ws + WS_Q); bf16* Kb = (bf16*)(ws + WS_K); bf16* Vb = (bf16*)(ws + WS_V); bf16* PIN = (bf16*)(ws + WS_PIN); bf16* GA = (bf16*)(ws + WS_GA); bf16* GB = (bf16*)(ws + WS_GB);
    bf16* DPOOL = (bf16*)(ws + WS_DPOOL); bf16* ATTN = (bf16*)(ws + WS_ATTN); bf16* POOL = (bf16*)(ws + WS_POOL); bf16* MERGED = (bf16*)(ws + WS_MERGED);
    bf16* PQ = (bf16*)(ws + WS_PQ); float* SC = (float*)(ws + WS_SC);
    float* H = args.hbuf;
    const float *shift1 = mod, *scale1 = mod + D, *gate1 = mod + 2 * D, *shift2 = mod + 3 * D, *scale2 = mod + 4 * D, *gate2 = mod + 5 * D;

    for (int u = tid; u < (LDS_BYTES - LDSCTL_OFF) / 4; u += NWAVES * 64) ((LAS unsigned*)(lds + LDSCTL_OFF))[u] = 0u;
    __syncthreads();
    XcdBarrier bar; bar.bar = (unsigned*)(ws + WS_CTL) + CW_BAR; bar.x = 0; bar.st = nullptr;
    if (MK_N_LAUNCHES == 1) bar = xcd_barrier_post((unsigned*)(ws + WS_CTL) + CW_BAR, MISC + 8);
    const int lo = args.ph_lo, hi = args.ph_hi;
#define IN(k) (lo <= (k) && (k) < hi)
#define SEAM(k) do { if (IN(k) && IN((k) + 1)) xcd_barrier(bar); } while (0)

    if (IN(0)) REP(0) {
        for (int chunk = bx; chunk < 6 * D / 48; chunk += G) {
            LAS float* red = (LAS float*)lds;
            const int cq = tid % 12, rg = tid / 12;
            if (rg < 32) {
                f32x4 a = {0.f, 0.f, 0.f, 0.f};
                const float* wp = ada_w + (size_t)(rg * 64) * (6 * D) + chunk * 48 + 4 * cq;
#pragma unroll 8
                for (int i = 0; i < 64; ++i) { const float ci = cvec[rg * 64 + i]; const float sl = ci / (1.0f + __expf(-ci)); a = a + *(const f32x4*)(wp + (size_t)i * (6 * D)) * sl; }
                *(LAS f32x4*)(red + rg * 48 + 4 * cq) = a;
            }
            __syncthreads();
            if (tid < 48) { float s = 0.f;
#pragma unroll 8
                for (int i = 0; i < 32; ++i) s += red[i * 48 + tid];
                mod[chunk * 48 + tid] = s + ada_b[chunk * 48 + tid]; }
            __syncthreads();
        }
        if (gw == 0) invf[lane] = (float)pow(10000.0, -(double)lane / 64.0);
        LAS float* scr = (LAS float*)(lds + wave * 16384);
        constexpr int I_IN = (D / 64) * (INW / 32), I_B = (AOW / 64) * (D / 32), I_O = (D / 64) * (D / 32);
        constexpr int NT_ITEMS = I_IN + 2 * I_B + 2 * I_O;
        for (int it = gw; it < NT_ITEMS; it += NGW) {
            int r = it;
            if (r < I_IN) { p0_transpose_item(w_in, D, INW, WIN, true, scr, r, lane); continue; } r -= I_IN;
            if (r < I_B) { p0_transpose_item(w_ab, AOW, D, WAB, false, scr, r, lane); continue; } r -= I_B;
            if (r < I_B) { p0_transpose_item(w_pb, PW, D, WPB, false, scr, r, lane); continue; } r -= I_B;
            if (r < I_O) { p0_transpose_item(w_out, D, D, WOUT, false, scr, r, lane); continue; } r -= I_O;
            p0_transpose_item(wq, D, D, WQ, false, scr, r, lane);
        }
        for (int n = gw; n < PW; n += NGW) { const int g = n >> 7, d = n & 127, k0 = 8 * lane; v4u o = {0u, 0u, 0u, 0u};
            if ((k0 >> 7) == g) { const float* p = pool_mix + ((size_t)g * 128 + (k0 & 127)) * 128 + d;
                o.x = pk2(p[0], p[128]); o.y = pk2(p[256], p[384]); o.z = pk2(p[512], p[640]); o.w = pk2(p[768], p[896]); }
            *(v4u*)(MIX + (size_t)n * PW + k0) = o; }
        for (int it = gw; it < PH * 128; it += NGW) { const int rowi = 2 * it + (lane >> 5), h = rowi >> 8, nn = rowi & 255, p = nn >> 7, k0 = 8 * (lane & 31); v4u o = {0u, 0u, 0u, 0u};
            if ((k0 >> 7) == p) { const float* s = keys + (((size_t)h * 2 + p) * NKEY + (nn & 127)) * 128 + (k0 & 127); const f32x4 a = *(const f32x4*)s, b = *(const f32x4*)(s + 4); o = pack8(a, b); }
            *(v4u*)(KEYS + (size_t)rowi * 256 + k0) = o; }
        for (int rowi = gw; rowi < 2 * 16384; rowi += NGW) { const int e = rowi & 16383;
            if (rowi < 16384) quant_row(wdn + (size_t)e * D, DOWN + (size_t)e * ROWB, DSC + e, lane); else quant_row(wup + (size_t)e * D, UP + (size_t)e * ROWB, USC + e, lane); }
    }
    SEAM(0);
    if (IN(1)) REP(1) { for (int m = gw; m < S; m += NGW) rmsmod_row(x + (size_t)m * D, norm1_g, scale1, shift1, XN + (size_t)m * D, lane); }
    SEAM(1);
    if (IN(2)) REP(2) {
        pg8::Gemm g{XN, WIN, D, D, S, INW, D, 0}; pg8::StaticOrder So; So.init(S, INW, G, bx);
        EpiInProj E{Qb, Kb, Vb, PIN, GA, GB, invf};
        pg8::gemm_phase<EpiInProj>(lds, g, So, E);
    }
    SEAM(2);
    if (IN(3)) REP(3) {
        for (int u = bx; u < 1536; u += G) attn_unit(lds, u, Qb, Kb, Vb, OG, LSE);
        for (int tb = 8 * gw; tb < S; tb += 8 * NGW) {
            v4u rows[23];
#pragma unroll
            for (int i = 0; i < 23; ++i) { const int tr = tb - 15 + i; const v4u p = *(const v4u*)(PIN + (size_t)(tr < 0 ? 0 : tr) * PW + 8 * lane); const v4u z = {0u, 0u, 0u, 0u}; rows[i] = tr < 0 ? z : p; }
            const int gsel = lane >> 4; const int wszi = 2 << gsel; const float wsz = (float)wszi;
            float sacc[8] = {0.f, 0.f, 0.f, 0.f, 0.f, 0.f, 0.f, 0.f};
#pragma unroll
            for (int i = 0; i < 16; ++i) { const bool in = i < wszi; const v4u rr = rows[15 - i];
#pragma unroll
                for (int c = 0; c < 4; ++c) { sacc[2 * c] += in ? bflo(rr[c]) : 0.f; sacc[2 * c + 1] += in ? bfhi(rr[c]) : 0.f; } }
#pragma unroll
            for (int q = 0; q < 8; ++q) {
                const int t = tb + q; const v4u cur = rows[15 + q];
                if (q > 0) { const v4u o2 = rows[13 + q], o4 = rows[11 + q], o8 = rows[7 + q], o16 = rows[q - 1 < 0 ? 0 : q - 1];
#pragma unroll
                    for (int c = 0; c < 4; ++c) { const unsigned od = gsel == 0 ? o2[c] : (gsel == 1 ? o4[c] : (gsel == 2 ? o8[c] : o16[c]));
                        sacc[2 * c] += bflo(cur[c]) - bflo(od); sacc[2 * c + 1] += bfhi(cur[c]) - bfhi(od); } }
                const float rn = 1.0f / fminf((float)(t + 1), wsz);
                v4u o;
#pragma unroll
                for (int c = 0; c < 4; ++c) o[c] = pk2(sacc[2 * c] * rn - bflo(cur[c]), sacc[2 * c + 1] * rn - bfhi(cur[c]));
                *(v4u*)(DPOOL + (size_t)t * PW + 8 * lane) = o;
            }
        }
    }
    SEAM(3);
    if (IN(4)) REP(4) {
        for (int t = gw; t < S; t += NGW) { const int j = lane >> 4;
            const float l0 = LSE[((size_t)0 * S + t) * 4 + j], l1 = LSE[((size_t)1 * S + t) * 4 + j], l2 = LSE[((size_t)2 * S + t) * 4 + j];
            const float m = fmaxf(l0, fmaxf(l1, l2)); float e0 = __expf(l0 - m), e1 = __expf(l1 - m), e2 = __expf(l2 - m); const float inv = 1.0f / (e0 + e1 + e2); e0 *= inv; e1 *= inv; e2 *= inv;
            const v4u a = *(const v4u*)(OG + ((size_t)0 * S + t) * AOW + 8 * lane), b = *(const v4u*)(OG + ((size_t)1 * S + t) * AOW + 8 * lane), c = *(const v4u*)(OG + ((size_t)2 * S + t) * AOW + 8 * lane);
            v4u o;
            o.x = pk2(e0 * bflo(a.x) + e1 * bflo(b.x) + e2 * bflo(c.x), e0 * bfhi(a.x) + e1 * bfhi(b.x) + e2 * bfhi(c.x));
            o.y = pk2(e0 * bflo(a.y) + e1 * bflo(b.y) + e2 * bflo(c.y), e0 * bfhi(a.y) + e1 * bfhi(b.y) + e2 * bfhi(c.y));
            o.z = pk2(e0 * bflo(a.z) + e1 * bflo(b.z) + e2 * bflo(c.z), e0 * bfhi(a.z) + e1 * bfhi(b.z) + e2 * bfhi(c.z));
            o.w = pk2(e0 * bflo(a.w) + e1 * bflo(b.w) + e2 * bflo(c.w), e0 * bfhi(a.w) + e1 * bfhi(b.w) + e2 * bfhi(c.w));
            *(v4u*)(ATTN + (size_t)t * AOW + 8 * lane) = o; }
        pg8::Gemm g{DPOOL, MIX, PW, PW, S, PW, PW, 0}; pg8::StaticOrder So; So.init(S, PW, G, bx);
        EpiBf16 E{POOL, PW, pool_scale};
        pg8::gemm_phase<EpiBf16>(lds, g, So, E);
    }
    SEAM(4);
    if (IN(5)) REP(5) {
        pg8::StaticOrder So; So.init(S, D, G, bx);
        { pg8::Gemm g{ATTN, WAB, AOW, AOW, S, D, AOW, 0}; EpiGate E{MERGED, GA, 0}; pg8::gemm_phase<EpiGate>(lds, g, So, E); }
        { pg8::Gemm g{POOL, WPB, PW, PW, S, D, PW, 0}; EpiGate E{MERGED, GB, 1}; pg8::gemm_phase<EpiGate>(lds, g, So, E); }
    }
    SEAM(5);
    if (IN(6)) REP(6) {
        pg8::Gemm g{MERGED, WOUT, D, D, S, D, D, 0}; pg8::StaticOrder So; So.init(S, D, G, bx);
        EpiResid E{H, x, gate1};
        pg8::gemm_phase<EpiResid>(lds, g, So, E);
    }
    SEAM(6);
    if (IN(7)) REP(7) { for (int m = gw; m < S; m += NGW) rmsmod_row(H + (size_t)m * D, norm2_g, scale2, shift2, XN + (size_t)m * D, lane); }
    SEAM(7);
    if (IN(8)) REP(8) {
        pg8::Gemm g{XN, WQ, D, D, S, D, D, 0}; pg8::StaticOrder So; So.init(S, D, G, bx);
        EpiBf16 E{PQ, D, nullptr};
        pg8::gemm_phase<EpiBf16>(lds, g, So, E);
    }
    SEAM(8);
    if (IN(9)) REP(9) {
        pg8::Gemm g{PQ, KEYS, D, 256, S, D, 256, 256}; pg8::StaticOrder So; So.init(S, D, G, bx);
        EpiF32 E{SC, D};
        pg8::gemm_phase<EpiF32>(lds, g, So, E);
    }
    SEAM(9);
    if (IN(10)) {
        LAS int* eidL = (LAS int*)(lds + wave * 16384); LAS float* gtL = (LAS float*)(lds + wave * 16384 + 4096); LAS int* lk = (LAS int*)(lds + wave * 16384 + 8192);
        for (int tb = 8 * gw; tb < S; tb += 8 * NGW) {
            route8(SC, tb, lane, eidL, gtL, lk);
            LDS_WAIT(); asm volatile("" ::: "memory");
            for (int tl = 0; tl < 8; ++tl) {
                const int t = tb + tl; LAS int* eid = eidL + tl * 128; LAS float* gt = gtL + tl * 128;
                float xv[32];
#pragma unroll
                for (int q = 0; q < 4; ++q) { const v4u p = *(const v4u*)(XN + (size_t)t * D + 32 * lane + 8 * q);
                    xv[8 * q + 0] = bflo(p.x); xv[8 * q + 1] = bfhi(p.x); xv[8 * q + 2] = bflo(p.y); xv[8 * q + 3] = bfhi(p.y);
                    xv[8 * q + 4] = bflo(p.z); xv[8 * q + 5] = bfhi(p.z); xv[8 * q + 6] = bflo(p.w); xv[8 * q + 7] = bfhi(p.w); }
                const int rid = ((lane >> 5) & 1) * 4 + ((lane >> 4) & 1) * 2 + ((lane >> 3) & 1);
                for (int kb = 0; kb < 128; kb += 8) {
                    QRow buf[8];
#pragma unroll
                    for (int i = 0; i < 8; ++i) { const int ex = __builtin_amdgcn_readfirstlane(eid[kb + i]); buf[i] = qrow_load(DOWN + (size_t)ex * ROWB, lane); }
                    float dd[8];
#pragma unroll
                    for (int i = 0; i < 8; ++i) dd[i] = qdot(buf[i], xv);
                    const float tot = reduce8(dd, lane);
                    const int kk = kb + rid, ex = eid[kk];
                    const float u = DSC[ex] * tot;
                    const float a = 0.5f * u * (1.0f + erff(u * 0.70710678118654752f)) * gt[kk] * USC[ex];
                    if ((lane & 7) == 0) gt[kk] = a;
                }
                LDS_WAIT(); asm volatile("" ::: "memory");
                float acc[32];
#pragma unroll
                for (int i = 0; i < 32; ++i) acc[i] = 0.f;
                for (int kb = 0; kb < 128; kb += 8) {
                    QRow buf[8]; float cc[8];
#pragma unroll
                    for (int i = 0; i < 8; ++i) { const int ex = __builtin_amdgcn_readfirstlane(eid[kb + i]); buf[i] = qrow_load(UP + (size_t)ex * ROWB, lane); cc[i] = gt[kb + i]; }
#pragma unroll
                    for (int i = 0; i < 8; ++i) qaxpy(acc, buf[i], cc[i]);
                }
                float ss = 0.f;
#pragma unroll
                for (int q = 0; q < 8; ++q) { const int c0 = 32 * lane + 4 * q; const f32x4 hh = *(const f32x4*)(H + (size_t)t * D + c0), g2 = *(const f32x4*)(gate2 + c0);
#pragma unroll
                    for (int e = 0; e < 4; ++e) { const float v = hh[e] + g2[e] * acc[4 * q + e]; acc[4 * q + e] = v; ss += v * v; } }
                const float rr = 1.0f / sqrtf(wave_sum(ss) * (1.f / D) + EPS);
#pragma unroll
                for (int q = 0; q < 8; ++q) { const int c0 = 32 * lane + 4 * q; const f32x4 fg = *(const f32x4*)(final_g + c0); f32x4 o;
#pragma unroll
                    for (int e = 0; e < 4; ++e) o[e] = acc[4 * q + e] * rr * fg[e];
                    *(f32x4*)(out + (size_t)t * D + c0) = o; }
            }
            LDS_WAIT(); asm volatile("" ::: "memory");
        }
    }
#undef IN
#undef SEAM
}

extern "C" void kernel_launch(void* const* d_in, const int* in_sizes, int n_in, void* d_out, int out_size, void* d_ws, size_t ws_size, hipStream_t stream) {
    static int grid = 0;
    if (grid == 0) {
        if (n_in != 17 || out_size != S * D || ws_size < WS_END) { fprintf(stderr, "kernel_launch: unexpected shapes (n_in %d, out %d, ws %zu); nothing launched\n", n_in, out_size, ws_size); grid = -1; return; }
        int dev = 0, cus = 0, per_cu = 0;
        if (hipGetDevice(&dev) != hipSuccess || hipDeviceGetAttribute(&cus, hipDeviceAttributeMultiprocessorCount, dev) != hipSuccess) { grid = -1; return; }
        if (hipFuncSetAttribute((const void*)mk_fwd, hipFuncAttributeMaxDynamicSharedMemorySize, LDS_BYTES) != hipSuccess) { fprintf(stderr, "kernel_launch: hipFuncSetAttribute failed\n"); grid = -1; return; }
        if (hipOccupancyMaxActiveBlocksPerMultiprocessor(&per_cu, (const void*)mk_fwd, NWAVES * 64, LDS_BYTES) != hipSuccess || per_cu < 1) { fprintf(stderr, "kernel_launch: occupancy query says %d blocks per CU\n", per_cu); per_cu = 1; }
        (void)hipGetLastError();
        grid = cus;
    }
    if (grid < 0) return;
    (void)hipMemsetAsync((char*)d_ws + WS_CTL, 0, CTL_ZERO_BYTES, stream);
    Args a{};
    for (int i = 0; i < 17; ++i) a.in[i] = (const float*)d_in[i];
    a.out = (float*)d_out; a.hbuf = (float*)d_out; a.ws = (unsigned char*)d_ws;
    if (MK_N_LAUNCHES == 1) {
        a.ph_lo = 0; a.ph_hi = N_PHASES; a.li = 0;
        void* kargs[] = {&a};
        hipError_t e = hipLaunchCooperativeKernel((const void*)mk_fwd, dim3(grid), dim3(NWAVES * 64), kargs, LDS_BYTES, stream);
        if (e != hipSuccess) fprintf(stderr, "kernel_launch: cooperative launch failed: %s (grid %d)\n", hipGetErrorString(e), grid);
    } else {
        for (int li = 0; li < N_PHASES; ++li) { a.ph_lo = li; a.ph_hi = li + 1; a.li = li;
#ifdef DUP_PHASE
            if (li == DUP_PHASE) { Args b = a; if (li == 10) b.out = (float*)((char*)d_ws + 412 * MiB); hipLaunchKernelGGL(mk_fwd, dim3(grid), dim3(NWAVES * 64), LDS_BYTES, stream, b); }
#endif
            hipLaunchKernelGGL(mk_fwd, dim3(grid), dim3(NWAVES * 64), LDS_BYTES, stream, a); }
    }
}
```

```cpp
#include <hip/hip_runtime.h>
#include <cstdio>
#include <cstdint>
#include <cmath>

#ifndef MK_N_LAUNCHES
#define MK_N_LAUNCHES 1
#endif
constexpr int N_PHASES = 14;
#define KN_CHAIN10 1
#define KN_PK10 1
#define KN_CHAIN11 1
#define KN_PK11 1
#ifndef HOST_SPLIT
#define HOST_SPLIT 0
#endif
#ifndef PROBE_PHASE
#define PROBE_PHASE -1
#endif
#define REP(k) for (int _rep = 0; _rep < ((PROBE_PHASE == (k)) ? 2 : 1); ++_rep)

namespace pg8 {
#define PG8_LAS __attribute__((address_space(3)))
typedef unsigned short bf16_t;
typedef short bf16x8 __attribute__((ext_vector_type(8)));
typedef float f32x4 __attribute__((ext_vector_type(4)));
typedef unsigned u32x4 __attribute__((ext_vector_type(4)));
constexpr int BM = 256, BK = 64, HALF = 128, HTB = HALF * BK * 2, STAGE_BYTES = 8 * HTB, NXCD = 8, WGM = 8;

__host__ __device__ __forceinline__ int lds_byte(int r, int c) { const int st = (r >> 4) * 2 + (c >> 5), rr = r & 15, cc = c & 31, ob = rr * 64 + cc * 2; return st * 1024 + (ob ^ (((ob >> 9) & 1) << 5)); }
__host__ __device__ __forceinline__ void stage_rc(int b, int& R, int& C) { const int st = b / 1024, sb = b % 1024, swz = sb ^ (((sb >> 9) & 1) << 5); R = (st >> 1) * 16 + swz / 64; C = (st & 1) * 32 + (swz % 64) / 2; }
__host__ __device__ __forceinline__ int perm32(int rho) { const int n = rho >> 4, i = rho & 15; return 8 * (i >> 2) + 4 * n + (i & 3); }

struct Unit { int pm, pn; };
struct Gemm { const bf16_t* A; const bf16_t* Bt; int lda, ldb, M, N, K; int acol_per_pn; };

struct StaticOrder {
    int nM, nN, nwg, G, c;
    __host__ __device__ void init(int M, int N, int G_, int c_) { nM = M / BM; nN = N / BM; nwg = nM * nN; G = G_; c = c_; }
    __host__ __device__ bool next(int i, Unit& u) const {
        const long L = (long)i * G + c; if (L >= nwg) return false;
        int wgid = (int)L; { const int q = nwg / NXCD, r = nwg % NXCD, xcd = wgid % NXCD, off = wgid / NXCD; wgid = (xcd < r ? xcd * (q + 1) : r * (q + 1) + (xcd - r) * q) + off; }
        const int nig = WGM * nN, gid = wgid / nig, fm = gid * WGM, gsz = (nM - fm) < WGM ? (nM - fm) : WGM;
        u.pm = fm + ((wgid % nig) % gsz); u.pn = (wgid % nig) / gsz; return true;
    }
};

template <class Epi>
__device__ __forceinline__ void gemm_phase(PG8_LAS unsigned char* lds, const Gemm g, const StaticOrder& S, const Epi& E) {
    const int tid = threadIdx.x, wid = __builtin_amdgcn_readfirstlane(tid >> 6), lane = tid & 63, wr = wid >> 2, wc = wid & 3, fr = lane & 15, fq = lane >> 4;
    const int K = g.K, nt = K / BK;
    unsigned voffA[2], voffB[2];
#pragma unroll
    for (int i = 0; i < 2; ++i) { int R, C; stage_rc(tid * 16 + i * 8192, R, C); const int Rb = Epi::PERM ? ((R & ~31) + perm32(R & 31)) : R;
        voffA[i] = (unsigned)(R * g.lda + C) * 2u; voffB[i] = (unsigned)(Rb * g.ldb + C) * 2u; }
    const size_t kstep = (size_t)(BK * 2);
    const size_t hstepA = (size_t)HALF * g.lda * 2, hstepB = (size_t)HALF * g.ldb * 2;
    const size_t tstepA = 2 * hstepA, tstepB = 2 * hstepB, cstepA = (size_t)g.acol_per_pn * 2;
    const unsigned ldsw = (unsigned)wid * 1024u;
    const int aoff = lds_byte(wr * 64 + fr, fq * 8), boff = lds_byte(wc * 32 + fr, fq * 8);
#define PG8_SA(b, h) (((b) * 2 + (h)) * HTB)
#define PG8_SB(b, h) ((4 + (b) * 2 + (h)) * HTB)
#define PG8_STAGE(bufoff, gbase, voff) do { _Pragma("unroll") for (int _i = 0; _i < 2; ++_i) \
        __builtin_amdgcn_global_load_lds((const unsigned*)((const char*)(gbase) + (voff)[_i]), (PG8_LAS unsigned*)(lds + (bufoff) + ldsw + _i * 8192), 16, 0, 0); } while (0)
#define PG8_LDA(dst, b, h) do { _Pragma("unroll") for (int m = 0; m < 4; ++m) _Pragma("unroll") for (int k = 0; k < 2; ++k) dst[m][k] = *(const PG8_LAS bf16x8*)(lds + PG8_SA(b, h) + aoff + m * 2048 + k * 1024); } while (0)
#define PG8_LDB(dst, b, h) do { _Pragma("unroll") for (int n = 0; n < 2; ++n) _Pragma("unroll") for (int k = 0; k < 2; ++k) dst[n][k] = *(const PG8_LAS bf16x8*)(lds + PG8_SB(b, h) + boff + n * 2048 + k * 1024); } while (0)
#define PG8_MMA(ai, bj, At, Bt) do { __builtin_amdgcn_s_setprio(1); _Pragma("unroll") for (int m = 0; m < 4; ++m) _Pragma("unroll") for (int n = 0; n < 2; ++n) _Pragma("unroll") for (int k = 0; k < 2; ++k) \
        acc[ai][bj][m][n] = __builtin_amdgcn_mfma_f32_16x16x32_bf16(Bt[n][k], At[m][k], acc[ai][bj][m][n], 0, 0, 0); __builtin_amdgcn_s_setprio(0); } while (0)
#define PG8_WAIT_V(n) asm volatile("s_waitcnt vmcnt(" #n ")" ::: "memory")
#define PG8_WAIT_L(n) asm volatile("s_waitcnt lgkmcnt(" #n ")" ::: "memory")
#define PG8_BAR __builtin_amdgcn_s_barrier()
#define PG8_SCHED __builtin_amdgcn_sched_barrier(0)
    Unit cur, nxt; int ui = 0;
    if (!S.next(0, cur)) return;
    f32x4 acc[2][2][4][2];
#pragma unroll
    for (int a = 0; a < 2; ++a)
#pragma unroll
        for (int b = 0; b < 2; ++b)
#pragma unroll
            for (int m = 0; m < 4; ++m)
#pragma unroll
                for (int n = 0; n < 2; ++n) acc[a][b][m][n] = (f32x4){0.f, 0.f, 0.f, 0.f};
    bf16x8 At[4][2], B0[2][2], B1[2][2];
    const char* cA = (const char*)g.A + (size_t)cur.pm * tstepA + (size_t)cur.pn * cstepA; const char* cB = (const char*)g.Bt + (size_t)cur.pn * tstepB;
    PG8_STAGE(PG8_SB(0, 0), cB, voffB); PG8_STAGE(PG8_SB(0, 1), cB + hstepB, voffB); PG8_STAGE(PG8_SA(0, 0), cA, voffA); PG8_STAGE(PG8_SA(0, 1), cA + hstepA, voffA);
    if (wr == 1) PG8_BAR;
    PG8_WAIT_V(2); PG8_BAR;
    PG8_STAGE(PG8_SB(1, 0), cB + kstep, voffB); PG8_STAGE(PG8_SA(1, 0), cA + kstep, voffA); PG8_STAGE(PG8_SB(1, 1), cB + hstepB + kstep, voffB);
    PG8_WAIT_V(6); PG8_BAR;
    for (;;) {
        const bool has_next = S.next(ui + 1, nxt);
        const char* nA = has_next ? (const char*)g.A + (size_t)nxt.pm * tstepA + (size_t)nxt.pn * cstepA : cA; const char* nB = has_next ? (const char*)g.Bt + (size_t)nxt.pn * tstepB : cB;
        for (int t = 0; t < nt; t += 2) {
            const bool last = (t == nt - 2);
            const char* a1 = cA + (size_t)(t + 1) * kstep;
            const char* a2 = last ? nA : cA + (size_t)(t + 2) * kstep; const char* b2 = last ? nB : cB + (size_t)(t + 2) * kstep;
            const char* a3 = a2 + kstep; const char* b3 = b2 + kstep;
            PG8_LDB(B0, 0, 0); PG8_LDB(B1, 0, 1); PG8_SCHED; PG8_LDA(At, 0, 0); PG8_STAGE(PG8_SA(1, 1), a1 + hstepA, voffA);
            PG8_WAIT_V(8); PG8_WAIT_L(0); PG8_BAR; PG8_MMA(0, 0, At, B0); PG8_MMA(0, 1, At, B1); PG8_BAR; PG8_SCHED;
            PG8_LDA(At, 0, 1); PG8_STAGE(PG8_SB(0, 0), b2, voffB); PG8_STAGE(PG8_SB(0, 1), b2 + hstepB, voffB); PG8_STAGE(PG8_SA(0, 0), a2, voffA);
            PG8_WAIT_V(8); PG8_WAIT_L(0); PG8_BAR; PG8_MMA(1, 0, At, B0); PG8_MMA(1, 1, At, B1); PG8_BAR; PG8_SCHED;
            PG8_LDB(B0, 1, 0); PG8_LDB(B1, 1, 1); PG8_SCHED; PG8_LDA(At, 1, 0); PG8_STAGE(PG8_SA(0, 1), a2 + hstepA, voffA);
            PG8_WAIT_V(8); PG8_WAIT_L(0); PG8_BAR; PG8_MMA(0, 0, At, B0); PG8_MMA(0, 1, At, B1); PG8_BAR; PG8_SCHED;
            PG8_LDA(At, 1, 1); PG8_STAGE(PG8_SB(1, 0), b3, voffB); PG8_STAGE(PG8_SB(1, 1), b3 + hstepB, voffB); PG8_STAGE(PG8_SA(1, 0), a3, voffA);
            PG8_WAIT_V(8); PG8_WAIT_L(0); PG8_BAR; PG8_MMA(1, 0, At, B0); PG8_MMA(1, 1, At, B1); PG8_BAR; PG8_SCHED;
        }
        if (wr == 0) PG8_BAR;
        E(acc, cur, wr, wc, fr, fq);
        if (!has_next) break;
#pragma unroll
        for (int a = 0; a < 2; ++a)
#pragma unroll
            for (int b = 0; b < 2; ++b)
#pragma unroll
                for (int m = 0; m < 4; ++m)
#pragma unroll
                    for (int n = 0; n < 2; ++n) acc[a][b][m][n] = (f32x4){0.f, 0.f, 0.f, 0.f};
        cur = nxt; cA = nA; cB = nB; ++ui;
        if (wr == 1) PG8_BAR;
    }
    PG8_WAIT_V(0);
    PG8_BAR;
#undef PG8_SA
#undef PG8_SB
#undef PG8_STAGE
#undef PG8_LDA
#undef PG8_LDB
#undef PG8_MMA
#undef PG8_WAIT_V
#undef PG8_WAIT_L
#undef PG8_BAR
#undef PG8_SCHED
}
typedef int v8i32_t __attribute__((ext_vector_type(8)));
typedef int v4i32_t __attribute__((ext_vector_type(4)));
template <class Epi>
__device__ __forceinline__ void gemm_phase_f8n(PG8_LAS unsigned char* lds, const Gemm g, const StaticOrder& S, const Epi& E) {
    const int tid = threadIdx.x, wid = __builtin_amdgcn_readfirstlane(tid >> 6), lane = tid & 63, wr = wid >> 2, wc = wid & 3, fr = lane & 15, fq = lane >> 4;
    const int K = g.K, nt = K / BK;
    unsigned voffA[2], voffB[2];
#pragma unroll
    for (int i = 0; i < 2; ++i) { int R, C; stage_rc(tid * 16 + i * 8192, R, C); const int Rb = Epi::PERM ? ((R & ~31) + perm32(R & 31)) : R;
        voffA[i] = (unsigned)(R * g.lda + C) * 2u; voffB[i] = (unsigned)(Rb * g.ldb + C) * 2u; }
    const size_t kstep = (size_t)(BK * 2);
    const size_t hstepA = (size_t)HALF * g.lda * 2, hstepB = (size_t)HALF * g.ldb * 2;
    const size_t tstepA = 2 * hstepA, tstepB = 2 * hstepB, cstepA = (size_t)g.acol_per_pn * 2;
    const unsigned ldsw = (unsigned)wid * 1024u;
    const int aoff = lds_byte(wr * 64 + fr, fq * 8), boff = lds_byte(wc * 32 + fr, fq * 8);
#define PG8_SA(b, h) (((b) * 2 + (h)) * HTB)
#define PG8_SB(b, h) ((4 + (b) * 2 + (h)) * HTB)
#define PG8_STAGE(bufoff, gbase, voff) do { _Pragma("unroll") for (int _i = 0; _i < 2; ++_i) \
        __builtin_amdgcn_global_load_lds((const unsigned*)((const char*)(gbase) + (voff)[_i]), (PG8_LAS unsigned*)(lds + (bufoff) + ldsw + _i * 8192), 16, 0, 0); } while (0)
#define PG8_LDA(dst, b, h) do { _Pragma("unroll") for (int m = 0; m < 4; ++m) _Pragma("unroll") for (int k = 0; k < 2; ++k) dst[m][k] = *(const PG8_LAS bf16x8*)(lds + PG8_SA(b, h) + aoff + m * 2048 + k * 1024); } while (0)
#define PG8_LDB(dst, b, h) do { _Pragma("unroll") for (int n = 0; n < 2; ++n) _Pragma("unroll") for (int k = 0; k < 2; ++k) dst[n][k] = *(const PG8_LAS bf16x8*)(lds + PG8_SB(b, h) + boff + n * 2048 + k * 1024); } while (0)
#define PG8_CAT(x) __builtin_shufflevector(__builtin_bit_cast(v4i32_t, x[0]), __builtin_bit_cast(v4i32_t, x[1]), 0, 1, 2, 3, 4, 5, 6, 7)
#define PG8_MMA(ai, bj, At, Bt) do { __builtin_amdgcn_s_setprio(1); _Pragma("unroll") for (int m = 0; m < 4; ++m) _Pragma("unroll") for (int n = 0; n < 2; ++n) \
        acc[ai][bj][m][n] = __builtin_amdgcn_mfma_scale_f32_16x16x128_f8f6f4(PG8_CAT(Bt[n]), PG8_CAT(At[m]), acc[ai][bj][m][n], 0, 0, 0, 0x7f7f7f7f, 0, 0x7f7f7f7f); __builtin_amdgcn_s_setprio(0); } while (0)
#define PG8_WAIT_V(n) asm volatile("s_waitcnt vmcnt(" #n ")" ::: "memory")
#define PG8_WAIT_L(n) asm volatile("s_waitcnt lgkmcnt(" #n ")" ::: "memory")
#define PG8_BAR __builtin_amdgcn_s_barrier()
#define PG8_SCHED __builtin_amdgcn_sched_barrier(0)
    Unit cur, nxt; int ui = 0;
    if (!S.next(0, cur)) return;
    f32x4 acc[2][2][4][2];
#pragma unroll
    for (int a = 0; a < 2; ++a)
#pragma unroll
        for (int b = 0; b < 2; ++b)
#pragma unroll
            for (int m = 0; m < 4; ++m)
#pragma unroll
                for (int n = 0; n < 2; ++n) acc[a][b][m][n] = (f32x4){0.f, 0.f, 0.f, 0.f};
    bf16x8 At[4][2], B0[2][2];
    const char* cA = (const char*)g.A + (size_t)cur.pm * tstepA + (size_t)cur.pn * cstepA; const char* cB = (const char*)g.Bt + (size_t)cur.pn * hstepB;
    PG8_STAGE(PG8_SB(0, 0), cB, voffB); PG8_STAGE(PG8_SA(0, 0), cA, voffA); PG8_STAGE(PG8_SA(0, 1), cA + hstepA, voffA);
    if (wr == 1) PG8_BAR;
    PG8_WAIT_V(2); PG8_BAR;
    PG8_STAGE(PG8_SB(1, 0), cB + kstep, voffB); PG8_STAGE(PG8_SA(1, 0), cA + kstep, voffA);
    PG8_WAIT_V(4); PG8_BAR;
    for (;;) {
        const bool has_next = S.next(ui + 1, nxt);
        const char* nA = has_next ? (const char*)g.A + (size_t)nxt.pm * tstepA + (size_t)nxt.pn * cstepA : cA; const char* nB = has_next ? (const char*)g.Bt + (size_t)nxt.pn * hstepB : cB;
        for (int t = 0; t < nt; t += 2) {
            const bool last = (t == nt - 2);
            const char* a1 = cA + (size_t)(t + 1) * kstep;
            const char* a2 = last ? nA : cA + (size_t)(t + 2) * kstep; const char* b2 = last ? nB : cB + (size_t)(t + 2) * kstep;
            const char* a3 = a2 + kstep; const char* b3 = b2 + kstep;
            PG8_LDB(B0, 0, 0); PG8_SCHED; PG8_LDA(At, 0, 0); PG8_STAGE(PG8_SA(1, 1), a1 + hstepA, voffA);
            PG8_WAIT_V(6); PG8_WAIT_L(0); PG8_BAR; PG8_MMA(0, 0, At, B0); PG8_BAR; PG8_SCHED;
            PG8_LDA(At, 0, 1); PG8_STAGE(PG8_SB(0, 0), b2, voffB); PG8_STAGE(PG8_SA(0, 0), a2, voffA);
            PG8_WAIT_V(6); PG8_WAIT_L(0); PG8_BAR; PG8_MMA(1, 0, At, B0); PG8_BAR; PG8_SCHED;
            PG8_LDB(B0, 1, 0); PG8_SCHED; PG8_LDA(At, 1, 0); PG8_STAGE(PG8_SA(0, 1), a2 + hstepA, voffA);
            PG8_WAIT_V(6); PG8_WAIT_L(0); PG8_BAR; PG8_MMA(0, 0, At, B0); PG8_BAR; PG8_SCHED;
            PG8_LDA(At, 1, 1); PG8_STAGE(PG8_SB(1, 0), b3, voffB); PG8_STAGE(PG8_SA(1, 0), a3, voffA);
            PG8_WAIT_V(6); PG8_WAIT_L(0); PG8_BAR; PG8_MMA(1, 0, At, B0); PG8_BAR; PG8_SCHED;
        }
        if (wr == 0) PG8_BAR;
        E(acc, cur, wr, wc, fr, fq);
        if (!has_next) break;
#pragma unroll
        for (int a = 0; a < 2; ++a)
#pragma unroll
            for (int b = 0; b < 2; ++b)
#pragma unroll
                for (int m = 0; m < 4; ++m)
#pragma unroll
                    for (int n = 0; n < 2; ++n) acc[a][b][m][n] = (f32x4){0.f, 0.f, 0.f, 0.f};
        cur = nxt; cA = nA; cB = nB; ++ui;
        if (wr == 1) PG8_BAR;
    }
    PG8_WAIT_V(0);
    PG8_BAR;
#undef PG8_SA
#undef PG8_SB
#undef PG8_STAGE
#undef PG8_LDA
#undef PG8_LDB
#undef PG8_MMA
#undef PG8_CAT
#undef PG8_WAIT_V
#undef PG8_WAIT_L
#undef PG8_BAR
#undef PG8_SCHED
}
}

constexpr int S = 16384, D = 2048, AW = 1536, NH = 12, HD = 128, AOW = 512, PW = 512, INW = 9216;
constexpr int PH = 8, PK = 16, NKEY = 128;
constexpr float EPS = 1e-6f;
constexpr float QSCALE = 0.08838834764831845f * 1.4426950408889634f;
constexpr int NWAVES = 8;

constexpr size_t MiB = 1u << 20;
constexpr size_t WS_CTL = 0, CTL_ZERO_BYTES = 1 * MiB;
constexpr size_t WS_MOD = 512 * 1024;
constexpr size_t WS_INVF = 1 * MiB;
constexpr size_t WS_DSC = 1 * MiB + 65536, WS_USC = 1 * MiB + 131072;
constexpr size_t WS_CSUM = 1 * MiB + 786432;
constexpr size_t WS_G2S = 1 * MiB + 925696;
constexpr size_t WS_CVEC = 1 * MiB + 851968;
constexpr size_t WS_RR = 1 * MiB + 860160;
constexpr size_t WS_SSP = 6 * MiB;
constexpr size_t WS_SSQ = 1 * MiB + 196608;
constexpr size_t WS_EID = 396 * MiB, WS_GATE = 404 * MiB;
constexpr size_t WS_DSCT = 412 * MiB;
constexpr size_t WS_UPART = 252 * MiB;
constexpr size_t WS_WAB = 2 * MiB, WS_WPB = 4 * MiB, WS_MIX = 6 * MiB, WS_KEYS = 7 * MiB, WS_WOUT = 8 * MiB, WS_WQ = 16 * MiB, WS_WIN = 24 * MiB;
constexpr size_t WS_DOWN = 60 * MiB, WS_UP = 124 * MiB;
constexpr size_t WS_XN = 188 * MiB;
constexpr size_t WS_OG = 188 * MiB, WS_LSE = 236 * MiB;
constexpr size_t WS_Q = 252 * MiB, WS_K = 300 * MiB, WS_V = 348 * MiB, WS_PIN = 396 * MiB, WS_GA = 412 * MiB, WS_GB = 476 * MiB;
constexpr size_t WS_DPOOL = 24 * MiB, WS_ATTN = 40 * MiB;
constexpr size_t WS_POOL = 252 * MiB;
constexpr size_t WS_MERGED = 300 * MiB;
constexpr size_t WS_PQ = 412 * MiB;
constexpr size_t WS_VB = 316 * MiB;
constexpr size_t WS_HB = 476 * MiB;
constexpr size_t WS_SC = 252 * MiB;
constexpr size_t WS_XN8 = 540 * MiB;
constexpr size_t WS_WIN8 = 572 * MiB;
constexpr size_t WS_END = 580 * MiB;
constexpr int CW_BAR = 4096;

constexpr int RING_BYTES = 147456;
constexpr int LDSCTL_OFF = RING_BYTES, MISC_OFF = LDSCTL_OFF + 320;
constexpr int LDS_BYTES = RING_BYTES + 1024;

#define GAS __attribute__((address_space(1)))
#define LAS __attribute__((address_space(3)))
typedef unsigned short bf16;
typedef unsigned v4u __attribute__((ext_vector_type(4)));
typedef unsigned v2u __attribute__((ext_vector_type(2)));
typedef float f32x4 __attribute__((ext_vector_type(4)));
typedef float f32x2 __attribute__((ext_vector_type(2)));
typedef short bf16x8 __attribute__((ext_vector_type(8)));
typedef short s16x4 __attribute__((ext_vector_type(4)));
typedef __bf16 bf16x2_t __attribute__((ext_vector_type(2)));
#define LDS_WAIT() asm volatile("s_waitcnt lgkmcnt(0)" ::: "memory")
#define VM_WAIT() asm volatile("s_waitcnt vmcnt(0)" ::: "memory")
__device__ __forceinline__ unsigned pk2(float lo, float hi) { f32x2 v = {lo, hi}; bf16x2_t b = __builtin_convertvector(v, bf16x2_t); return __builtin_bit_cast(unsigned, b); }
__device__ __forceinline__ float bflo(unsigned u) { return __uint_as_float(u << 16); }
__device__ __forceinline__ float bfhi(unsigned u) { return __uint_as_float(u & 0xffff0000u); }
__device__ __forceinline__ float wave_sum(float v) {
#pragma unroll
    for (int o = 1; o < 64; o <<= 1) v += __shfl_xor(v, o);
    return v;
}

#define XB_TMO      128
#define XB_XCNT(j)  (256  + 64 * (j))
#define XB_XSUB(j)  (1280 + 64 * (j))
#define XB_XGEN(j)  (2304 + 64 * (j))
#define XB_TOP      3328
#define XB_TOPGEN   3392
#define XCD_BAR_WORDS 3456
#define XB_SPIN_CAP (1u << 22)
__device__ __forceinline__ unsigned xb_ld(unsigned* p)              { return __hip_atomic_load(p, __ATOMIC_RELAXED, __HIP_MEMORY_SCOPE_AGENT); }
__device__ __forceinline__ unsigned xb_add(unsigned* p, unsigned v) { return __hip_atomic_fetch_add(p, v, __ATOMIC_RELAXED, __HIP_MEMORY_SCOPE_AGENT); }
__device__ __forceinline__ unsigned xb_xcc_id() { return (unsigned)__builtin_amdgcn_s_getreg((3 << 11) | 20) & 0xFu; }
#define XB_SPIN(cond, bar) do { unsigned _sp = 0; while (cond) { __builtin_amdgcn_s_sleep(1); \
    if ((++_sp & 255u) == 0u) { if (xb_ld(&(bar)[XB_TMO])) break; if (_sp > XB_SPIN_CAP) { atomicAdd(&(bar)[XB_TMO], 1u); break; } } } } while (0)
struct XcdBarrier { unsigned* bar; unsigned x; volatile LAS unsigned* st; };
__device__ __forceinline__ XcdBarrier xcd_barrier_post(unsigned* bar, volatile LAS unsigned* st) {
    XcdBarrier b; b.bar = bar; b.x = xb_xcc_id(); b.st = st;
    if (threadIdx.x == 0) (void)xb_add(&bar[XB_XCNT(b.x)], 1u);
    return b;
}
__device__ __forceinline__ void xcd_barrier_complete(unsigned* bar, unsigned x, unsigned& nloc, unsigned& nx) {
    const unsigned G = gridDim.x * gridDim.y * gridDim.z;
    unsigned sum, cnt, mine, sp = 0u;
    for (;;) {
        sum = 0u; cnt = 0u; mine = 0u;
#pragma unroll
        for (unsigned j = 0; j < 16; ++j) { const unsigned c = xb_ld(&bar[XB_XCNT(j)]); sum += c; cnt += (c > 0u) ? 1u : 0u; mine = (j == x) ? c : mine; }
        if (sum == G) break;
        __builtin_amdgcn_s_sleep(1);
        if ((++sp & 255u) == 0u) { if (xb_ld(&bar[XB_TMO])) break; if (sp > XB_SPIN_CAP) { atomicAdd(&bar[XB_TMO], 1u); break; } }
    }
    nloc = mine > 0u ? mine : 1u; nx = cnt > 0u ? cnt : 1u;
}
__device__ __forceinline__ void xcd_barrier(const XcdBarrier& b) {
    asm volatile("s_waitcnt vmcnt(0)" ::: "memory");
    __syncthreads();
    if (threadIdx.x == 0) {
        unsigned* bar = b.bar;
        __builtin_amdgcn_s_waitcnt(0);
        unsigned nloc = b.st[0], nx = b.st[1];
        if (nloc == 0u) { xcd_barrier_complete(bar, b.x, nloc, nx); b.st[0] = nloc; b.st[1] = nx; }
        const unsigned old = xb_add(&bar[XB_XSUB(b.x)], 1u);
        const unsigned gen = old / nloc;
        if (old + 1u == (gen + 1u) * nloc) {
            __builtin_amdgcn_fence(__ATOMIC_RELEASE, "agent");
            asm volatile("s_waitcnt vmcnt(0)" ::: "memory");
            const unsigned og = xb_add(&bar[XB_TOP], 1u);
            const unsigned tg = og / nx;
            if (og + 1u == (tg + 1u) * nx) xb_add(&bar[XB_TOPGEN], 1u);
            else XB_SPIN(xb_ld(&bar[XB_TOPGEN]) == tg, bar);
            __builtin_amdgcn_fence(__ATOMIC_ACQUIRE, "agent");
            xb_add(&bar[XB_XGEN(b.x)], 1u);
            asm volatile("s_waitcnt vmcnt(0)" ::: "memory");
        } else {
            XB_SPIN(xb_ld(&bar[XB_XGEN(b.x)]) == gen, bar);
            __builtin_amdgcn_fence(__ATOMIC_ACQUIRE, "agent");
            asm volatile("s_waitcnt vmcnt(0)" ::: "memory");
        }
    }
    __syncthreads();
}

using pg8::Unit;
__device__ __forceinline__ v4u pack8(const f32x4 a, const f32x4 b) { v4u w; w.x = pk2(a[0], a[1]); w.y = pk2(a[2], a[3]); w.z = pk2(b[0], b[1]); w.w = pk2(b[2], b[3]); return w; }

typedef _Float16 h16x2 __attribute__((ext_vector_type(2)));
__device__ __forceinline__ unsigned pkh2(float a, float b) { const h16x2 v = {(_Float16)a, (_Float16)b}; return __builtin_bit_cast(unsigned, v); }
struct EpiInProj {
    static constexpr bool PERM = true;
    bf16 *Q, *K, *V, *PIN, *GA, *GB; const float* invf;
    __device__ __forceinline__ void operator()(const f32x4 (&acc)[2][2][4][2], const Unit& u, int wr, int wc, int fr, int fq) const {
        const int pn = u.pn, row0 = u.pm * 256 + wr * 64 + fr, cl = wc * 32 + 8 * fq;
        if (pn < 12) {
            bf16* base = pn < 6 ? Q : K; const int ct = (pn < 6 ? pn : pn - 6) * 256; const float qs = pn < 6 ? QSCALE : 1.0f;
            float inv[4];
#pragma unroll
            for (int i = 0; i < 4; ++i) inv[i] = invf[(cl >> 1) + i];
#pragma unroll
            for (int ai = 0; ai < 2; ++ai)
#pragma unroll
                for (int m = 0; m < 4; ++m) {
                    const int row = row0 + ai * 128 + m * 16;
                    float cs[4], sn[4];
#pragma unroll
                    for (int i = 0; i < 4; ++i) { const float ang = (float)row * inv[i]; double rev = (double)ang * 0.15915494309189533577; rev -= rint(rev);
                        sn[i] = __builtin_amdgcn_sinf((float)rev) * qs; cs[i] = __builtin_amdgcn_cosf((float)rev) * qs; }
#pragma unroll
                    for (int bj = 0; bj < 2; ++bj) {
                        const f32x4 v0 = acc[ai][bj][m][0], v1 = acc[ai][bj][m][1]; f32x4 o0, o1;
                        o0[0] = v0[0] * cs[0] - v0[1] * sn[0]; o0[1] = v0[1] * cs[0] + v0[0] * sn[0]; o0[2] = v0[2] * cs[1] - v0[3] * sn[1]; o0[3] = v0[3] * cs[1] + v0[2] * sn[1];
                        o1[0] = v1[0] * cs[2] - v1[1] * sn[2]; o1[1] = v1[1] * cs[2] + v1[0] * sn[2]; o1[2] = v1[2] * cs[3] - v1[3] * sn[3]; o1[3] = v1[3] * cs[3] + v1[2] * sn[3];
                        *(v4u*)(base + (size_t)row * AW + ct + bj * 128 + cl) = pack8(o0, o1);
                    }
                }
        } else if (pn < 20) {
            bf16* base = pn < 18 ? V : PIN; const int ct = (pn < 18 ? pn - 12 : pn - 18) * 256; const int ld = pn < 18 ? AW : PW;
#pragma unroll
            for (int ai = 0; ai < 2; ++ai)
#pragma unroll
                for (int m = 0; m < 4; ++m) { const int row = row0 + ai * 128 + m * 16;
#pragma unroll
                    for (int bj = 0; bj < 2; ++bj) *(v4u*)(base + (size_t)row * ld + ct + bj * 128 + cl) = pack8(acc[ai][bj][m][0], acc[ai][bj][m][1]); }
        } else {
            bf16* base = pn < 28 ? GA : GB; const int ct = (pn < 28 ? pn - 20 : pn - 28) * 256;
#pragma unroll
            for (int ai = 0; ai < 2; ++ai)
#pragma unroll
                for (int m = 0; m < 4; ++m) { const int row = row0 + ai * 128 + m * 16;
#pragma unroll
                    for (int bj = 0; bj < 2; ++bj) { f32x4 a = acc[ai][bj][m][0], b = acc[ai][bj][m][1];
#pragma unroll
                        for (int e = 0; e < 4; ++e) { a[e] = __builtin_amdgcn_rcpf(1.0f + __expf(-a[e])); b[e] = __builtin_amdgcn_rcpf(1.0f + __expf(-b[e])); }
                        *(v4u*)(base + (size_t)row * D + ct + bj * 128 + cl) = pack8(a, b); } }
        }
    }
};
struct EpiGates8n {
    static constexpr bool PERM = true;
    bf16 *GA, *GB;
    __device__ __forceinline__ void operator()(const f32x4 (&acc)[2][2][4][2], const Unit& u, int wr, int wc, int fr, int fq) const {
        const int pn = u.pn, row0 = u.pm * 256 + wr * 64 + fr, cl = wc * 32 + 8 * fq;
        bf16* base = pn < 16 ? GA : GB; const int ct = (pn & 15) * 128;
#pragma unroll
        for (int ai = 0; ai < 2; ++ai)
#pragma unroll
            for (int m = 0; m < 4; ++m) { const int row = row0 + ai * 128 + m * 16; f32x4 a = acc[ai][0][m][0], b = acc[ai][0][m][1];
#pragma unroll
                for (int e = 0; e < 4; ++e) { a[e] = __builtin_amdgcn_rcpf(1.0f + __expf(-0.015625f * a[e])); b[e] = __builtin_amdgcn_rcpf(1.0f + __expf(-0.015625f * b[e])); }
                *(v4u*)(base + (size_t)row * D + ct + cl) = pack8(a, b); }
    }
};
struct EpiBf16 {
    static constexpr bool PERM = true;
    bf16* O; int ld; const float* colscale;
    __device__ __forceinline__ void operator()(const f32x4 (&acc)[2][2][4][2], const Unit& u, int wr, int wc, int fr, int fq) const {
        const int row0 = u.pm * 256 + wr * 64 + fr, col0 = u.pn * 256 + wc * 32 + 8 * fq;
        f32x4 s[2][2];
#pragma unroll
        for (int bj = 0; bj < 2; ++bj)
#pragma unroll
            for (int n = 0; n < 2; ++n) s[bj][n] = colscale ? *(const f32x4*)(colscale + col0 + bj * 128 + 4 * n) : (f32x4){1.f, 1.f, 1.f, 1.f};
#pragma unroll
        for (int ai = 0; ai < 2; ++ai)
#pragma unroll
            for (int m = 0; m < 4; ++m) { const int row = row0 + ai * 128 + m * 16;
#pragma unroll
                for (int bj = 0; bj < 2; ++bj) *(v4u*)(O + (size_t)row * ld + col0 + bj * 128) = pack8(acc[ai][bj][m][0] * s[bj][0], acc[ai][bj][m][1] * s[bj][1]); }
    }
};
struct EpiGate {
    static constexpr bool PERM = true;
    bf16* O; const bf16* G; int accum;
    __device__ __forceinline__ void operator()(const f32x4 (&acc)[2][2][4][2], const Unit& u, int wr, int wc, int fr, int fq) const {
        const int row0 = u.pm * 256 + wr * 64 + fr, col0 = u.pn * 256 + wc * 32 + 8 * fq;
#pragma unroll
        for (int ai = 0; ai < 2; ++ai) {
            v4u gv[4][2], pv[4][2];
#pragma unroll
            for (int m = 0; m < 4; ++m)
#pragma unroll
                for (int bj = 0; bj < 2; ++bj) { const size_t off = (size_t)(row0 + ai * 128 + m * 16) * D + col0 + bj * 128;
                    gv[m][bj] = *(const v4u*)(G + off); pv[m][bj] = accum ? *(const v4u*)(O + off) : (v4u){0u, 0u, 0u, 0u}; }
#pragma unroll
            for (int m = 0; m < 4; ++m)
#pragma unroll
                for (int bj = 0; bj < 2; ++bj) { const size_t off = (size_t)(row0 + ai * 128 + m * 16) * D + col0 + bj * 128;
                    const v4u g = gv[m][bj], p = pv[m][bj]; f32x4 a = acc[ai][bj][m][0], b = acc[ai][bj][m][1];
                    a[0] = a[0] * bflo(g.x) + bflo(p.x); a[1] = a[1] * bfhi(g.x) + bfhi(p.x); a[2] = a[2] * bflo(g.y) + bflo(p.y); a[3] = a[3] * bfhi(g.y) + bfhi(p.y);
                    b[0] = b[0] * bflo(g.z) + bflo(p.z); b[1] = b[1] * bfhi(g.z) + bfhi(p.z); b[2] = b[2] * bflo(g.w) + bflo(p.w); b[3] = b[3] * bfhi(g.w) + bfhi(p.w);
                    *(v4u*)(O + off) = pack8(a, b); }
        }
    }
};
struct EpiResid {
    static constexpr bool PERM = false;
    float* H; const float* x; const float* gate;
    __device__ __forceinline__ void operator()(const f32x4 (&acc)[2][2][4][2], const Unit& u, int wr, int wc, int fr, int fq) const {
        const int row0 = u.pm * 256 + wr * 64 + fr, col0 = u.pn * 256 + wc * 32 + 4 * fq;
#pragma unroll
        for (int ai = 0; ai < 2; ++ai)
#pragma unroll
            for (int m = 0; m < 4; ++m) { const int row = row0 + ai * 128 + m * 16;
#pragma unroll
                for (int bj = 0; bj < 2; ++bj)
#pragma unroll
                    for (int n = 0; n < 2; ++n) { const int col = col0 + bj * 128 + n * 16; const size_t off = (size_t)row * D + col;
                        const f32x4 g = *(const f32x4*)(gate + col), xx = *(const f32x4*)(x + off); *(f32x4*)(H + off) = xx + g * acc[ai][bj][m][n]; } }
    }
};
struct EpiResid2 {
    static constexpr bool PERM = false;
    bf16* H; const float* x; const float* gate; bf16* A2; const float* g2s; float* SSP;
    __device__ __forceinline__ void operator()(const f32x4 (&acc)[2][2][4][2], const Unit& u, int wr, int wc, int fr, int fq) const {
        const int row0 = u.pm * 256 + wr * 64 + fr, col0 = u.pn * 256 + wc * 32 + 4 * fq;
        f32x4 gc[2][2], g2c[2][2];
#pragma unroll
        for (int bj = 0; bj < 2; ++bj)
#pragma unroll
            for (int n = 0; n < 2; ++n) { const int col = col0 + bj * 128 + n * 16; gc[bj][n] = *(const f32x4*)(gate + col); g2c[bj][n] = *(const f32x4*)(g2s + col); }
#pragma unroll
        for (int ai = 0; ai < 2; ++ai)
#pragma unroll
        for (int mh = 0; mh < 2; ++mh) {
            f32x4 xv[4][2][2];
#pragma unroll
            for (int m = 2 * mh; m < 2 * mh + 2; ++m)
#pragma unroll
                for (int bj = 0; bj < 2; ++bj)
#pragma unroll
                    for (int n = 0; n < 2; ++n) xv[m][bj][n] = *(const f32x4*)(x + (size_t)(row0 + ai * 128 + m * 16) * D + col0 + bj * 128 + n * 16);
#pragma unroll
            for (int m = 2 * mh; m < 2 * mh + 2; ++m) { const int row = row0 + ai * 128 + m * 16; float ss = 0.f;
#pragma unroll
                for (int bj = 0; bj < 2; ++bj)
#pragma unroll
                    for (int n = 0; n < 2; ++n) { const size_t off = (size_t)row * D + col0 + bj * 128 + n * 16;
                        const f32x4 h = xv[m][bj][n] + gc[bj][n] * acc[ai][bj][m][n]; { v2u hw; hw.x = pk2(h.x, h.y); hw.y = pk2(h.z, h.w); *(v2u*)(H + off) = hw; }
                        ss += (h.x * h.x + h.y * h.y) + (h.z * h.z + h.w * h.w);
                        const f32x4 gg = g2c[bj][n];
                        v2u w; w.x = pk2(h.x * gg.x, h.y * gg.y); w.y = pk2(h.z * gg.z, h.w * gg.w); *(v2u*)(A2 + off) = w; }
                ss += __shfl_xor(ss, 16); ss += __shfl_xor(ss, 32);
                if (fq == 0) SSP[(size_t)row * 32 + u.pn * 4 + wc] = ss; }
        }
    }
};
struct EpiScores {
    static constexpr bool PERM = false;
    unsigned char* O; const float* cvec; const LAS float* rrl; int pm0;
    __device__ __forceinline__ void operator()(const f32x4 (&acc)[2][2][4][2], const Unit& u, int wr, int wc, int fr, int fq) const {
        const int rl0 = wr * 64 + fr, col0 = u.pn * 256 + wc * 32 + 4 * fq; const LAS float* rp = rrl + (u.pm == pm0 ? 0 : 256);
        f32x4 cv[2][2]; float rv[2][4];
#pragma unroll
        for (int bj = 0; bj < 2; ++bj)
#pragma unroll
            for (int n = 0; n < 2; ++n) cv[bj][n] = *(const f32x4*)(cvec + col0 + bj * 128 + n * 16);
#pragma unroll
        for (int ai = 0; ai < 2; ++ai)
#pragma unroll
            for (int m = 0; m < 4; ++m) rv[ai][m] = rp[rl0 + ai * 128 + m * 16];
#pragma unroll
        for (int ai = 0; ai < 2; ++ai)
#pragma unroll
            for (int m = 0; m < 4; ++m) { const int row = u.pm * 256 + rl0 + ai * 128 + m * 16;
#pragma unroll
                for (int bj = 0; bj < 2; ++bj)
#pragma unroll
                    for (int n = 0; n < 2; ++n) { const f32x4 r = acc[ai][bj][m][n] * rv[ai][m] + cv[bj][n]; v2u w; w.x = pkh2(r.x, r.y); w.y = pkh2(r.z, r.w);
                        *(v2u*)(O + (((size_t)(u.pn * 256 + (row >> 6)) * 32 + (wc * 4 + (fq >> 1) + bj * 16 + n * 2)) * 64 + (row & 63)) * 16 + (fq & 1) * 8) = w; } }
    }
};
struct EpiF32 {
    static constexpr bool PERM = false;
    float* O; int ld;
    __device__ __forceinline__ void operator()(const f32x4 (&acc)[2][2][4][2], const Unit& u, int wr, int wc, int fr, int fq) const {
        const int row0 = u.pm * 256 + wr * 64 + fr, col0 = u.pn * 256 + wc * 32 + 4 * fq;
#pragma unroll
        for (int ai = 0; ai < 2; ++ai)
#pragma unroll
            for (int m = 0; m < 4; ++m) { const int row = row0 + ai * 128 + m * 16;
#pragma unroll
                for (int bj = 0; bj < 2; ++bj)
#pragma unroll
                    for (int n = 0; n < 2; ++n) *(f32x4*)(O + (size_t)row * ld + col0 + bj * 128 + n * 16) = acc[ai][bj][m][n]; }
    }
};

__device__ __forceinline__ void p0_transpose_item(const float* W, int K, int N, bf16* WT, bool ropeperm, LAS float* scr, int item, int lane, unsigned char* W8 = nullptr) {
    const int nblk = N / 32, kb = item / nblk, nb = item % nblk, k0 = 64 * kb, n0 = 32 * nb;
    {
        f32x4 tv[8];
#pragma unroll
        for (int i = 0; i < 8; ++i) tv[i] = *(const f32x4*)(W + (size_t)(k0 + 8 * i + (lane >> 3)) * N + n0 + 4 * (lane & 7));
#pragma unroll
        for (int i = 0; i < 8; ++i) { LAS float* d = scr + (8 * i + (lane >> 3)) * 33 + 4 * (lane & 7); d[0] = tv[i].x; d[1] = tv[i].y; d[2] = tv[i].z; d[3] = tv[i].w; }
    }
    LDS_WAIT(); asm volatile("" ::: "memory");
    const int c = lane & 7;
#pragma unroll
    for (int j = 0; j < 4; ++j) { const int n = (lane >> 3) + 8 * j; const LAS float* s = scr + (8 * c) * 33 + n;
        v4u o; o.x = pk2(s[0 * 33], s[1 * 33]); o.y = pk2(s[2 * 33], s[3 * 33]); o.z = pk2(s[4 * 33], s[5 * 33]); o.w = pk2(s[6 * 33], s[7 * 33]);
        int rown = n0 + n; if (ropeperm && rown < 2 * AW) { const int d = rown & 127; rown = (rown & ~127) + 2 * (d & 63) + (d >> 6); }
        if (W8 != nullptr && rown >= 5120) {
            int lo = __builtin_amdgcn_cvt_pk_fp8_f32(64.f * s[0 * 33], 64.f * s[1 * 33], 0, false); lo = __builtin_amdgcn_cvt_pk_fp8_f32(64.f * s[2 * 33], 64.f * s[3 * 33], lo, true);
            int hi = __builtin_amdgcn_cvt_pk_fp8_f32(64.f * s[4 * 33], 64.f * s[5 * 33], 0, false); hi = __builtin_amdgcn_cvt_pk_fp8_f32(64.f * s[6 * 33], 64.f * s[7 * 33], hi, true);
            const v2u o8 = {(unsigned)lo, (unsigned)hi}; *(v2u*)(W8 + (size_t)(rown - 5120) * K + k0 + 8 * c) = o8;
        } else *(v4u*)(WT + (size_t)rown * K + k0 + 8 * c) = o; }
    LDS_WAIT(); asm volatile("" ::: "memory");
}
__device__ __forceinline__ void rmsmod_row(const float* xrow, const float* g, const float* scale, const float* shift, bf16* orow, int lane, unsigned char* orow8 = nullptr) {
    const f32x4* xr = (const f32x4*)xrow + lane;
    f32x4 v[8]; float s = 0.f;
#pragma unroll
    for (int j = 0; j < 8; ++j) { v[j] = xr[64 * j]; s += (v[j].x * v[j].x + v[j].y * v[j].y) + (v[j].z * v[j].z + v[j].w * v[j].w); }
    const float r = 1.0f / sqrtf(wave_sum(s) * (1.f / D) + EPS);
    v2u* o = (v2u*)orow + lane;
#pragma unroll
    for (int j = 0; j < 8; ++j) { const int c0 = 4 * lane + 256 * j;
        const f32x4 gg = *(const f32x4*)(g + c0), sc = *(const f32x4*)(scale + c0), sh = *(const f32x4*)(shift + c0);
        const float y0 = v[j].x * r * gg.x * (1.f + sc.x) + sh.x, y1 = v[j].y * r * gg.y * (1.f + sc.y) + sh.y, y2 = v[j].z * r * gg.z * (1.f + sc.z) + sh.z, y3 = v[j].w * r * gg.w * (1.f + sc.w) + sh.w;
        v2u w; w.x = pk2(y0, y1); w.y = pk2(y2, y3);
        o[64 * j] = w;
        if (orow8 != nullptr) { int q = __builtin_amdgcn_cvt_pk_fp8_f32(y0, y1, 0, false); q = __builtin_amdgcn_cvt_pk_fp8_f32(y2, y3, q, true); *(unsigned*)(orow8 + c0) = (unsigned)q; } }
}

constexpr int KV_STRIDE = 288;
constexpr int KV_TILE = 256 * KV_STRIDE;
typedef short v4i16_t __attribute__((ext_vector_type(4)));
__device__ __forceinline__ s16x4 vtr(LAS const unsigned char* p) { return __builtin_bit_cast(s16x4, __builtin_amdgcn_ds_read_tr16_b64_v4i16((LAS v4i16_t*)p)); }

struct AttnStage { v4u kreg[8], vreg[8]; bf16x8 qf[4]; };
__device__ __forceinline__ void attn_load(AttnStage& st_, int unit, const bf16* Q, const bf16* K, const bf16* V) {
    const int tid = threadIdx.x, lane = tid & 63, w = __builtin_amdgcn_readfirstlane(tid >> 6), fr = lane & 15, fq = lane >> 4;
    const int g = unit >> 9, rem = unit & 511, j = rem & 3, blk = rem >> 2;
    const int dsh = 2 * g, dil = 1 << dsh;
    const int r = blk & (dil - 1), n = blk >> dsh, head = 4 * g + j;
#pragma unroll
    for (int i = 0; i < 8; ++i) { const int idx = tid + 512 * i, kr = idx >> 4, ch = idx & 15; const int l = 128 * n - 128 + kr, lc = l < 0 ? 0 : l;
        const size_t off = (size_t)((lc << dsh) + r) * AW + head * HD + ch * 8; st_.kreg[i] = *(const v4u*)(K + off); st_.vreg[i] = *(const v4u*)(V + off); }
    const int qpos = ((128 * n + 16 * w + fr) << dsh) + r;
#pragma unroll
    for (int ks = 0; ks < 4; ++ks) st_.qf[ks] = *(const bf16x8*)(Q + (size_t)qpos * AW + head * HD + 32 * ks + 8 * fq);
}
__device__ __forceinline__ void attn_unit(LAS unsigned char* lds, int unit, int next_unit, AttnStage& sg, const bf16* Q, const bf16* K, const bf16* V, bf16* OG, float* LSE) {
    const int tid = threadIdx.x, lane = tid & 63, w = __builtin_amdgcn_readfirstlane(tid >> 6), fr = lane & 15, fq = lane >> 4;
    const int g = unit >> 9, rem = unit & 511, j = rem & 3, blk = rem >> 2;
    const int dsh = 2 * g, dil = 1 << dsh;
    const int r = blk & (dil - 1), n = blk >> dsh, head = 4 * g + j;
    LAS unsigned char* Kl = lds; LAS unsigned char* Vl = lds + KV_TILE;
#pragma unroll
    for (int i = 0; i < 8; ++i) { const int idx = tid + 512 * i, kr = idx >> 4, ch = idx & 15; const bool ok = (128 * n - 128 + kr) >= 0; const v4u z = {0u, 0u, 0u, 0u};
        *(LAS v4u*)(Kl + kr * KV_STRIDE + ch * 16) = ok ? sg.kreg[i] : z; *(LAS v4u*)(Vl + kr * KV_STRIDE + ch * 16) = ok ? sg.vreg[i] : z; }
    const int qpos = ((128 * n + 16 * w + fr) << dsh) + r;
    bf16x8 qf[4];
#pragma unroll
    for (int ks = 0; ks < 4; ++ks) qf[ks] = sg.qf[ks];
    __syncthreads();
    if (next_unit >= 0) attn_load(sg, next_unit, Q, K, V);
    f32x4 st[9];
#pragma unroll
    for (int b = 0; b < 9; ++b) st[b] = (f32x4){0.f, 0.f, 0.f, 0.f};
#pragma unroll
    for (int ks = 0; ks < 4; ++ks) {
        bf16x8 kf[9];
#pragma unroll
        for (int b = 0; b < 9; ++b) kf[b] = *(LAS const bf16x8*)(Kl + (16 * (w + b) + fr) * KV_STRIDE + 64 * ks + 16 * fq);
#pragma unroll
        for (int b = 0; b < 9; ++b) st[b] = __builtin_amdgcn_mfma_f32_16x16x32_bf16(kf[b], qf[ks], st[b], 0, 0, 0);
    }
    float mx = -INFINITY;
#pragma unroll
    for (int b = 0; b < 9; ++b)
#pragma unroll
        for (int e = 0; e < 4; ++e) { const int kk = 16 * b + 4 * fq + e;
            const bool ok = (kk >= fr) && (kk <= fr + 128) && (n > 0 || 16 * w + kk >= 128);
            st[b][e] = ok ? st[b][e] : -INFINITY; mx = fmaxf(mx, st[b][e]); }
    mx = fmaxf(mx, __shfl_xor(mx, 16)); mx = fmaxf(mx, __shfl_xor(mx, 32));
    float sm = 0.f;
#pragma unroll
    for (int b = 0; b < 9; ++b)
#pragma unroll
        for (int e = 0; e < 4; ++e) { const float p = __builtin_amdgcn_exp2f(st[b][e] - mx); st[b][e] = p; sm += p; }
    sm += __shfl_xor(sm, 16); sm += __shfl_xor(sm, 32);
    f32x4 o[8];
#pragma unroll
    for (int dt = 0; dt < 8; ++dt) o[dt] = (f32x4){0.f, 0.f, 0.f, 0.f};
    const int q4 = fr >> 2, p4 = fr & 3;
#pragma unroll
    for (int s = 0; s < 5; ++s) {
        bf16x8 pf; { const unsigned a = pk2(st[2 * s][0], st[2 * s][1]), b = pk2(st[2 * s][2], st[2 * s][3]);
            unsigned c = 0u, d = 0u; if (s < 4) { c = pk2(st[2 * s + 1][0], st[2 * s + 1][1]); d = pk2(st[2 * s + 1][2], st[2 * s + 1][3]); }
            const v4u t = {a, b, c, d}; pf = __builtin_bit_cast(bf16x8, t); }
        LAS const unsigned char* v0 = Vl + (16 * (w + 2 * s) + 4 * fq + q4) * KV_STRIDE + 8 * p4;
        s16x4 lo[8], hi[8];
#pragma unroll
        for (int dt = 0; dt < 8; ++dt) { lo[dt] = vtr(v0 + 32 * dt); hi[dt] = (s16x4){0, 0, 0, 0}; if (s < 4) hi[dt] = vtr(v0 + 16 * KV_STRIDE + 32 * dt); }
#pragma unroll
        for (int dt = 0; dt < 8; ++dt) {
            const bf16x8 vf = {lo[dt][0], lo[dt][1], lo[dt][2], lo[dt][3], hi[dt][0], hi[dt][1], hi[dt][2], hi[dt][3]};
            o[dt] = __builtin_amdgcn_mfma_f32_16x16x32_bf16(vf, pf, o[dt], 0, 0, 0);
        }
    }
    const float inv = 1.0f / sm;
    bf16* orow = OG + ((size_t)g * S + qpos) * AOW + j * HD + 4 * fq;
#pragma unroll
    for (int dt = 0; dt < 8; ++dt) { v2u wv; wv.x = pk2(o[dt][0] * inv, o[dt][1] * inv); wv.y = pk2(o[dt][2] * inv, o[dt][3] * inv); *(v2u*)(orow + 16 * dt) = wv; }
    if (fq == 0) LSE[((size_t)g * S + qpos) * 4 + j] = mx * 0.6931471805599453f + __logf(sm);
    __syncthreads();
}

__device__ __forceinline__ unsigned okey(float f) { const unsigned u = __float_as_uint(f); return u ^ ((unsigned)((int)u >> 31) | 0x80000000u); }
__device__ __forceinline__ float okey_inv(unsigned k) { return __uint_as_float((k & 0x80000000u) ? (k ^ 0x80000000u) : ~k); }
__device__ __forceinline__ unsigned umed3(unsigned a, unsigned b, unsigned c) { unsigned r; asm("v_med3_u32 %0, %1, %2, %3" : "=v"(r) : "v"(a), "v"(b), "v"(c)); return r; }
__device__ __forceinline__ void ins16k(unsigned (&tk)[16], unsigned key) {
#pragma unroll
    for (int s = 15; s >= 1; --s) tk[s] = umed3(key, tk[s], tk[s - 1]);
    tk[0] = key > tk[0] ? key : tk[0];
}
__device__ __forceinline__ unsigned okeyb(unsigned x) { return x ^ ((unsigned)((int)x >> 31) | 0x80000000u); }
__device__ __forceinline__ float okeyh_inv(unsigned k) { const unsigned u = (k & 0x80000000u) ? (k ^ 0x80000000u) : ~k; return (float)__builtin_bit_cast(_Float16, (unsigned short)(u >> 16)); }
__device__ __forceinline__ void route8(const unsigned char* SC, int job, int lane, int* eidG, float* gtG, float* dsG, const float* DSC, const float* USC, LAS int* lk) {
    const int h = job & 7, tblk = job >> 3; const unsigned char* p = SC + ((size_t)(h * 256 + tblk) * 2048 + lane) * 16;
    unsigned k0[16], k1[16], kk[16];
#pragma unroll
    for (int s = 0; s < 16; ++s) { kk[s] = 0u; k0[s] = 0u; }
    v4u b0[4], b1[4], b2[4], b3[4];
#pragma unroll
    for (int i = 0; i < 4; ++i) { b0[i] = *(const v4u*)(p + 1024 * i); b1[i] = *(const v4u*)(p + 1024 * (4 + i)); b2[i] = *(const v4u*)(p + 1024 * (8 + i)); }
#define RT_STAGE(ld, off, pr, nb) { _Pragma("unroll") for (int i = 0; i < 4; ++i) ld[i] = *(const v4u*)(p + 1024 * ((off) + i)); \
        _Pragma("unroll") for (int i = 0; i < 4; ++i) _Pragma("unroll") for (int d = 0; d < 4; ++d) { const unsigned w = pr[i][d]; \
            ins16k(kk, (okeyb(w << 16) & ~0x7fu) | (unsigned)(127 - (nb) - 8 * i - 2 * d)); ins16k(kk, (okeyb(w & 0xffff0000u) & ~0x7fu) | (unsigned)(126 - (nb) - 8 * i - 2 * d)); } }
#pragma unroll 1
    for (int tr = 0; tr < 2; ++tr) {
        RT_STAGE(b3, 12, b0, 0)
        RT_STAGE(b0, 16, b1, 32)
        RT_STAGE(b1, 20, b2, 64)
        RT_STAGE(b2, 24, b3, 96)
        p += 16 * 1024;
        if (tr == 0) {
#pragma unroll
            for (int s = 0; s < 16; ++s) { k0[s] = kk[s]; kk[s] = 0u; } }
    }
#undef RT_STAGE
#pragma unroll
    for (int s = 0; s < 16; ++s) k1[s] = kk[s];
    float a0[16], a1[16];
#pragma unroll
    for (int s = 0; s < 16; ++s) { const int n0 = 127 - (int)(k0[s] & 0x7fu), n1 = 127 - (int)(k1[s] & 0x7fu); lk[s * 64 + lane] = n0; lk[1024 + s * 64 + lane] = n1; a0[s] = okeyh_inv(k0[s]); a1[s] = okeyh_inv(k1[s]); }
    unsigned ck[16];
#pragma unroll
    for (int s = 0; s < 16; ++s) ck[s] = 0u;
#pragma unroll
    for (int i = 0; i < 16; ++i)
#pragma unroll
        for (int j = 0; j < 16; ++j) if ((i + 1) * (j + 1) <= 16) ins16k(ck, (okey(a0[i] + a1[j]) & ~0xffu) | (unsigned)(255 - (i * 16 + j)));
    float cs[16]; float mx = -INFINITY;
#pragma unroll
    for (int s = 0; s < 16; ++s) { cs[s] = okey_inv((ck[s] & ~0xffu) | 0x80u); mx = fmaxf(mx, cs[s]); }
    float sum = 0.f;
#pragma unroll
    for (int s = 0; s < 16; ++s) { cs[s] = __expf(cs[s] - mx); sum += cs[s]; }
    const float rs = 1.0f / sum;
    int exv[16]; float usv[16], dsv[16];
#pragma unroll
    for (int s = 0; s < 16; ++s) { const int flat = 255 - (int)(ck[s] & 0xffu); const int i1 = lk[(flat >> 4) * 64 + lane], i2 = lk[1024 + (flat & 15) * 64 + lane]; exv[s] = i1 * NKEY + i2; }
#pragma unroll
    for (int s = 0; s < 16; ++s) { usv[s] = USC[exv[s]]; dsv[s] = DSC[exv[s]]; }
    const size_t oi0 = (size_t)(tblk * 64 + lane) * 128 + h * 16;
#pragma unroll
    for (int q = 0; q < 4; ++q) {
        *(v4u*)(eidG + oi0 + 4 * q) = (v4u){(unsigned)exv[4 * q], (unsigned)exv[4 * q + 1], (unsigned)exv[4 * q + 2], (unsigned)exv[4 * q + 3]};
        *(f32x4*)(gtG + oi0 + 4 * q) = (f32x4){cs[4 * q] * rs * usv[4 * q], cs[4 * q + 1] * rs * usv[4 * q + 1], cs[4 * q + 2] * rs * usv[4 * q + 2], cs[4 * q + 3] * rs * usv[4 * q + 3]};
        *(f32x4*)(dsG + oi0 + 4 * q) = (f32x4){dsv[4 * q], dsv[4 * q + 1], dsv[4 * q + 2], dsv[4 * q + 3]}; }
}
constexpr int QB = 6, NDW = 6;
constexpr float QMAXV = 7.5f;
constexpr int PIECE_B = 24, SLICE_ROW_B = 8 * PIECE_B;
constexpr size_t SLICE_B = (size_t)16384 * SLICE_ROW_B;
typedef unsigned u32x6 __attribute__((ext_vector_type(6)));
typedef float f32x32 __attribute__((ext_vector_type(32)));
struct QRow { v4u a; v2u b; };
__device__ __forceinline__ QRow qrow_load(const unsigned char* p, int j) { const unsigned o64 = (unsigned)(size_t)p & 64u; QRow r; r.a = *(const v4u*)(p + (o64 + 16 * j)); r.b = *(const v2u*)(p + (128 - 2 * o64 + 8 * j)); return r; }
__device__ __forceinline__ QRow qrow_load_o(const unsigned char* base, unsigned off, int j) { const unsigned o64 = off & 64u; QRow r; r.a = *(const v4u*)(base + (off + o64 + 16 * j)); r.b = *(const v2u*)(base + (off + 128 - 2 * o64 + 8 * j)); return r; }
__device__ __forceinline__ f32x32 qrow_dec(const QRow& r) { const u32x6 v = {r.a.x, r.a.y, r.a.z, r.a.w, r.b.x, r.b.y}; return __builtin_amdgcn_cvt_scalef32_pk32_f32_fp6(v, 1.0f); }
typedef float f32x2p __attribute__((ext_vector_type(2)));
__device__ __forceinline__ float qdot(QRow r, const f32x2p (&x)[16], float dep) {
#if KN_CHAIN10
    r.a.x += (unsigned)(int)(dep * 0.0f);
#endif
    const f32x32 v = qrow_dec(r);
#if KN_PK10
    f32x2p s0 = {0.f, 0.f}, s1 = {0.f, 0.f};
#pragma unroll
    for (int i = 0; i < 16; i += 2) { const f32x2p v0 = {v[2 * i], v[2 * i + 1]}, v1 = {v[2 * i + 2], v[2 * i + 3]}; s0 = __builtin_elementwise_fma(v0, x[i], s0); s1 = __builtin_elementwise_fma(v1, x[i + 1], s1); }
    const f32x2p t = s0 + s1; return t.x + t.y;
#else
    float s0 = 0.f, s1 = 0.f, s2 = 0.f, s3 = 0.f;
#pragma unroll
    for (int i = 0; i < 16; i += 2) { s0 += v[2 * i] * x[i].x; s1 += v[2 * i + 1] * x[i].y; s2 += v[2 * i + 2] * x[i + 1].x; s3 += v[2 * i + 3] * x[i + 1].y; }
    return (s0 + s1) + (s2 + s3);
#endif
}
__device__ __forceinline__ void qaxpy(f32x2p (&a)[16], QRow r, float c) {
#if KN_CHAIN11
    r.a.x += (unsigned)(int)(a[15].y * 0.0f);
#endif
    const f32x32 v = qrow_dec(r);
#if KN_PK11
    const f32x2p c2 = {c, c};
#pragma unroll
    for (int i = 0; i < 16; ++i) { const f32x2p vi = {v[2 * i], v[2 * i + 1]}; a[i] = __builtin_elementwise_fma(c2, vi, a[i]); }
#else
#pragma unroll
    for (int i = 0; i < 16; ++i) { a[i].x += c * v[2 * i]; a[i].y += c * v[2 * i + 1]; }
#endif
}
__device__ __forceinline__ float reduce8(const float (&d)[8], int lane) {
    const bool h5 = (lane & 32) != 0, h4 = (lane & 16) != 0, h3 = (lane & 8) != 0;
    float e[4], f[2];
#pragma unroll
    for (int i = 0; i < 4; ++i) { const float keep = h5 ? d[i + 4] : d[i], send = h5 ? d[i] : d[i + 4]; e[i] = keep + __shfl_xor(send, 32); }
#pragma unroll
    for (int i = 0; i < 2; ++i) { const float keep = h4 ? e[i + 2] : e[i], send = h4 ? e[i] : e[i + 2]; f[i] = keep + __shfl_xor(send, 16); }
    float g = (h3 ? f[1] : f[0]) + __shfl_xor(h3 ? f[0] : f[1], 8);
    g += __shfl_xor(g, 4); g += __shfl_xor(g, 2); g += __shfl_xor(g, 1);
    return g;
}
__device__ __forceinline__ float reduce8j(const float (&d)[8], int lane) {
    const bool b2 = (lane & 4) != 0, b1 = (lane & 2) != 0, b0 = (lane & 1) != 0;
    float e[4], f[2];
#pragma unroll
    for (int i = 0; i < 4; ++i) { const float keep = b2 ? d[i + 4] : d[i], send = b2 ? d[i] : d[i + 4]; e[i] = keep + __shfl_xor(send, 4); }
#pragma unroll
    for (int i = 0; i < 2; ++i) { const float keep = b1 ? e[i + 2] : e[i], send = b1 ? e[i] : e[i + 2]; f[i] = keep + __shfl_xor(send, 2); }
    return (b0 ? f[1] : f[0]) + __shfl_xor(b0 ? f[0] : f[1], 1);
}
__device__ __forceinline__ float wave_maxf(float v) {
#pragma unroll
    for (int o = 1; o < 64; o <<= 1) v = fmaxf(v, __shfl_xor(v, o));
    return v;
}
__device__ __forceinline__ unsigned fp6_code(float y) {
    const float a = fabsf(y);
    const float c = a < 2.0f ? 8.0f * a : (a < 4.0f ? 8.0f + 4.0f * a : 16.0f + 2.0f * a);
    int code = (int)rintf(c); code = code > 31 ? 31 : code;
    return (unsigned)code | (y < 0.f ? 32u : 0u);
}
template <int I> struct QPack { static __device__ __forceinline__ void put(unsigned (&w)[NDW], const float (&v)[32], float inv) {
    constexpr int bit = QB * I, dw = bit >> 5, sh = bit & 31;
    const unsigned f = fp6_code(v[I] * inv);
    w[dw] |= f << sh; if constexpr (sh + QB > 32) w[dw + 1 < NDW ? dw + 1 : dw] |= f >> (32 - sh);
    QPack<I - 1>::put(w, v, inv); } };
template <> struct QPack<-1> { static __device__ __forceinline__ void put(unsigned (&)[NDW], const float (&)[32], float) {} };
__device__ __forceinline__ void quant_row(const float* src, unsigned char* dst, float* scale_out, int lane) {
    float v[32]; float mx = 0.f;
#pragma unroll
    for (int i = 0; i < 8; ++i) { const f32x4 t = *(const f32x4*)(src + 32 * lane + 4 * i); v[4 * i] = t.x; v[4 * i + 1] = t.y; v[4 * i + 2] = t.z; v[4 * i + 3] = t.w;
        mx = fmaxf(mx, fmaxf(fmaxf(fabsf(t.x), fabsf(t.y)), fmaxf(fabsf(t.z), fabsf(t.w)))); }
    mx = wave_maxf(mx);
    const float inv = mx > 0.f ? QMAXV / mx : 0.f;
    unsigned w[NDW];
#pragma unroll
    for (int i = 0; i < NDW; ++i) w[i] = 0u;
    QPack<31>::put(w, v, inv);
    unsigned char* pd = dst + (size_t)(lane >> 3) * SLICE_B;
    const unsigned o64 = (unsigned)(size_t)dst & 64u;
    const v4u a = {w[0], w[1], w[2], w[3]}; const v2u b = {w[4], w[5]}; *(v4u*)(pd + (o64 + 16 * (lane & 7))) = a; *(v2u*)(pd + (128 - 2 * o64 + 8 * (lane & 7))) = b;
    if (lane == 0) *scale_out = mx * (1.0f / QMAXV);
}

__device__ __forceinline__ void fold_tile(const float* base, size_t stride, LAS float* scr, int lane, f32x4 (&outv)[16]) {
    f32x4 tv[16];
#pragma unroll
    for (int i = 0; i < 16; ++i) tv[i] = *(const f32x4*)(base + (size_t)(2 * i + (lane >> 5)) * stride + 4 * (lane & 31));
#pragma unroll
    for (int i = 0; i < 16; ++i) *(LAS f32x4*)(scr + (2 * i + (lane >> 5)) * 132 + 4 * (lane & 31)) = tv[i];
    LDS_WAIT(); asm volatile("" ::: "memory");
#pragma unroll
    for (int i = 0; i < 16; ++i) outv[i] = *(LAS const f32x4*)(scr + (lane & 31) * 132 + 64 * (lane >> 5) + 4 * i);
    LDS_WAIT(); asm volatile("" ::: "memory");
}
struct Args { const float* in[17]; float* out; float* hbuf; unsigned char* ws; int ph_lo, ph_hi, li, pad; };

__global__ void __launch_bounds__(NWAVES * 64, 2) mk_fwd(Args args) {
    extern __shared__ __attribute__((aligned(16))) unsigned char lds_raw[];
    LAS unsigned char* lds = (LAS unsigned char*)lds_raw;
    volatile LAS unsigned* MISC = (volatile LAS unsigned*)(lds + MISC_OFF);
    const int tid = threadIdx.x, lane = tid & 63, wave = __builtin_amdgcn_readfirstlane(tid >> 6);
    const int G = gridDim.x, bx = blockIdx.x;
    const int vcu = (G % 8 == 0) ? (bx % 8) * (G / 8) + bx / 8 : bx;
    const int gw = vcu * NWAVES + wave, NGW = G * NWAVES;
    unsigned char* ws = args.ws;
    const float* x = args.in[0]; const float* cvec = args.in[1]; const float* ada_w = args.in[2]; const float* ada_b = args.in[3]; const float* norm1_g = args.in[4];
    const float* w_in = args.in[5]; const float* pool_mix = args.in[6]; const float* pool_scale = args.in[7]; const float* w_ab = args.in[8]; const float* w_pb = args.in[9];
    const float* w_out = args.in[10]; const float* norm2_g = args.in[11]; const float* wq = args.in[12]; const float* keys = args.in[13]; const float* wdn = args.in[14];
    const float* wup = args.in[15]; const float* final_g = args.in[16];
    float* out = args.out;
    float* mod = (float*)(ws + WS_MOD); float* invf = (float*)(ws + WS_INVF);
    bf16* WAB = (bf16*)(ws + WS_WAB); bf16* WPB = (bf16*)(ws + WS_WPB);
    bf16* WOUT = (bf16*)(ws + WS_WOUT); bf16* WQ = (bf16*)(ws + WS_WQ); bf16* WIN = (bf16*)(ws + WS_WIN); unsigned char* DOWN = ws + WS_DOWN; unsigned char* UP = ws + WS_UP; float* DSC = (float*)(ws + WS_DSC); float* USC = (float*)(ws + WS_USC);
    bf16* XN = (bf16*)(ws + WS_XN); bf16* OG = (bf16*)(ws + WS_OG); float* LSE = (float*)(ws + WS_LSE);
    bf16* Qb = (bf16*)(ws + WS_Q); bf16* Kb = (bf16*)(ws + WS_K); bf16* Vb = (bf16*)(ws + WS_V); bf16* PIN = (bf16*)(ws + WS_PIN); bf16* GA = (bf16*)(ws + WS_GA); bf16* GB = (bf16*)(ws + WS_GB);
    bf16* DPOOL = (bf16*)(ws + WS_DPOOL); bf16* ATTN = (bf16*)(ws + WS_ATTN); bf16* MERGED = (bf16*)(ws + WS_MERGED);
    unsigned char* SC = ws + WS_SC; unsigned char* XN8 = ws + WS_XN8; unsigned char* WIN8 = ws + WS_WIN8; float* CSUM = (float*)(ws + WS_CSUM); float* CVEC = (float*)(ws + WS_CVEC); float* RR = (float*)(ws + WS_RR); float* SSP = (float*)(ws + WS_SSP); float* G2S = (float*)(ws + WS_G2S); int* EID = (int*)(ws + WS_EID); float* GATE = (float*)(ws + WS_GATE); float* UPART = (float*)(ws + WS_UPART); float* SSQ = (float*)(ws + WS_SSQ); float* DSCT = (float*)(ws + WS_DSCT);
    bf16* VB = (bf16*)(ws + WS_VB);
    bf16* H = (bf16*)(ws + WS_HB);
    const float *shift1 = mod, *scale1 = mod + D, *gate1 = mod + 2 * D, *shift2 = mod + 3 * D, *scale2 = mod + 4 * D, *gate2 = mod + 5 * D;

    for (int u = tid; u < (LDS_BYTES - LDSCTL_OFF) / 4; u += NWAVES * 64) ((LAS unsigned*)(lds + LDSCTL_OFF))[u] = 0u;
    __syncthreads();
    XcdBarrier bar; bar.bar = (unsigned*)(ws + WS_CTL) + CW_BAR; bar.x = 0; bar.st = nullptr;
    if (MK_N_LAUNCHES == 1) bar = xcd_barrier_post((unsigned*)(ws + WS_CTL) + CW_BAR, MISC + 8);
    const int lo = args.ph_lo, hi = args.ph_hi;
#define IN(k) (lo <= (k) && (k) < hi)
#define SEAM(k) do { if (IN(k) && IN((k) + 1)) xcd_barrier(bar); } while (0)

    if (IN(0)) REP(0) {
        for (int chunk = bx; chunk < 6 * D / 48; chunk += G) {
            LAS float* red = (LAS float*)lds;
            const int cq = tid % 12, rg = tid / 12;
            if (rg < 32) {
                f32x4 a = {0.f, 0.f, 0.f, 0.f};
                const float* wp = ada_w + (size_t)(rg * 64) * (6 * D) + chunk * 48 + 4 * cq;
#pragma unroll 8
                for (int i = 0; i < 64; ++i) { const float ci = cvec[rg * 64 + i]; const float sl = ci / (1.0f + __expf(-ci)); a = a + *(const f32x4*)(wp + (size_t)i * (6 * D)) * sl; }
                *(LAS f32x4*)(red + rg * 48 + 4 * cq) = a;
            }
            __syncthreads();
            if (tid < 48) { float s = 0.f;
#pragma unroll 8
                for (int i = 0; i < 32; ++i) s += red[i * 48 + tid];
                mod[chunk * 48 + tid] = s + ada_b[chunk * 48 + tid]; }
            __syncthreads();
        }
        if (gw == 0) invf[lane] = (float)pow(10000.0, -(double)lane / 64.0);
        LAS float* scr = (LAS float*)(lds + wave * 16896);
        constexpr int I_IN = (D / 64) * (INW / 32), I_B = (AOW / 64) * (D / 32), I_O = (D / 64) * (D / 32);
        constexpr int NT_ITEMS = I_IN + I_B + I_O;
        for (int it = gw; it < NT_ITEMS; it += NGW) {
            int r = it;
            if (r < I_IN) { p0_transpose_item(w_in, D, INW, WIN, true, scr, r, lane, WIN8); continue; } r -= I_IN;
            if (r < I_B) { p0_transpose_item(w_ab, AOW, D, WAB, false, scr, r, lane); continue; } r -= I_B;
            p0_transpose_item(w_out, D, D, WOUT, false, scr, r, lane);
        }
        {
            typedef float f32x16 __attribute__((ext_vector_type(16)));
            const int li = lane & 31, hf = lane >> 5;
            for (int it = NGW - 1 - gw; it < 16 * 4 * 64; it += NGW) {
                const int hp = it >> 8, nt = (it >> 6) & 3, kt = it & 63;
                f32x4 av[16], bv[16];
                fold_tile(keys + ((size_t)(hp * 128 + nt * 32)) * 128, 128, scr, lane, av);
                fold_tile(wq + (size_t)(kt * 32) * D + hp * 128, D, scr, lane, bv);
                f32x16 c = {0.f, 0.f, 0.f, 0.f, 0.f, 0.f, 0.f, 0.f, 0.f, 0.f, 0.f, 0.f, 0.f, 0.f, 0.f, 0.f};
#pragma unroll
                for (int i = 0; i < 16; ++i)
#pragma unroll
                    for (int e = 0; e < 4; ++e) c = __builtin_amdgcn_mfma_f32_32x32x2f32(av[i][e], bv[i][e], c, 0, 0, 0);
#pragma unroll
                for (int r = 0; r < 16; ++r) { const int nn = (r & 3) + 8 * (r >> 2) + 4 * hf;
                    WQ[(size_t)(hp * 128 + nt * 32 + nn) * D + kt * 32 + li] = (bf16)(pk2(c[r], 0.f) & 0xffffu); }
            }
            for (int it = (NGW == 2048) ? 1023 - gw : gw; it >= 0 && it < 4 * 4 * 64; it += NGW) {
                const int g = it >> 8, ct = (it >> 6) & 3, ntl = it & 63;
                f32x4 av[16]; float bs[64];
                fold_tile(pool_mix + ((size_t)(g * 128 + ct * 32)) * 128, 128, scr, lane, av);
#pragma unroll
                for (int d = 0; d < 64; ++d) bs[d] = pool_scale[g * 128 + 64 * hf + d] * w_pb[(size_t)(g * 128 + 64 * hf + d) * D + ntl * 32 + li];
                f32x16 c = {0.f, 0.f, 0.f, 0.f, 0.f, 0.f, 0.f, 0.f, 0.f, 0.f, 0.f, 0.f, 0.f, 0.f, 0.f, 0.f};
#pragma unroll
                for (int i = 0; i < 16; ++i)
#pragma unroll
                    for (int e = 0; e < 4; ++e) c = __builtin_amdgcn_mfma_f32_32x32x2f32(av[i][e], bs[4 * i + e], c, 0, 0, 0);
#pragma unroll
                for (int q = 0; q < 4; ++q) { v2u o; o.x = pk2(c[4 * q], c[4 * q + 1]); o.y = pk2(c[4 * q + 2], c[4 * q + 3]);
                    *(v2u*)(WPB + (size_t)(ntl * 32 + li) * PW + g * 128 + ct * 32 + 8 * q + 4 * hf) = o; }
            }
        }
        for (int rowi = gw; rowi < 2 * 16384; rowi += NGW) { const int e = rowi & 16383;
            if (rowi < 16384) quant_row(wdn + (size_t)e * D, DOWN + (size_t)e * SLICE_ROW_B, DSC + e, lane); else quant_row(wup + (size_t)e * D, UP + (size_t)e * SLICE_ROW_B, USC + e, lane); }
    }
    SEAM(0);
    if (IN(1)) REP(1) {
        for (int m = gw; m < S; m += NGW) rmsmod_row(x + (size_t)m * D, norm1_g, scale1, shift1, XN + (size_t)m * D, lane, XN8 + (size_t)m * D);
        for (int n = gw * 64 + lane; n < D; n += NGW * 64) G2S[n] = norm2_g[n] * (1.f + scale2[n]);
        for (int n = gw; n < D; n += NGW) { float a = 0.f;
#pragma unroll
            for (int q = 0; q < 4; ++q) { const v4u p = *(const v4u*)(WQ + (size_t)n * D + 32 * lane + 8 * q); const f32x4 s0 = *(const f32x4*)(shift2 + 32 * lane + 8 * q), s1 = *(const f32x4*)(shift2 + 32 * lane + 8 * q + 4);
                a += (bflo(p.x) * s0.x + bfhi(p.x) * s0.y) + (bflo(p.y) * s0.z + bfhi(p.y) * s0.w) + (bflo(p.z) * s1.x + bfhi(p.z) * s1.y) + (bflo(p.w) * s1.z + bfhi(p.w) * s1.w); }
            a = wave_sum(a); if (lane == 0) CVEC[n] = a; }
        { float sh[32];
#pragma unroll
          for (int q = 0; q < 8; ++q) { const f32x4 t4 = *(const f32x4*)(shift2 + 32 * lane + 4 * q); sh[4 * q] = t4.x; sh[4 * q + 1] = t4.y; sh[4 * q + 2] = t4.z; sh[4 * q + 3] = t4.w; }
          for (int e0_ = gw; e0_ < 16384; e0_ += 8 * NGW) {
              QRow rr8[8];
#pragma unroll
              for (int q = 0; q < 8; ++q) { const int e = e0_ + q * NGW; rr8[q] = qrow_load(DOWN + (size_t)(lane >> 3) * SLICE_B + (size_t)(e < 16384 ? e : gw) * SLICE_ROW_B, lane & 7); }
#pragma unroll
              for (int q = 0; q < 8; ++q) { const int e = e0_ + q * NGW; const f32x32 v = qrow_dec(rr8[q]); float a = 0.f;
#pragma unroll
                  for (int i = 0; i < 32; ++i) a += v[i] * sh[i];
                  a = wave_sum(a); if (lane == 0 && e < 16384) CSUM[e] = a; }
          } }
    }
    SEAM(1);
    if (IN(2)) REP(2) {
        { pg8::Gemm g{XN, WIN, D, D, S, 5120, D, 0}; pg8::StaticOrder So; So.init(S, 5120, G, bx);
          EpiInProj E{Qb, Kb, Vb, PIN, GA, GB, invf};
          pg8::gemm_phase<EpiInProj>(lds, g, So, E); }
        { pg8::Gemm g{(const bf16*)XN8, (const bf16*)WIN8, D / 2, D / 2, S, 4096, D / 2, 0}; pg8::StaticOrder So; So.init(S, 8192, G, bx);
          EpiGates8n E{GA, GB};
          pg8::gemm_phase_f8n<EpiGates8n>(lds, g, So, E); }
    }
    SEAM(2);
    if (IN(3)) REP(3) {
        { AttnStage sg; if (bx < 1536) attn_load(sg, bx, Qb, Kb, Vb);
          for (int u = bx; u < 1536; u += G) attn_unit(lds, u, (u + G < 1536) ? u + G : -1, sg, Qb, Kb, Vb, OG, LSE); }
        for (int tb = 8 * gw; tb < S; tb += 8 * NGW) {
            v4u rows[23];
#pragma unroll
            for (int i = 0; i < 23; ++i) { const int tr = tb - 15 + i; rows[i] = *(const v4u*)(PIN + (size_t)(tr < 0 ? 0 : tr) * PW + 8 * lane); }
            asm volatile("" : "+v"(rows[0]), "+v"(rows[1]), "+v"(rows[2]), "+v"(rows[3]), "+v"(rows[4]), "+v"(rows[5]), "+v"(rows[6]), "+v"(rows[7]), "+v"(rows[8]), "+v"(rows[9]), "+v"(rows[10]), "+v"(rows[11]));
            asm volatile("" : "+v"(rows[12]), "+v"(rows[13]), "+v"(rows[14]), "+v"(rows[15]), "+v"(rows[16]), "+v"(rows[17]), "+v"(rows[18]), "+v"(rows[19]), "+v"(rows[20]), "+v"(rows[21]), "+v"(rows[22]));
#pragma unroll
            for (int i = 0; i < 15; ++i) { const v4u z = {0u, 0u, 0u, 0u}; rows[i] = (tb - 15 + i) < 0 ? z : rows[i]; }
            const int gsel = lane >> 4; const int wszi = 2 << gsel; const float wsz = (float)wszi;
            float sacc[8] = {0.f, 0.f, 0.f, 0.f, 0.f, 0.f, 0.f, 0.f};
#pragma unroll
            for (int i = 0; i < 16; ++i) { const bool in = i < wszi; const v4u rr = rows[15 - i];
#pragma unroll
                for (int c = 0; c < 4; ++c) { sacc[2 * c] += in ? bflo(rr[c]) : 0.f; sacc[2 * c + 1] += in ? bfhi(rr[c]) : 0.f; } }
#pragma unroll
            for (int q = 0; q < 8; ++q) {
                const int t = tb + q; const v4u cur = rows[15 + q];
                if (q > 0) { const v4u o2 = rows[13 + q], o4 = rows[11 + q], o8 = rows[7 + q], o16 = rows[q - 1 < 0 ? 0 : q - 1];
#pragma unroll
                    for (int c = 0; c < 4; ++c) { const unsigned od = gsel == 0 ? o2[c] : (gsel == 1 ? o4[c] : (gsel == 2 ? o8[c] : o16[c]));
                        sacc[2 * c] += bflo(cur[c]) - bflo(od); sacc[2 * c + 1] += bfhi(cur[c]) - bfhi(od); } }
                const float rn = 1.0f / fminf((float)(t + 1), wsz);
                v4u o;
#pragma unroll
                for (int c = 0; c < 4; ++c) o[c] = pk2(sacc[2 * c] * rn - bflo(cur[c]), sacc[2 * c + 1] * rn - bfhi(cur[c]));
                *(v4u*)(DPOOL + (size_t)t * PW + 8 * lane) = o;
            }
        }
    }
    SEAM(3);
    if (IN(4)) REP(4) {
        for (int t = gw; t < S; t += NGW) { const int j = lane >> 4;
            const float l0 = LSE[((size_t)0 * S + t) * 4 + j], l1 = LSE[((size_t)1 * S + t) * 4 + j], l2 = LSE[((size_t)2 * S + t) * 4 + j];
            const float m = fmaxf(l0, fmaxf(l1, l2)); float e0 = __expf(l0 - m), e1 = __expf(l1 - m), e2 = __expf(l2 - m); const float inv = 1.0f / (e0 + e1 + e2); e0 *= inv; e1 *= inv; e2 *= inv;
            const v4u a = *(const v4u*)(OG + ((size_t)0 * S + t) * AOW + 8 * lane), b = *(const v4u*)(OG + ((size_t)1 * S + t) * AOW + 8 * lane), c = *(const v4u*)(OG + ((size_t)2 * S + t) * AOW + 8 * lane);
            v4u o;
            o.x = pk2(e0 * bflo(a.x) + e1 * bflo(b.x) + e2 * bflo(c.x), e0 * bfhi(a.x) + e1 * bfhi(b.x) + e2 * bfhi(c.x));
            o.y = pk2(e0 * bflo(a.y) + e1 * bflo(b.y) + e2 * bflo(c.y), e0 * bfhi(a.y) + e1 * bfhi(b.y) + e2 * bfhi(c.y));
            o.z = pk2(e0 * bflo(a.z) + e1 * bflo(b.z) + e2 * bflo(c.z), e0 * bfhi(a.z) + e1 * bfhi(b.z) + e2 * bfhi(c.z));
            o.w = pk2(e0 * bflo(a.w) + e1 * bflo(b.w) + e2 * bflo(c.w), e0 * bfhi(a.w) + e1 * bfhi(b.w) + e2 * bfhi(c.w));
            *(v4u*)(ATTN + (size_t)t * AOW + 8 * lane) = o; }
    }
    SEAM(4);
    if (IN(5)) REP(5) {
        pg8::StaticOrder So; So.init(S, D, G, bx);
        { pg8::Gemm g{ATTN, WAB, AOW, AOW, S, D, AOW, 0}; EpiGate E{MERGED, GA, 0}; pg8::gemm_phase<EpiGate>(lds, g, So, E); }
        { pg8::Gemm g{DPOOL, WPB, PW, PW, S, D, PW, 0}; EpiGate E{MERGED, GB, 1}; pg8::gemm_phase<EpiGate>(lds, g, So, E); }
    }
    SEAM(5);
    if (IN(6)) REP(6) {
        pg8::Gemm g{MERGED, WOUT, D, D, S, D, D, 0}; pg8::StaticOrder So; So.init(S, D, G, bx);
        EpiResid2 E{H, x, gate1, XN, G2S, SSP};
        pg8::gemm_phase<EpiResid2>(lds, g, So, E);
    }
    SEAM(6);
    if (IN(8)) REP(8) {
        pg8::Gemm g{XN, WQ, D, D, S, D, D, 0}; pg8::StaticOrder So; So.init(S, D, G, bx);
        LAS float* rrl = (LAS float*)(lds + 131072);
        pg8::Unit u0{0, 0}, u1{0, 0}; const bool h0 = So.next(0, u0), h1 = So.next(1, u1); if (!h1) u1 = u0;
        { const pg8::Unit uu = (tid < 256) ? u0 : u1; const int row = uu.pm * 256 + (tid & 255); float ss = 0.f;
#pragma unroll
          for (int q = 0; q < 8; ++q) { const f32x4 p = *(const f32x4*)(SSP + (size_t)row * 32 + 4 * q); ss += (p.x + p.y) + (p.z + p.w); }
          const float r = 1.0f / sqrtf(ss * (1.f / D) + EPS);
          rrl[tid] = r; if (h0 && uu.pn == 0 && (tid < 256 || h1)) RR[row] = r; }
        __syncthreads();
        EpiScores E{SC, CVEC, rrl, u0.pm};
        pg8::gemm_phase<EpiScores>(lds, g, So, E);
    }
    SEAM(8);
    if (IN(9)) {
        LAS int* lk = (LAS int*)(lds + wave * 16384);
        for (int job = gw; job < (S / 64) * 8; job += NGW) route8(SC, job, lane, EID, GATE, DSCT, DSC, USC, lk);
    }
    SEAM(9);
    if (IN(10)) {
        const int lane = (int)__builtin_amdgcn_mbcnt_hi(~0u, __builtin_amdgcn_mbcnt_lo(~0u, 0u));
        const int x = bx & 7, blk = bx >> 3, nblk = G >> 3, tpb = S / nblk, g = lane >> 3, j = lane & 7;
        const unsigned char* sub = DOWN + (size_t)x * SLICE_B; float* up = UPART + (size_t)x * S * 128;
        if ((G & 7) == 0) {
#define ROW1(EH, ST) qrow_load_o(sub, (unsigned)(__shfl(EH, 8 * ((ST) & 7) + g) * SLICE_ROW_B), j)
        int tt = wave; int t = blk * tpb + tt;
        const int tlast = blk * tpb + tpb - 1;
        v4u xr[4]; int e0 = 0, e1 = 0, e0n = 0, e1n = 0; QRow R[16];
        if (tt < tpb) {
            const int t1 = (t + NWAVES <= tlast) ? t + NWAVES : t;
#pragma unroll
            for (int q = 0; q < 4; ++q) xr[q] = *(const v4u*)(XN + (unsigned)(t * D + 256 * x + 32 * j + 8 * q));
            e0 = EID[(unsigned)(t * 128) + lane]; e1 = EID[(unsigned)(t * 128) + 64 + lane];
            e0n = EID[(unsigned)(t1 * 128) + lane]; e1n = EID[(unsigned)(t1 * 128) + 64 + lane];
#pragma unroll
            for (int st = 0; st < 16; ++st) R[st] = ROW1(st < 8 ? e0 : e1, st);
        }
        for (; tt < tpb; tt += NWAVES) {
            const int tn = (t + NWAVES <= tlast) ? t + NWAVES : t, tnn = (tn + NWAVES <= tlast) ? tn + NWAVES : tn;
            const int e0nn = EID[(unsigned)(tnn * 128) + lane], e1nn = EID[(unsigned)(tnn * 128) + 64 + lane];
            f32x2p xs[16];
#pragma unroll
            for (int q = 0; q < 4; ++q) { const v4u p = xr[q];
                xs[4 * q + 0] = (f32x2p){bflo(p.x), bfhi(p.x)}; xs[4 * q + 1] = (f32x2p){bflo(p.y), bfhi(p.y)}; xs[4 * q + 2] = (f32x2p){bflo(p.z), bfhi(p.z)}; xs[4 * q + 3] = (f32x2p){bflo(p.w), bfhi(p.w)}; }
#pragma unroll
            for (int q = 0; q < 4; ++q) xr[q] = *(const v4u*)(XN + (unsigned)(tn * D + 256 * x + 32 * j + 8 * q));
            float dd[8]; float dep = 0.f;
#pragma unroll
            for (int st = 0; st < 8; ++st) { dd[st] = qdot(R[st], xs, dep); dep = dd[st]; R[st] = ROW1(e0n, st); }
            const float kp0 = reduce8j(dd, lane);
#pragma unroll
            for (int st = 0; st < 8; ++st) { dd[st] = qdot(R[8 + st], xs, dep); dep = dd[st]; R[8 + st] = ROW1(e1n, st); }
            const float kp1 = reduce8j(dd, lane);
            up[(unsigned)(t * 128) + 8 * j + g] = kp0; up[(unsigned)(t * 128) + 64 + 8 * j + g] = kp1;
            e0n = e0nn; e1n = e1nn; t = tn;
        }
        }
    }
    SEAM(10);
    if (IN(11)) {
        const int lane = (int)__builtin_amdgcn_mbcnt_hi(~0u, __builtin_amdgcn_mbcnt_lo(~0u, 0u));
        for (int t = gw; t < S; t += NGW) {
            float u0 = 0.f, u1 = 0.f;
#pragma unroll
            for (int y = 0; y < 8; ++y) { u0 += UPART[(unsigned)((y * S + t) * 128 + lane)]; u1 += UPART[(unsigned)((y * S + t) * 128 + 64 + lane)]; }
            { const float rr = RR[t]; const int ea = EID[(unsigned)(t * 128) + lane], eb = EID[(unsigned)(t * 128) + 64 + lane];
              u0 = u0 * rr + CSUM[ea]; u1 = u1 * rr + CSUM[eb]; }
            u0 *= DSCT[(unsigned)(t * 128) + lane]; u1 *= DSCT[(unsigned)(t * 128) + 64 + lane];
            GATE[(unsigned)(t * 128) + lane] *= 0.5f * u0 * (1.0f + erff(u0 * 0.70710678118654752f));
            GATE[(unsigned)(t * 128) + 64 + lane] *= 0.5f * u1 * (1.0f + erff(u1 * 0.70710678118654752f));
        }
    }
    SEAM(11);
    if (IN(12)) {
        const int lane = (int)__builtin_amdgcn_mbcnt_hi(~0u, __builtin_amdgcn_mbcnt_lo(~0u, 0u));
        const int x = bx & 7, blk = bx >> 3, nblk = G >> 3, tpb = S / nblk, g = lane >> 3, j = lane & 7;
        const unsigned char* sub = UP + (size_t)x * SLICE_B;
        LAS float* red = (LAS float*)(lds + wave * 16384);
        if ((G & 7) == 0) {
        int tt = wave; int t = blk * tpb + tt;
        const int tlast = blk * tpb + tpb - 1;
        int e0 = 0, e1 = 0, e0n = 0, e1n = 0; float a0 = 0.f, a1 = 0.f; QRow R[16];
        const int c0 = 256 * x + 4 * lane;
        const f32x4 g2 = *(const f32x4*)(gate2 + (unsigned)c0);
        v2u hb = {0u, 0u};
#define P11_META(T, A0, A1) do { A0 = GATE[(unsigned)((T) * 128) + lane]; A1 = GATE[(unsigned)((T) * 128) + 64 + lane]; } while (0)
        if (tt < tpb) {
            const int t1 = (t + NWAVES <= tlast) ? t + NWAVES : t;
            P11_META(t, a0, a1);
            hb = *(const v2u*)(H + (unsigned)(t * D + c0));
            e0 = EID[(unsigned)(t * 128) + lane]; e1 = EID[(unsigned)(t * 128) + 64 + lane];
            e0n = EID[(unsigned)(t1 * 128) + lane]; e1n = EID[(unsigned)(t1 * 128) + 64 + lane];
#pragma unroll
            for (int st = 0; st < 16; ++st) R[st] = ROW1(st < 8 ? e0 : e1, st);
        }
        for (; tt < tpb; tt += NWAVES) {
            const int tn = (t + NWAVES <= tlast) ? t + NWAVES : t, tnn = (tn + NWAVES <= tlast) ? tn + NWAVES : tn;
            const int e0nn = EID[(unsigned)(tnn * 128) + lane], e1nn = EID[(unsigned)(tnn * 128) + 64 + lane];
            float a0n, a1n; P11_META(tn, a0n, a1n);
            f32x2p acc[16];
#pragma unroll
            for (int i = 0; i < 16; ++i) acc[i] = (f32x2p){0.f, 0.f};
#pragma unroll
            for (int st = 0; st < 8; ++st) { qaxpy(acc, R[st], __shfl(a0, 8 * st + g)); R[st] = ROW1(e0n, st); }
#pragma unroll
            for (int st = 0; st < 8; ++st) { qaxpy(acc, R[8 + st], __shfl(a1, 8 * st + g)); R[8 + st] = ROW1(e1n, st); }
            const f32x4 hh = {bflo(hb.x), bfhi(hb.x), bflo(hb.y), bfhi(hb.y)};
            LAS float* wp = red + (g * 8 + j) * 36;
#pragma unroll
            for (int q = 0; q < 8; ++q) *(LAS f32x4*)(wp + 4 * q) = (f32x4){acc[2 * q].x, acc[2 * q].y, acc[2 * q + 1].x, acc[2 * q + 1].y};
            LDS_WAIT(); asm volatile("" ::: "memory");
            f32x4 pe = {0.f, 0.f, 0.f, 0.f};
#pragma unroll
            for (int gg = 0; gg < 8; ++gg) pe = pe + *(LAS const f32x4*)(red + (gg * 8 + (lane >> 3)) * 36 + 4 * (lane & 7));
            LDS_WAIT(); asm volatile("" ::: "memory");
            const f32x4 v = hh + g2 * pe;
            { v2u vw; vw.x = pk2(v.x, v.y); vw.y = pk2(v.z, v.w); *(v2u*)(VB + (unsigned)(t * D + c0)) = vw; }
            hb = *(const v2u*)(H + (unsigned)(tn * D + c0));
            const float ss = wave_sum((v.x * v.x + v.y * v.y) + (v.z * v.z + v.w * v.w));
            if (lane == 0) SSQ[(unsigned)(t * 8 + x)] = ss;
            e0n = e0nn; e1n = e1nn; a0 = a0n; a1 = a1n; t = tn;
        }
#undef P11_META
#undef ROW1
        }
    }
    SEAM(12);
    if (IN(13)) {
        const int lane = (int)__builtin_amdgcn_mbcnt_hi(~0u, __builtin_amdgcn_mbcnt_lo(~0u, 0u));
        f32x4 fgv[8];
#pragma unroll
        for (int q = 0; q < 8; ++q) fgv[q] = *((const f32x4*)final_g + lane + 64 * q);
        v2u cur[8]; float sq[8];
        int t = gw;
        if (t < S) {
#pragma unroll
            for (int q = 0; q < 8; ++q) { cur[q] = *((const v2u*)(VB + (size_t)t * D) + lane + 64 * q); sq[q] = SSQ[(size_t)t * 8 + q]; } }
        for (; t < S; t += NGW) {
            const int tn = (t + NGW < S) ? t + NGW : t;
            v2u nxt[8]; float sqn[8];
#pragma unroll
            for (int q = 0; q < 8; ++q) { nxt[q] = *((const v2u*)(VB + (size_t)tn * D) + lane + 64 * q); sqn[q] = SSQ[(size_t)tn * 8 + q]; }
            float ss = 0.f;
#pragma unroll
            for (int y = 0; y < 8; ++y) ss += sq[y];
            const float rr = 1.0f / sqrtf(ss * (1.f / D) + EPS);
            f32x4* orow = (f32x4*)(out + (size_t)t * D) + lane;
#pragma unroll
            for (int q = 0; q < 8; ++q) { const f32x4 c = {bflo(cur[q].x), bfhi(cur[q].x), bflo(cur[q].y), bfhi(cur[q].y)}; orow[64 * q] = c * rr * fgv[q]; }
#pragma unroll
            for (int q = 0; q < 8; ++q) { cur[q] = nxt[q]; sq[q] = sqn[q]; }
        }
    }
#undef IN
#undef SEAM
}

extern "C" void kernel_launch(void* const* d_in, const int* in_sizes, int n_in, void* d_out, int out_size, void* d_ws, size_t ws_size, hipStream_t stream) {
    static int grid = 0;
    if (grid == 0) {
        if (n_in != 17 || out_size != S * D || ws_size < WS_END) { fprintf(stderr, "kernel_launch: unexpected shapes (n_in %d, out %d, ws %zu); nothing launched\n", n_in, out_size, ws_size); grid = -1; return; }
        int dev = 0, cus = 0, per_cu = 0;
        if (hipGetDevice(&dev) != hipSuccess || hipDeviceGetAttribute(&cus, hipDeviceAttributeMultiprocessorCount, dev) != hipSuccess) { grid = -1; return; }
        if (hipFuncSetAttribute((const void*)mk_fwd, hipFuncAttributeMaxDynamicSharedMemorySize, LDS_BYTES) != hipSuccess) { fprintf(stderr, "kernel_launch: hipFuncSetAttribute failed\n"); grid = -1; return; }
        if (hipOccupancyMaxActiveBlocksPerMultiprocessor(&per_cu, (const void*)mk_fwd, NWAVES * 64, LDS_BYTES) != hipSuccess || per_cu < 1) { fprintf(stderr, "kernel_launch: occupancy query says %d blocks per CU\n", per_cu); per_cu = 1; }
        (void)hipGetLastError();
        grid = 1; while (grid * 2 <= cus) grid *= 2;
    }
    if (grid < 0) return;
    (void)hipMemsetAsync((char*)d_ws + WS_CTL, 0, CTL_ZERO_BYTES, stream);
    Args a{};
    for (int i = 0; i < 17; ++i) a.in[i] = (const float*)d_in[i];
    a.out = (float*)d_out; a.hbuf = (float*)d_out; a.ws = (unsigned char*)d_ws;
    if (MK_N_LAUNCHES == 1 && !HOST_SPLIT) {
        a.ph_lo = 0; a.ph_hi = N_PHASES; a.li = 0;
        void* kargs[] = {&a};
        hipError_t e = hipLaunchCooperativeKernel((const void*)mk_fwd, dim3(grid), dim3(NWAVES * 64), kargs, LDS_BYTES, stream);
        if (e != hipSuccess) fprintf(stderr, "kernel_launch: cooperative launch failed: %s (grid %d)\n", hipGetErrorString(e), grid);
    } else {
        for (int li = 0; li < N_PHASES; ++li) { a.ph_lo = li; a.ph_hi = li + 1; a.li = li;
#ifdef DUP_PHASE
            if (li == DUP_PHASE) { Args b = a; if (li == 99) b.out = (float*)((char*)d_ws + 412 * MiB); hipLaunchKernelGGL(mk_fwd, dim3(grid), dim3(NWAVES * 64), LDS_BYTES, stream, b); }
#endif
            hipLaunchKernelGGL(mk_fwd, dim3(grid), dim3(NWAVES * 64), LDS_BYTES, stream, a); }
    }
}
```

```cpp
#include <hip/hip_runtime.h>
#include <cstdio>
#include <cstdint>
#include <cmath>

#ifndef MK_N_LAUNCHES
#define MK_N_LAUNCHES 1
#endif
constexpr int N_PHASES = 14;
#define KN_CHAIN10 1
#define KN_PK10 1
#define KN_CHAIN11 0
#define KN_PK11 0
#ifndef HOST_SPLIT
#define HOST_SPLIT 0
#endif
#ifndef PROBE_PHASE
#define PROBE_PHASE -1
#endif
#define REP(k) for (int _rep = 0; _rep < ((PROBE_PHASE == (k)) ? 2 : 1); ++_rep)

namespace pg8 {
#define PG8_LAS __attribute__((address_space(3)))
typedef unsigned short bf16_t;
typedef short bf16x8 __attribute__((ext_vector_type(8)));
typedef float f32x4 __attribute__((ext_vector_type(4)));
typedef unsigned u32x4 __attribute__((ext_vector_type(4)));
constexpr int BM = 256, BK = 64, HALF = 128, HTB = HALF * BK * 2, STAGE_BYTES = 8 * HTB, NXCD = 8, WGM = 4;

__host__ __device__ __forceinline__ int lds_byte(int r, int c) { const int st = (r >> 4) * 2 + (c >> 5), rr = r & 15, cc = c & 31, ob = rr * 64 + cc * 2; return st * 1024 + (ob ^ (((ob >> 9) & 1) << 5)); }
__host__ __device__ __forceinline__ void stage_rc(int b, int& R, int& C) { const int st = b / 1024, sb = b % 1024, swz = sb ^ (((sb >> 9) & 1) << 5); R = (st >> 1) * 16 + swz / 64; C = (st & 1) * 32 + (swz % 64) / 2; }
__host__ __device__ __forceinline__ int perm32(int rho) { const int n = rho >> 4, i = rho & 15; return 8 * (i >> 2) + 4 * n + (i & 3); }

struct Unit { int pm, pn; };
struct Gemm { const bf16_t* A; const bf16_t* Bt; int lda, ldb, M, N, K; int acol_per_pn; };

struct StaticOrder {
    int nM, nN, nwg, G, c, wgm;
    __host__ __device__ void init(int M, int N, int G_, int c_, int wgm_ = WGM) { nM = M / BM; nN = N / BM; nwg = nM * nN; G = G_; c = c_; wgm = wgm_; }
    __host__ __device__ bool next(int i, Unit& u) const {
        const long L = (long)i * G + c; if (L >= nwg) return false;
        int wgid = (int)L; { const int q = nwg / NXCD, r = nwg % NXCD, xcd = wgid % NXCD, off = wgid / NXCD; wgid = (xcd < r ? xcd * (q + 1) : r * (q + 1) + (xcd - r) * q) + off; }
        const int nig = wgm * nN, gid = wgid / nig, fm = gid * wgm, gsz = (nM - fm) < wgm ? (nM - fm) : wgm;
        u.pm = fm + ((wgid % nig) % gsz); u.pn = (wgid % nig) / gsz; return true;
    }
};

template <class Epi>
__device__ __forceinline__ void gemm_phase(PG8_LAS unsigned char* lds, const Gemm g, const StaticOrder& S, const Epi& E) {
    const int tid = threadIdx.x, wid = __builtin_amdgcn_readfirstlane(tid >> 6), lane = tid & 63, wr = wid >> 2, wc = wid & 3, fr = lane & 15, fq = lane >> 4;
    const int K = g.K, nt = K / BK;
    unsigned voffA[2], voffB[2];
#pragma unroll
    for (int i = 0; i < 2; ++i) { int R, C; stage_rc(tid * 16 + i * 8192, R, C); const int Rb = Epi::PERM ? ((R & ~31) + perm32(R & 31)) : R;
        voffA[i] = (unsigned)(R * g.lda + C) * 2u; voffB[i] = (unsigned)(Rb * g.ldb + C) * 2u; }
    const size_t kstep = (size_t)(BK * 2);
    const size_t hstepA = (size_t)HALF * g.lda * 2, hstepB = (size_t)HALF * g.ldb * 2;
    const size_t tstepA = 2 * hstepA, tstepB = 2 * hstepB, cstepA = (size_t)g.acol_per_pn * 2;
    const unsigned ldsw = (unsigned)wid * 1024u;
    const int aoff = lds_byte(wr * 64 + fr, fq * 8), boff = lds_byte(wc * 32 + fr, fq * 8);
#define PG8_SA(b, h) (((b) * 2 + (h)) * HTB)
#define PG8_SB(b, h) ((4 + (b) * 2 + (h)) * HTB)
#define PG8_STAGE(bufoff, gbase, voff) do { _Pragma("unroll") for (int _i = 0; _i < 2; ++_i) \
        __builtin_amdgcn_global_load_lds((const unsigned*)((const char*)(gbase) + (voff)[_i]), (PG8_LAS unsigned*)(lds + (bufoff) + ldsw + _i * 8192), 16, 0, 0); } while (0)
#define PG8_LDA(dst, b, h) do { _Pragma("unroll") for (int m = 0; m < 4; ++m) _Pragma("unroll") for (int k = 0; k < 2; ++k) dst[m][k] = *(const PG8_LAS bf16x8*)(lds + PG8_SA(b, h) + aoff + m * 2048 + k * 1024); } while (0)
#define PG8_LDB(dst, b, h) do { _Pragma("unroll") for (int n = 0; n < 2; ++n) _Pragma("unroll") for (int k = 0; k < 2; ++k) dst[n][k] = *(const PG8_LAS bf16x8*)(lds + PG8_SB(b, h) + boff + n * 2048 + k * 1024); } while (0)
#define PG8_MMA(ai, bj, At, Bt) do { __builtin_amdgcn_s_setprio(3); _Pragma("unroll") for (int m = 0; m < 4; ++m) _Pragma("unroll") for (int n = 0; n < 2; ++n) _Pragma("unroll") for (int k = 0; k < 2; ++k) \
        acc[ai][bj][m][n] = __builtin_amdgcn_mfma_f32_16x16x32_bf16(Bt[n][k], At[m][k], acc[ai][bj][m][n], 0, 0, 0); __builtin_amdgcn_s_setprio(0); } while (0)
#define PG8_WAIT_V(n) asm volatile("s_waitcnt vmcnt(" #n ")" ::: "memory")
#define PG8_WAIT_L(n) asm volatile("s_waitcnt lgkmcnt(" #n ")" ::: "memory")
#define PG8_BAR __builtin_amdgcn_s_barrier()
#define PG8_SCHED __builtin_amdgcn_sched_barrier(0)
    Unit cur, nxt; int ui = 0;
    if (!S.next(0, cur)) return;
    f32x4 acc[2][2][4][2];
#pragma unroll
    for (int a = 0; a < 2; ++a)
#pragma unroll
        for (int b = 0; b < 2; ++b)
#pragma unroll
            for (int m = 0; m < 4; ++m)
#pragma unroll
                for (int n = 0; n < 2; ++n) acc[a][b][m][n] = (f32x4){0.f, 0.f, 0.f, 0.f};
    bf16x8 At[4][2], B0[2][2], B1[2][2];
    const char* cA = (const char*)g.A + (size_t)cur.pm * tstepA + (size_t)cur.pn * cstepA; const char* cB = (const char*)g.Bt + (size_t)cur.pn * tstepB;
    PG8_STAGE(PG8_SB(0, 0), cB, voffB); PG8_STAGE(PG8_SB(0, 1), cB + hstepB, voffB); PG8_STAGE(PG8_SA(0, 0), cA, voffA); PG8_STAGE(PG8_SA(0, 1), cA + hstepA, voffA);
    if (wr == 1) PG8_BAR;
    PG8_WAIT_V(2); PG8_BAR;
    PG8_STAGE(PG8_SB(1, 0), cB + kstep, voffB); PG8_STAGE(PG8_SA(1, 0), cA + kstep, voffA); PG8_STAGE(PG8_SB(1, 1), cB + hstepB + kstep, voffB);
    PG8_WAIT_V(6); PG8_BAR;
    for (;;) {
        const bool has_next = S.next(ui + 1, nxt);
        const char* nA = has_next ? (const char*)g.A + (size_t)nxt.pm * tstepA + (size_t)nxt.pn * cstepA : cA; const char* nB = has_next ? (const char*)g.Bt + (size_t)nxt.pn * tstepB : cB;
        for (int t = 0; t < nt; t += 2) {
            const bool last = (t == nt - 2);
            const char* a1 = cA + (size_t)(t + 1) * kstep;
            const char* a2 = last ? nA : cA + (size_t)(t + 2) * kstep; const char* b2 = last ? nB : cB + (size_t)(t + 2) * kstep;
            const char* a3 = a2 + kstep; const char* b3 = b2 + kstep;
            PG8_LDB(B0, 0, 0); PG8_LDB(B1, 0, 1); PG8_SCHED; PG8_LDA(At, 0, 0); PG8_STAGE(PG8_SA(1, 1), a1 + hstepA, voffA);
            PG8_WAIT_V(8); PG8_WAIT_L(0); PG8_BAR; PG8_MMA(0, 0, At, B0); PG8_MMA(0, 1, At, B1); PG8_BAR; PG8_SCHED;
            PG8_LDA(At, 0, 1); PG8_STAGE(PG8_SB(0, 0), b2, voffB); PG8_STAGE(PG8_SB(0, 1), b2 + hstepB, voffB); PG8_STAGE(PG8_SA(0, 0), a2, voffA);
            PG8_WAIT_V(8); PG8_WAIT_L(0); PG8_BAR; PG8_MMA(1, 0, At, B0); PG8_MMA(1, 1, At, B1); PG8_BAR; PG8_SCHED;
            PG8_LDB(B0, 1, 0); PG8_LDB(B1, 1, 1); PG8_SCHED; PG8_LDA(At, 1, 0); PG8_STAGE(PG8_SA(0, 1), a2 + hstepA, voffA);
            PG8_WAIT_V(8); PG8_WAIT_L(0); PG8_BAR; PG8_MMA(0, 0, At, B0); PG8_MMA(0, 1, At, B1); PG8_BAR; PG8_SCHED;
            PG8_LDA(At, 1, 1); PG8_STAGE(PG8_SB(1, 0), b3, voffB); PG8_STAGE(PG8_SB(1, 1), b3 + hstepB, voffB); PG8_STAGE(PG8_SA(1, 0), a3, voffA);
            PG8_WAIT_V(8); PG8_WAIT_L(0); PG8_BAR; PG8_MMA(1, 0, At, B0); PG8_MMA(1, 1, At, B1); PG8_BAR; PG8_SCHED;
        }
        if (wr == 0) PG8_BAR;
        E(acc, cur, wr, wc, fr, fq);
        if (!has_next) break;
#pragma unroll
        for (int a = 0; a < 2; ++a)
#pragma unroll
            for (int b = 0; b < 2; ++b)
#pragma unroll
                for (int m = 0; m < 4; ++m)
#pragma unroll
                    for (int n = 0; n < 2; ++n) acc[a][b][m][n] = (f32x4){0.f, 0.f, 0.f, 0.f};
        cur = nxt; cA = nA; cB = nB; ++ui;
        if (wr == 1) PG8_BAR;
    }
    PG8_WAIT_V(0);
    PG8_BAR;
#undef PG8_SA
#undef PG8_SB
#undef PG8_STAGE
#undef PG8_LDA
#undef PG8_LDB
#undef PG8_MMA
#undef PG8_WAIT_V
#undef PG8_WAIT_L
#undef PG8_BAR
#undef PG8_SCHED
}
typedef int v8i32_t __attribute__((ext_vector_type(8)));
typedef int v4i32_t __attribute__((ext_vector_type(4)));
template <class Epi>
__device__ __forceinline__ void gemm_phase_f8n(PG8_LAS unsigned char* lds, const Gemm g, const StaticOrder& S, const Epi& E) {
    const int tid = threadIdx.x, wid = __builtin_amdgcn_readfirstlane(tid >> 6), lane = tid & 63, wr = wid >> 2, wc = wid & 3, fr = lane & 15, fq = lane >> 4;
    const int K = g.K, nt = K / BK;
    unsigned voffA[2], voffB[2];
#pragma unroll
    for (int i = 0; i < 2; ++i) { int R, C; stage_rc(tid * 16 + i * 8192, R, C); const int Rb = Epi::PERM ? ((R & ~31) + perm32(R & 31)) : R;
        voffA[i] = (unsigned)(R * g.lda + C) * 2u; voffB[i] = (unsigned)(Rb * g.ldb + C) * 2u; }
    const size_t kstep = (size_t)(BK * 2);
    const size_t hstepA = (size_t)HALF * g.lda * 2, hstepB = (size_t)HALF * g.ldb * 2;
    const size_t tstepA = 2 * hstepA, tstepB = 2 * hstepB, cstepA = (size_t)g.acol_per_pn * 2;
    const unsigned ldsw = (unsigned)wid * 1024u;
    const int aoff = lds_byte(wr * 64 + fr, fq * 8), boff = lds_byte(wc * 32 + fr, fq * 8);
#define PG8_SA(b, h) (((b) * 2 + (h)) * HTB)
#define PG8_SB(b, h) ((4 + (b) * 2 + (h)) * HTB)
#define PG8_STAGE(bufoff, gbase, voff) do { _Pragma("unroll") for (int _i = 0; _i < 2; ++_i) \
        __builtin_amdgcn_global_load_lds((const unsigned*)((const char*)(gbase) + (voff)[_i]), (PG8_LAS unsigned*)(lds + (bufoff) + ldsw + _i * 8192), 16, 0, 0); } while (0)
#define PG8_LDA(dst, b, h) do { _Pragma("unroll") for (int m = 0; m < 4; ++m) _Pragma("unroll") for (int k = 0; k < 2; ++k) dst[m][k] = *(const PG8_LAS bf16x8*)(lds + PG8_SA(b, h) + aoff + m * 2048 + k * 1024); } while (0)
#define PG8_LDB(dst, b, h) do { _Pragma("unroll") for (int n = 0; n < 2; ++n) _Pragma("unroll") for (int k = 0; k < 2; ++k) dst[n][k] = *(const PG8_LAS bf16x8*)(lds + PG8_SB(b, h) + boff + n * 2048 + k * 1024); } while (0)
#define PG8_CAT(x) __builtin_shufflevector(__builtin_bit_cast(v4i32_t, x[0]), __builtin_bit_cast(v4i32_t, x[1]), 0, 1, 2, 3, 4, 5, 6, 7)
#define PG8_MMA(ai, bj, At, Bt) do { __builtin_amdgcn_s_setprio(3); _Pragma("unroll") for (int m = 0; m < 4; ++m) _Pragma("unroll") for (int n = 0; n < 2; ++n) \
        acc[ai][bj][m][n] = __builtin_amdgcn_mfma_scale_f32_16x16x128_f8f6f4(PG8_CAT(Bt[n]), PG8_CAT(At[m]), acc[ai][bj][m][n], 0, 0, 0, 0x7f7f7f7f, 0, 0x7f7f7f7f); __builtin_amdgcn_s_setprio(0); } while (0)
#define PG8_WAIT_V(n) asm volatile("s_waitcnt vmcnt(" #n ")" ::: "memory")
#define PG8_WAIT_L(n) asm volatile("s_waitcnt lgkmcnt(" #n ")" ::: "memory")
#define PG8_BAR __builtin_amdgcn_s_barrier()
#define PG8_SCHED __builtin_amdgcn_sched_barrier(0)
    Unit cur, nxt; int ui = 0;
    if (!S.next(0, cur)) return;
    f32x4 acc[2][2][4][2];
#pragma unroll
    for (int a = 0; a < 2; ++a)
#pragma unroll
        for (int b = 0; b < 2; ++b)
#pragma unroll
            for (int m = 0; m < 4; ++m)
#pragma unroll
                for (int n = 0; n < 2; ++n) acc[a][b][m][n] = (f32x4){0.f, 0.f, 0.f, 0.f};
    bf16x8 At[4][2], B0[2][2];
    const char* cA = (const char*)g.A + (size_t)cur.pm * tstepA + (size_t)cur.pn * cstepA; const char* cB = (const char*)g.Bt + (size_t)cur.pn * hstepB;
    PG8_STAGE(PG8_SB(0, 0), cB, voffB); PG8_STAGE(PG8_SA(0, 0), cA, voffA); PG8_STAGE(PG8_SA(0, 1), cA + hstepA, voffA);
    if (wr == 1) PG8_BAR;
    PG8_WAIT_V(2); PG8_BAR;
    PG8_STAGE(PG8_SB(1, 0), cB + kstep, voffB); PG8_STAGE(PG8_SA(1, 0), cA + kstep, voffA);
    PG8_WAIT_V(4); PG8_BAR;
    for (;;) {
        const bool has_next = S.next(ui + 1, nxt);
        const char* nA = has_next ? (const char*)g.A + (size_t)nxt.pm * tstepA + (size_t)nxt.pn * cstepA : cA; const char* nB = has_next ? (const char*)g.Bt + (size_t)nxt.pn * hstepB : cB;
        for (int t = 0; t < nt; t += 2) {
            const bool last = (t == nt - 2);
            const char* a1 = cA + (size_t)(t + 1) * kstep;
            const char* a2 = last ? nA : cA + (size_t)(t + 2) * kstep; const char* b2 = last ? nB : cB + (size_t)(t + 2) * kstep;
            const char* a3 = a2 + kstep; const char* b3 = b2 + kstep;
            PG8_LDB(B0, 0, 0); PG8_SCHED; PG8_LDA(At, 0, 0); PG8_STAGE(PG8_SA(1, 1), a1 + hstepA, voffA);
            PG8_WAIT_V(6); PG8_WAIT_L(0); PG8_BAR; PG8_MMA(0, 0, At, B0); PG8_BAR; PG8_SCHED;
            PG8_LDA(At, 0, 1); PG8_STAGE(PG8_SB(0, 0), b2, voffB); PG8_STAGE(PG8_SA(0, 0), a2, voffA);
            PG8_WAIT_V(6); PG8_WAIT_L(0); PG8_BAR; PG8_MMA(1, 0, At, B0); PG8_BAR; PG8_SCHED;
            PG8_LDB(B0, 1, 0); PG8_SCHED; PG8_LDA(At, 1, 0); PG8_STAGE(PG8_SA(0, 1), a2 + hstepA, voffA);
            PG8_WAIT_V(6); PG8_WAIT_L(0); PG8_BAR; PG8_MMA(0, 0, At, B0); PG8_BAR; PG8_SCHED;
            PG8_LDA(At, 1, 1); PG8_STAGE(PG8_SB(1, 0), b3, voffB); PG8_STAGE(PG8_SA(1, 0), a3, voffA);
            PG8_WAIT_V(6); PG8_WAIT_L(0); PG8_BAR; PG8_MMA(1, 0, At, B0); PG8_BAR; PG8_SCHED;
        }
        if (wr == 0) PG8_BAR;
        E(acc, cur, wr, wc, fr, fq);
        if (!has_next) break;
#pragma unroll
        for (int a = 0; a < 2; ++a)
#pragma unroll
            for (int b = 0; b < 2; ++b)
#pragma unroll
                for (int m = 0; m < 4; ++m)
#pragma unroll
                    for (int n = 0; n < 2; ++n) acc[a][b][m][n] = (f32x4){0.f, 0.f, 0.f, 0.f};
        cur = nxt; cA = nA; cB = nB; ++ui;
        if (wr == 1) PG8_BAR;
    }
    PG8_WAIT_V(0);
    PG8_BAR;
#undef PG8_SA
#undef PG8_SB
#undef PG8_STAGE
#undef PG8_LDA
#undef PG8_LDB
#undef PG8_MMA
#undef PG8_CAT
#undef PG8_WAIT_V
#undef PG8_WAIT_L
#undef PG8_BAR
#undef PG8_SCHED
}
}

constexpr int S = 16384, D = 2048, AW = 1536, NH = 12, HD = 128, AOW = 512, PW = 512, INW = 9216;
constexpr int PH = 8, PK = 16, NKEY = 128;
constexpr float EPS = 1e-6f;
constexpr float QSCALE = 0.08838834764831845f * 1.4426950408889634f;
constexpr int NWAVES = 8;

constexpr size_t MiB = 1u << 20;
constexpr size_t WS_CTL = 0, CTL_ZERO_BYTES = 1 * MiB;
constexpr size_t WS_MOD = 512 * 1024;
constexpr size_t WS_INVF = 1 * MiB;
constexpr size_t WS_DSC = 1 * MiB + 65536, WS_USC = 1 * MiB + 131072;
constexpr size_t WS_CSUM = 1 * MiB + 786432;
constexpr size_t WS_G2S = 1 * MiB + 925696;
constexpr size_t WS_CVEC = 1 * MiB + 851968;
constexpr size_t WS_RR = 1 * MiB + 860160;
constexpr size_t WS_SSP = 6 * MiB;
constexpr size_t WS_SSQ = 1 * MiB + 196608;
constexpr size_t WS_EID = 396 * MiB, WS_GATE = 404 * MiB;
constexpr size_t WS_DSCT = 412 * MiB;
constexpr size_t WS_UPART = 252 * MiB;
constexpr size_t WS_WAB = 2 * MiB, WS_WPB = 4 * MiB, WS_MIX = 6 * MiB, WS_KEYS = 7 * MiB, WS_WOUT = 8 * MiB, WS_WQ = 16 * MiB, WS_WIN = 24 * MiB;
constexpr size_t WS_DOWN = 60 * MiB, WS_UP = 124 * MiB;
constexpr size_t WS_XN = 188 * MiB;
constexpr size_t WS_OG = 188 * MiB, WS_LSE = 236 * MiB;
constexpr size_t WS_Q = 252 * MiB, WS_K = 300 * MiB, WS_V = 348 * MiB, WS_PIN = 396 * MiB, WS_GA = 412 * MiB, WS_GB = 476 * MiB;
constexpr size_t WS_DPOOL = 24 * MiB, WS_ATTN = 40 * MiB;
constexpr size_t WS_POOL = 252 * MiB;
constexpr size_t WS_MERGED = 300 * MiB;
constexpr size_t WS_PQ = 412 * MiB;
constexpr size_t WS_VB = 316 * MiB;
constexpr size_t WS_HB = 476 * MiB;
constexpr size_t WS_SC = 252 * MiB;
constexpr size_t WS_XN8 = 540 * MiB;
constexpr size_t WS_WIN8 = 444 * MiB;
constexpr size_t WS_END = 580 * MiB;
constexpr int CW_BAR = 4096;

constexpr int RING_BYTES = 147456;
constexpr int LDSCTL_OFF = RING_BYTES, MISC_OFF = LDSCTL_OFF + 320;
constexpr int LDS_BYTES = RING_BYTES + 1024;

#define GAS __attribute__((address_space(1)))
#define LAS __attribute__((address_space(3)))
typedef unsigned short bf16;
typedef unsigned v4u __attribute__((ext_vector_type(4)));
typedef unsigned v2u __attribute__((ext_vector_type(2)));
typedef float f32x4 __attribute__((ext_vector_type(4)));
typedef float f32x2 __attribute__((ext_vector_type(2)));
typedef short bf16x8 __attribute__((ext_vector_type(8)));
typedef short s16x4 __attribute__((ext_vector_type(4)));
typedef __bf16 bf16x2_t __attribute__((ext_vector_type(2)));
#define LDS_WAIT() asm volatile("s_waitcnt lgkmcnt(0)" ::: "memory")
#define VM_WAIT() asm volatile("s_waitcnt vmcnt(0)" ::: "memory")
__device__ __forceinline__ unsigned pk2(float lo, float hi) { f32x2 v = {lo, hi}; bf16x2_t b = __builtin_convertvector(v, bf16x2_t); return __builtin_bit_cast(unsigned, b); }
__device__ __forceinline__ float bflo(unsigned u) { return __uint_as_float(u << 16); }
__device__ __forceinline__ float bfhi(unsigned u) { return __uint_as_float(u & 0xffff0000u); }
__device__ __forceinline__ float wave_sum(float v) {
#pragma unroll
    for (int o = 1; o < 64; o <<= 1) v += __shfl_xor(v, o);
    return v;
}

#define XB_TMO      128
#define XB_XCNT(j)  (256  + 64 * (j))
#define XB_XSUB(j)  (1280 + 64 * (j))
#define XB_XGEN(j)  (2304 + 64 * (j))
#define XB_TOP      3328
#define XB_TOPGEN   3392
#define XCD_BAR_WORDS 3456
#define XB_SPIN_CAP (1u << 22)
__device__ __forceinline__ unsigned xb_ld(unsigned* p)              { return __hip_atomic_load(p, __ATOMIC_RELAXED, __HIP_MEMORY_SCOPE_AGENT); }
__device__ __forceinline__ unsigned xb_add(unsigned* p, unsigned v) { return __hip_atomic_fetch_add(p, v, __ATOMIC_RELAXED, __HIP_MEMORY_SCOPE_AGENT); }
__device__ __forceinline__ unsigned xb_xcc_id() { return (unsigned)__builtin_amdgcn_s_getreg((3 << 11) | 20) & 0xFu; }
#define XB_SPIN(cond, bar) do { unsigned _sp = 0; while (cond) { __builtin_amdgcn_s_sleep(1); \
    if ((++_sp & 255u) == 0u) { if (xb_ld(&(bar)[XB_TMO])) break; if (_sp > XB_SPIN_CAP) { atomicAdd(&(bar)[XB_TMO], 1u); break; } } } } while (0)
struct XcdBarrier { unsigned* bar; unsigned x; volatile LAS unsigned* st; };
__device__ __forceinline__ XcdBarrier xcd_barrier_post(unsigned* bar, volatile LAS unsigned* st) {
    XcdBarrier b; b.bar = bar; b.x = xb_xcc_id(); b.st = st;
    if (threadIdx.x == 0) (void)xb_add(&bar[XB_XCNT(b.x)], 1u);
    return b;
}
__device__ __forceinline__ void xcd_barrier_complete(unsigned* bar, unsigned x, unsigned& nloc, unsigned& nx) {
    const unsigned G = gridDim.x * gridDim.y * gridDim.z;
    unsigned sum, cnt, mine, sp = 0u;
    for (;;) {
        sum = 0u; cnt = 0u; mine = 0u;
#pragma unroll
        for (unsigned j = 0; j < 16; ++j) { const unsigned c = xb_ld(&bar[XB_XCNT(j)]); sum += c; cnt += (c > 0u) ? 1u : 0u; mine = (j == x) ? c : mine; }
        if (sum == G) break;
        __builtin_amdgcn_s_sleep(1);
        if ((++sp & 255u) == 0u) { if (xb_ld(&bar[XB_TMO])) break; if (sp > XB_SPIN_CAP) { atomicAdd(&bar[XB_TMO], 1u); break; } }
    }
    nloc = mine > 0u ? mine : 1u; nx = cnt > 0u ? cnt : 1u;
}
__device__ __forceinline__ void xcd_barrier(const XcdBarrier& b) {
    asm volatile("s_waitcnt vmcnt(0)" ::: "memory");
    __syncthreads();
    if (threadIdx.x == 0) {
        unsigned* bar = b.bar;
        __builtin_amdgcn_s_waitcnt(0);
        unsigned nloc = b.st[0], nx = b.st[1];
        if (nloc == 0u) { xcd_barrier_complete(bar, b.x, nloc, nx); b.st[0] = nloc; b.st[1] = nx; }
        const unsigned old = xb_add(&bar[XB_XSUB(b.x)], 1u);
        const unsigned gen = old / nloc;
        if (old + 1u == (gen + 1u) * nloc) {
            __builtin_amdgcn_fence(__ATOMIC_RELEASE, "agent");
            asm volatile("s_waitcnt vmcnt(0)" ::: "memory");
            const unsigned og = xb_add(&bar[XB_TOP], 1u);
            const unsigned tg = og / nx;
            if (og + 1u == (tg + 1u) * nx) xb_add(&bar[XB_TOPGEN], 1u);
            else XB_SPIN(xb_ld(&bar[XB_TOPGEN]) == tg, bar);
            __builtin_amdgcn_fence(__ATOMIC_ACQUIRE, "agent");
            xb_add(&bar[XB_XGEN(b.x)], 1u);
            asm volatile("s_waitcnt vmcnt(0)" ::: "memory");
        } else {
            XB_SPIN(xb_ld(&bar[XB_XGEN(b.x)]) == gen, bar);
            __builtin_amdgcn_fence(__ATOMIC_ACQUIRE, "agent");
            asm volatile("s_waitcnt vmcnt(0)" ::: "memory");
        }
    }
    __syncthreads();
}

using pg8::Unit;
__device__ __forceinline__ v4u pack8(const f32x4 a, const f32x4 b) { v4u w; w.x = pk2(a[0], a[1]); w.y = pk2(a[2], a[3]); w.z = pk2(b[0], b[1]); w.w = pk2(b[2], b[3]); return w; }

typedef _Float16 h16x2 __attribute__((ext_vector_type(2)));
__device__ __forceinline__ unsigned pkh2(float a, float b) { const h16x2 v = {(_Float16)a, (_Float16)b}; return __builtin_bit_cast(unsigned, v); }
struct EpiInProj {
    static constexpr bool PERM = true;
    bf16 *Q, *K, *V, *PIN, *GA, *GB; const float* invf;
    __device__ __forceinline__ void operator()(const f32x4 (&acc)[2][2][4][2], const Unit& u, int wr, int wc, int fr, int fq) const {
        const int pn = u.pn, row0 = u.pm * 256 + wr * 64 + fr, cl = wc * 32 + 8 * fq;
        if (pn < 12) {
            bf16* base = pn < 6 ? Q : K; const int ct = (pn < 6 ? pn : pn - 6) * 256; const float qs = pn < 6 ? QSCALE : 1.0f;
            float inv[4];
#pragma unroll
            for (int i = 0; i < 4; ++i) inv[i] = invf[(cl >> 1) + i];
#pragma unroll
            for (int ai = 0; ai < 2; ++ai)
#pragma unroll
                for (int m = 0; m < 4; ++m) {
                    const int row = row0 + ai * 128 + m * 16;
                    float cs[4], sn[4];
#pragma unroll
                    for (int i = 0; i < 4; ++i) { const float ang = (float)row * inv[i]; double rev = (double)ang * 0.15915494309189533577; rev -= rint(rev);
                        sn[i] = __builtin_amdgcn_sinf((float)rev) * qs; cs[i] = __builtin_amdgcn_cosf((float)rev) * qs; }
#pragma unroll
                    for (int bj = 0; bj < 2; ++bj) {
                        const f32x4 v0 = acc[ai][bj][m][0], v1 = acc[ai][bj][m][1]; f32x4 o0, o1;
                        o0[0] = v0[0] * cs[0] - v0[1] * sn[0]; o0[1] = v0[1] * cs[0] + v0[0] * sn[0]; o0[2] = v0[2] * cs[1] - v0[3] * sn[1]; o0[3] = v0[3] * cs[1] + v0[2] * sn[1];
                        o1[0] = v1[0] * cs[2] - v1[1] * sn[2]; o1[1] = v1[1] * cs[2] + v1[0] * sn[2]; o1[2] = v1[2] * cs[3] - v1[3] * sn[3]; o1[3] = v1[3] * cs[3] + v1[2] * sn[3];
                        *(v4u*)(base + (size_t)row * AW + ct + bj * 128 + cl) = pack8(o0, o1);
                    }
                }
        } else if (pn < 20) {
            bf16* base = pn < 18 ? V : PIN; const int ct = (pn < 18 ? pn - 12 : pn - 18) * 256; const int ld = pn < 18 ? AW : PW;
#pragma unroll
            for (int ai = 0; ai < 2; ++ai)
#pragma unroll
                for (int m = 0; m < 4; ++m) { const int row = row0 + ai * 128 + m * 16;
#pragma unroll
                    for (int bj = 0; bj < 2; ++bj) *(v4u*)(base + (size_t)row * ld + ct + bj * 128 + cl) = pack8(acc[ai][bj][m][0], acc[ai][bj][m][1]); }
        } else {
            bf16* base = pn < 28 ? GA : GB; const int ct = (pn < 28 ? pn - 20 : pn - 28) * 256;
#pragma unroll
            for (int ai = 0; ai < 2; ++ai)
#pragma unroll
                for (int m = 0; m < 4; ++m) { const int row = row0 + ai * 128 + m * 16;
#pragma unroll
                    for (int bj = 0; bj < 2; ++bj) { f32x4 a = acc[ai][bj][m][0], b = acc[ai][bj][m][1];
#pragma unroll
                        for (int e = 0; e < 4; ++e) { a[e] = __builtin_amdgcn_rcpf(1.0f + __expf(-a[e])); b[e] = __builtin_amdgcn_rcpf(1.0f + __expf(-b[e])); }
                        *(v4u*)(base + (size_t)row * D + ct + bj * 128 + cl) = pack8(a, b); } }
        }
    }
};
struct EpiGates8n {
    static constexpr bool PERM = true;
    bf16 *GA, *GB, *V, *PIN;
    __device__ __forceinline__ void operator()(const f32x4 (&acc)[2][2][4][2], const Unit& u, int wr, int wc, int fr, int fq) const {
        const int pn = u.pn, row0 = u.pm * 256 + wr * 64 + fr, cl = wc * 32 + 8 * fq;
        if (pn < 16) {
            bf16* base = pn < 12 ? V : PIN; const int ct = (pn < 12 ? pn : pn - 12) * 128, ld = pn < 12 ? AW : PW;
#pragma unroll
            for (int ai = 0; ai < 2; ++ai)
#pragma unroll
                for (int m = 0; m < 4; ++m) { const int row = row0 + ai * 128 + m * 16;
                    *(v4u*)(base + (size_t)row * ld + ct + cl) = pack8(acc[ai][0][m][0] * 0.015625f, acc[ai][0][m][1] * 0.015625f); }
            return;
        }
        bf16* base = pn < 32 ? GA : GB; const int ct = (pn & 15) * 128;
#pragma unroll
        for (int ai = 0; ai < 2; ++ai)
#pragma unroll
            for (int m = 0; m < 4; ++m) { const int row = row0 + ai * 128 + m * 16; f32x4 a = acc[ai][0][m][0], b = acc[ai][0][m][1];
#pragma unroll
                for (int e = 0; e < 4; ++e) { a[e] = __builtin_amdgcn_rcpf(1.0f + __expf(-0.015625f * a[e])); b[e] = __builtin_amdgcn_rcpf(1.0f + __expf(-0.015625f * b[e])); }
                unsigned w0 = 0u, w1 = 0u;
                w0 = __builtin_amdgcn_cvt_pk_u8_f32(255.0f * a[0], 0, w0); w0 = __builtin_amdgcn_cvt_pk_u8_f32(255.0f * a[1], 1, w0); w0 = __builtin_amdgcn_cvt_pk_u8_f32(255.0f * a[2], 2, w0); w0 = __builtin_amdgcn_cvt_pk_u8_f32(255.0f * a[3], 3, w0);
                w1 = __builtin_amdgcn_cvt_pk_u8_f32(255.0f * b[0], 0, w1); w1 = __builtin_amdgcn_cvt_pk_u8_f32(255.0f * b[1], 1, w1); w1 = __builtin_amdgcn_cvt_pk_u8_f32(255.0f * b[2], 2, w1); w1 = __builtin_amdgcn_cvt_pk_u8_f32(255.0f * b[3], 3, w1);
                *(v2u*)((unsigned char*)base + (size_t)row * D + ct + cl) = (v2u){w0, w1}; }
    }
};
struct EpiBf16 {
    static constexpr bool PERM = true;
    bf16* O; int ld; const float* colscale;
    __device__ __forceinline__ void operator()(const f32x4 (&acc)[2][2][4][2], const Unit& u, int wr, int wc, int fr, int fq) const {
        const int row0 = u.pm * 256 + wr * 64 + fr, col0 = u.pn * 256 + wc * 32 + 8 * fq;
        f32x4 s[2][2];
#pragma unroll
        for (int bj = 0; bj < 2; ++bj)
#pragma unroll
            for (int n = 0; n < 2; ++n) s[bj][n] = colscale ? *(const f32x4*)(colscale + col0 + bj * 128 + 4 * n) : (f32x4){1.f, 1.f, 1.f, 1.f};
#pragma unroll
        for (int ai = 0; ai < 2; ++ai)
#pragma unroll
            for (int m = 0; m < 4; ++m) { const int row = row0 + ai * 128 + m * 16;
#pragma unroll
                for (int bj = 0; bj < 2; ++bj) *(v4u*)(O + (size_t)row * ld + col0 + bj * 128) = pack8(acc[ai][bj][m][0] * s[bj][0], acc[ai][bj][m][1] * s[bj][1]); }
    }
};
struct EpiGate {
    static constexpr bool PERM = true;
    bf16* O; const bf16* G; int accum;
    __device__ __forceinline__ void operator()(const f32x4 (&acc)[2][2][4][2], const Unit& u, int wr, int wc, int fr, int fq) const {
        const int row0 = u.pm * 256 + wr * 64 + fr, col0 = u.pn * 256 + wc * 32 + 8 * fq;
#pragma unroll
        for (int ai = 0; ai < 2; ++ai) {
            v2u gv[4][2]; v4u pv[4][2];
#pragma unroll
            for (int m = 0; m < 4; ++m)
#pragma unroll
                for (int bj = 0; bj < 2; ++bj) { const size_t off = (size_t)(row0 + ai * 128 + m * 16) * D + col0 + bj * 128;
                    gv[m][bj] = *(const v2u*)((const unsigned char*)G + off); pv[m][bj] = accum ? *(const v4u*)(O + off) : (v4u){0u, 0u, 0u, 0u}; }
#pragma unroll
            for (int m = 0; m < 4; ++m)
#pragma unroll
                for (int bj = 0; bj < 2; ++bj) { const size_t off = (size_t)(row0 + ai * 128 + m * 16) * D + col0 + bj * 128;
                    const v2u g = gv[m][bj]; const v4u p = pv[m][bj]; f32x4 a = acc[ai][bj][m][0], b = acc[ai][bj][m][1]; const float q8 = 1.0f / 255.0f;
                    a[0] = a[0] * (q8 * (float)((g.x >> 0) & 0xffu)) + bflo(p.x); a[1] = a[1] * (q8 * (float)((g.x >> 8) & 0xffu)) + bfhi(p.x); a[2] = a[2] * (q8 * (float)((g.x >> 16) & 0xffu)) + bflo(p.y); a[3] = a[3] * (q8 * (float)((g.x >> 24) & 0xffu)) + bfhi(p.y);
                    b[0] = b[0] * (q8 * (float)((g.y >> 0) & 0xffu)) + bflo(p.z); b[1] = b[1] * (q8 * (float)((g.y >> 8) & 0xffu)) + bfhi(p.z); b[2] = b[2] * (q8 * (float)((g.y >> 16) & 0xffu)) + bflo(p.w); b[3] = b[3] * (q8 * (float)((g.y >> 24) & 0xffu)) + bfhi(p.w);
                    *(v4u*)(O + off) = pack8(a, b); }
        }
    }
};
struct EpiResid {
    static constexpr bool PERM = false;
    float* H; const float* x; const float* gate;
    __device__ __forceinline__ void operator()(const f32x4 (&acc)[2][2][4][2], const Unit& u, int wr, int wc, int fr, int fq) const {
        const int row0 = u.pm * 256 + wr * 64 + fr, col0 = u.pn * 256 + wc * 32 + 4 * fq;
#pragma unroll
        for (int ai = 0; ai < 2; ++ai)
#pragma unroll
            for (int m = 0; m < 4; ++m) { const int row = row0 + ai * 128 + m * 16;
#pragma unroll
                for (int bj = 0; bj < 2; ++bj)
#pragma unroll
                    for (int n = 0; n < 2; ++n) { const int col = col0 + bj * 128 + n * 16; const size_t off = (size_t)row * D + col;
                        const f32x4 g = *(const f32x4*)(gate + col), xx = *(const f32x4*)(x + off); *(f32x4*)(H + off) = xx + g * acc[ai][bj][m][n]; } }
    }
};
struct EpiResid2 {
    static constexpr bool PERM = false;
    bf16* H; const float* x; const float* gate; bf16* A2; const float* g2s; float* SSP;
    __device__ __forceinline__ void operator()(const f32x4 (&acc)[2][2][4][2], const Unit& u, int wr, int wc, int fr, int fq) const {
        const int row0 = u.pm * 256 + wr * 64 + fr, col0 = u.pn * 256 + wc * 32 + 4 * fq;
        f32x4 gc[2][2], g2c[2][2];
#pragma unroll
        for (int bj = 0; bj < 2; ++bj)
#pragma unroll
            for (int n = 0; n < 2; ++n) { const int col = col0 + bj * 128 + n * 16; gc[bj][n] = *(const f32x4*)(gate + col); g2c[bj][n] = *(const f32x4*)(g2s + col); }
        f32x4 xa[2][2], xb[2][2];
#define ER2_LOAD(XV, G) do { _Pragma("unroll") for (int bj = 0; bj < 2; ++bj) _Pragma("unroll") for (int n = 0; n < 2; ++n) \
            XV[bj][n] = *(const f32x4*)(x + (size_t)(row0 + ((G) >> 2) * 128 + ((G) & 3) * 16) * D + col0 + bj * 128 + n * 16); } while (0)
#define ER2_PROC(XV, G) do { const int ai = (G) >> 2, m = (G) & 3, row = row0 + ai * 128 + m * 16; float ss = 0.f; \
            _Pragma("unroll") for (int bj = 0; bj < 2; ++bj) _Pragma("unroll") for (int n = 0; n < 2; ++n) { const size_t off = (size_t)row * D + col0 + bj * 128 + n * 16; \
                const f32x4 h = XV[bj][n] + gc[bj][n] * acc[ai][bj][m][n]; { v2u hw; hw.x = pk2(h.x, h.y); hw.y = pk2(h.z, h.w); *(v2u*)(H + off) = hw; } \
                ss += (h.x * h.x + h.y * h.y) + (h.z * h.z + h.w * h.w); \
                const f32x4 gg = g2c[bj][n]; \
                v2u w; w.x = pk2(h.x * gg.x, h.y * gg.y); w.y = pk2(h.z * gg.z, h.w * gg.w); *(v2u*)(A2 + off) = w; } \
            ss += __shfl_xor(ss, 16); ss += __shfl_xor(ss, 32); \
            if (fq == 0) SSP[(size_t)row * 32 + u.pn * 4 + wc] = ss; } while (0)
        ER2_LOAD(xa, 0);
        ER2_LOAD(xb, 1); ER2_PROC(xa, 0);
        ER2_LOAD(xa, 2); ER2_PROC(xb, 1);
        ER2_LOAD(xb, 3); ER2_PROC(xa, 2);
        ER2_LOAD(xa, 4); ER2_PROC(xb, 3);
        ER2_LOAD(xb, 5); ER2_PROC(xa, 4);
        ER2_LOAD(xa, 6); ER2_PROC(xb, 5);
        ER2_LOAD(xb, 7); ER2_PROC(xa, 6);
        ER2_PROC(xb, 7);
#undef ER2_LOAD
#undef ER2_PROC
    }
};
struct EpiScores {
    static constexpr bool PERM = false;
    unsigned char* O; const float* cvec; const LAS float* rrl; int pm0;
    __device__ __forceinline__ void operator()(const f32x4 (&acc)[2][2][4][2], const Unit& u, int wr, int wc, int fr, int fq) const {
        const int rl0 = wr * 64 + fr, col0 = u.pn * 256 + wc * 32 + 4 * fq; const LAS float* rp = rrl + (u.pm == pm0 ? 0 : 256);
        f32x4 cv[2][2]; float rv[2][4];
#pragma unroll
        for (int bj = 0; bj < 2; ++bj)
#pragma unroll
            for (int n = 0; n < 2; ++n) cv[bj][n] = *(const f32x4*)(cvec + col0 + bj * 128 + n * 16);
#pragma unroll
        for (int ai = 0; ai < 2; ++ai)
#pragma unroll
            for (int m = 0; m < 4; ++m) rv[ai][m] = rp[rl0 + ai * 128 + m * 16];
#pragma unroll
        for (int ai = 0; ai < 2; ++ai)
#pragma unroll
            for (int m = 0; m < 4; ++m) { const int row = u.pm * 256 + rl0 + ai * 128 + m * 16;
#pragma unroll
                for (int bj = 0; bj < 2; ++bj)
#pragma unroll
                    for (int n = 0; n < 2; ++n) { const f32x4 r = acc[ai][bj][m][n] * rv[ai][m] + cv[bj][n]; v2u w; w.x = pkh2(r.x, r.y); w.y = pkh2(r.z, r.w);
                        *(v2u*)(O + (((size_t)(u.pn * 256 + (row >> 6)) * 32 + (wc * 4 + (fq >> 1) + bj * 16 + n * 2)) * 64 + (row & 63)) * 16 + (fq & 1) * 8) = w; } }
    }
};
struct EpiF32 {
    static constexpr bool PERM = false;
    float* O; int ld;
    __device__ __forceinline__ void operator()(const f32x4 (&acc)[2][2][4][2], const Unit& u, int wr, int wc, int fr, int fq) const {
        const int row0 = u.pm * 256 + wr * 64 + fr, col0 = u.pn * 256 + wc * 32 + 4 * fq;
#pragma unroll
        for (int ai = 0; ai < 2; ++ai)
#pragma unroll
            for (int m = 0; m < 4; ++m) { const int row = row0 + ai * 128 + m * 16;
#pragma unroll
                for (int bj = 0; bj < 2; ++bj)
#pragma unroll
                    for (int n = 0; n < 2; ++n) *(f32x4*)(O + (size_t)row * ld + col0 + bj * 128 + n * 16) = acc[ai][bj][m][n]; }
    }
};

__device__ __forceinline__ void p0_transpose_item(const float* W, int K, int N, bf16* WT, bool ropeperm, LAS float* scr, int item, int lane, unsigned char* W8 = nullptr) {
    const int nblk = N / 32, kb = item / nblk, nb = item % nblk, k0 = 64 * kb, n0 = 32 * nb;
    {
        f32x4 tv[8];
#pragma unroll
        for (int i = 0; i < 8; ++i) tv[i] = *(const f32x4*)(W + (size_t)(k0 + 8 * i + (lane >> 3)) * N + n0 + 4 * (lane & 7));
#pragma unroll
        for (int i = 0; i < 8; ++i) { LAS float* d = scr + (8 * i + (lane >> 3)) * 33 + 4 * (lane & 7); d[0] = tv[i].x; d[1] = tv[i].y; d[2] = tv[i].z; d[3] = tv[i].w; }
    }
    LDS_WAIT(); asm volatile("" ::: "memory");
    const int c = lane & 7;
#pragma unroll
    for (int j = 0; j < 4; ++j) { const int n = (lane >> 3) + 8 * j; const LAS float* s = scr + (8 * c) * 33 + n;
        v4u o; o.x = pk2(s[0 * 33], s[1 * 33]); o.y = pk2(s[2 * 33], s[3 * 33]); o.z = pk2(s[4 * 33], s[5 * 33]); o.w = pk2(s[6 * 33], s[7 * 33]);
        int rown = n0 + n; if (ropeperm && rown < 2 * AW) { const int d = rown & 127; rown = (rown & ~127) + 2 * (d & 63) + (d >> 6); }
        if (W8 != nullptr && rown >= 3072) {
            int lo = __builtin_amdgcn_cvt_pk_fp8_f32(64.f * s[0 * 33], 64.f * s[1 * 33], 0, false); lo = __builtin_amdgcn_cvt_pk_fp8_f32(64.f * s[2 * 33], 64.f * s[3 * 33], lo, true);
            int hi = __builtin_amdgcn_cvt_pk_fp8_f32(64.f * s[4 * 33], 64.f * s[5 * 33], 0, false); hi = __builtin_amdgcn_cvt_pk_fp8_f32(64.f * s[6 * 33], 64.f * s[7 * 33], hi, true);
            const v2u o8 = {(unsigned)lo, (unsigned)hi}; *(v2u*)(W8 + (size_t)(rown - 3072) * K + k0 + 8 * c) = o8;
        } else *(v4u*)(WT + (size_t)rown * K + k0 + 8 * c) = o; }
    LDS_WAIT(); asm volatile("" ::: "memory");
}
__device__ __forceinline__ void rmsmod_row(const float* xrow, const float* g, const float* scale, const float* shift, bf16* orow, int lane, unsigned char* orow8 = nullptr) {
    const f32x4* xr = (const f32x4*)xrow + lane;
    f32x4 v[8]; float s = 0.f;
#pragma unroll
    for (int j = 0; j < 8; ++j) { v[j] = xr[64 * j]; s += (v[j].x * v[j].x + v[j].y * v[j].y) + (v[j].z * v[j].z + v[j].w * v[j].w); }
    const float r = 1.0f / sqrtf(wave_sum(s) * (1.f / D) + EPS);
    v2u* o = (v2u*)orow + lane;
#pragma unroll
    for (int j = 0; j < 8; ++j) { const int c0 = 4 * lane + 256 * j;
        const f32x4 gg = *(const f32x4*)(g + c0), sc = *(const f32x4*)(scale + c0), sh = *(const f32x4*)(shift + c0);
        const float y0 = v[j].x * r * gg.x * (1.f + sc.x) + sh.x, y1 = v[j].y * r * gg.y * (1.f + sc.y) + sh.y, y2 = v[j].z * r * gg.z * (1.f + sc.z) + sh.z, y3 = v[j].w * r * gg.w * (1.f + sc.w) + sh.w;
        v2u w; w.x = pk2(y0, y1); w.y = pk2(y2, y3);
        o[64 * j] = w;
        if (orow8 != nullptr) { int q = __builtin_amdgcn_cvt_pk_fp8_f32(y0, y1, 0, false); q = __builtin_amdgcn_cvt_pk_fp8_f32(y2, y3, q, true); *(unsigned*)(orow8 + c0) = (unsigned)q; } }
}

constexpr int KV_STRIDE = 288;
constexpr int KV_TILE = 256 * KV_STRIDE;
typedef short v4i16_t __attribute__((ext_vector_type(4)));
__device__ __forceinline__ s16x4 vtr(LAS const unsigned char* p) { return __builtin_bit_cast(s16x4, __builtin_amdgcn_ds_read_tr16_b64_v4i16((LAS v4i16_t*)p)); }

struct AttnStage { v4u kreg[8], vreg[8]; bf16x8 qf[4]; };
__device__ __forceinline__ void attn_load(AttnStage& st_, int unit, const bf16* Q, const bf16* K, const bf16* V) {
    const int tid = threadIdx.x, lane = tid & 63, w = __builtin_amdgcn_readfirstlane(tid >> 6), fr = lane & 15, fq = lane >> 4;
    const int g = unit >> 9, rem = unit & 511, j = rem & 3, blk = rem >> 2;
    const int dsh = 2 * g, dil = 1 << dsh;
    const int r = blk & (dil - 1), n = blk >> dsh, head = 4 * g + j;
#pragma unroll
    for (int i = 0; i < 8; ++i) { const int idx = tid + 512 * i, kr = idx >> 4, ch = idx & 15; const int l = 128 * n - 128 + kr, lc = l < 0 ? 0 : l;
        const size_t off = (size_t)((lc << dsh) + r) * AW + head * HD + ch * 8; st_.kreg[i] = *(const v4u*)(K + off); st_.vreg[i] = *(const v4u*)(V + off); }
    const int qpos = ((128 * n + 16 * w + fr) << dsh) + r;
#pragma unroll
    for (int ks = 0; ks < 4; ++ks) st_.qf[ks] = *(const bf16x8*)(Q + (size_t)qpos * AW + head * HD + 32 * ks + 8 * fq);
}
__device__ __forceinline__ void attn_unit(LAS unsigned char* lds, int unit, int next_unit, AttnStage& sg, const bf16* Q, const bf16* K, const bf16* V, bf16* OG, float* LSE) {
    const int tid = threadIdx.x, lane = tid & 63, w = __builtin_amdgcn_readfirstlane(tid >> 6), fr = lane & 15, fq = lane >> 4;
    const int g = unit >> 9, rem = unit & 511, j = rem & 3, blk = rem >> 2;
    const int dsh = 2 * g, dil = 1 << dsh;
    const int r = blk & (dil - 1), n = blk >> dsh, head = 4 * g + j;
    LAS unsigned char* Kl = lds; LAS unsigned char* Vl = lds + KV_TILE;
#pragma unroll
    for (int i = 0; i < 8; ++i) { const int idx = tid + 512 * i, kr = idx >> 4, ch = idx & 15; const bool ok = (128 * n - 128 + kr) >= 0; const v4u z = {0u, 0u, 0u, 0u};
        *(LAS v4u*)(Kl + kr * KV_STRIDE + ch * 16) = ok ? sg.kreg[i] : z; *(LAS v4u*)(Vl + kr * KV_STRIDE + ch * 16) = ok ? sg.vreg[i] : z; }
    const int qpos = ((128 * n + 16 * w + fr) << dsh) + r;
    bf16x8 qf[4];
#pragma unroll
    for (int ks = 0; ks < 4; ++ks) qf[ks] = sg.qf[ks];
    __syncthreads();
    if (next_unit >= 0) attn_load(sg, next_unit, Q, K, V);
    f32x4 st[9];
#pragma unroll
    for (int b = 0; b < 9; ++b) st[b] = (f32x4){0.f, 0.f, 0.f, 0.f};
#pragma unroll
    for (int ks = 0; ks < 4; ++ks) {
        bf16x8 kf[9];
#pragma unroll
        for (int b = 0; b < 9; ++b) kf[b] = *(LAS const bf16x8*)(Kl + (16 * (w + b) + fr) * KV_STRIDE + 64 * ks + 16 * fq);
#pragma unroll
        for (int b = 0; b < 9; ++b) st[b] = __builtin_amdgcn_mfma_f32_16x16x32_bf16(kf[b], qf[ks], st[b], 0, 0, 0);
    }
    float mx = -INFINITY;
#pragma unroll
    for (int b = 0; b < 9; ++b)
#pragma unroll
        for (int e = 0; e < 4; ++e) { const int kk = 16 * b + 4 * fq + e;
            const bool ok = (kk >= fr) && (kk <= fr + 128) && (n > 0 || 16 * w + kk >= 128);
            st[b][e] = ok ? st[b][e] : -INFINITY; mx = fmaxf(mx, st[b][e]); }
    mx = fmaxf(mx, __shfl_xor(mx, 16)); mx = fmaxf(mx, __shfl_xor(mx, 32));
    float sm = 0.f;
#pragma unroll
    for (int b = 0; b < 9; ++b)
#pragma unroll
        for (int e = 0; e < 4; ++e) { const float p = __builtin_amdgcn_exp2f(st[b][e] - mx); st[b][e] = p; sm += p; }
    sm += __shfl_xor(sm, 16); sm += __shfl_xor(sm, 32);
    f32x4 o[8];
#pragma unroll
    for (int dt = 0; dt < 8; ++dt) o[dt] = (f32x4){0.f, 0.f, 0.f, 0.f};
    const int q4 = fr >> 2, p4 = fr & 3;
#pragma unroll
    for (int s = 0; s < 5; ++s) {
        bf16x8 pf; { const unsigned a = pk2(st[2 * s][0], st[2 * s][1]), b = pk2(st[2 * s][2], st[2 * s][3]);
            unsigned c = 0u, d = 0u; if (s < 4) { c = pk2(st[2 * s + 1][0], st[2 * s + 1][1]); d = pk2(st[2 * s + 1][2], st[2 * s + 1][3]); }
            const v4u t = {a, b, c, d}; pf = __builtin_bit_cast(bf16x8, t); }
        LAS const unsigned char* v0 = Vl + (16 * (w + 2 * s) + 4 * fq + q4) * KV_STRIDE + 8 * p4;
        s16x4 lo[8], hi[8];
#pragma unroll
        for (int dt = 0; dt < 8; ++dt) { lo[dt] = vtr(v0 + 32 * dt); hi[dt] = (s16x4){0, 0, 0, 0}; if (s < 4) hi[dt] = vtr(v0 + 16 * KV_STRIDE + 32 * dt); }
#pragma unroll
        for (int dt = 0; dt < 8; ++dt) {
            const bf16x8 vf = {lo[dt][0], lo[dt][1], lo[dt][2], lo[dt][3], hi[dt][0], hi[dt][1], hi[dt][2], hi[dt][3]};
            o[dt] = __builtin_amdgcn_mfma_f32_16x16x32_bf16(vf, pf, o[dt], 0, 0, 0);
        }
    }
    const float inv = 1.0f / sm;
    bf16* orow = OG + ((size_t)g * S + qpos) * AOW + j * HD + 4 * fq;
#pragma unroll
    for (int dt = 0; dt < 8; ++dt) { v2u wv; wv.x = pk2(o[dt][0] * inv, o[dt][1] * inv); wv.y = pk2(o[dt][2] * inv, o[dt][3] * inv); *(v2u*)(orow + 16 * dt) = wv; }
    if (fq == 0) LSE[((size_t)g * S + qpos) * 4 + j] = mx * 0.6931471805599453f + __logf(sm);
    __syncthreads();
}

__device__ __forceinline__ unsigned okey(float f) { const unsigned u = __float_as_uint(f); return u ^ ((unsigned)((int)u >> 31) | 0x80000000u); }
__device__ __forceinline__ float okey_inv(unsigned k) { return __uint_as_float((k & 0x80000000u) ? (k ^ 0x80000000u) : ~k); }
__device__ __forceinline__ unsigned umed3(unsigned a, unsigned b, unsigned c) { unsigned r; asm("v_med3_u32 %0, %1, %2, %3" : "=v"(r) : "v"(a), "v"(b), "v"(c)); return r; }
__device__ __forceinline__ void ins16k(unsigned (&tk)[16], unsigned key) {
#pragma unroll
    for (int s = 15; s >= 1; --s) tk[s] = umed3(key, tk[s], tk[s - 1]);
    tk[0] = key > tk[0] ? key : tk[0];
}
__device__ __forceinline__ unsigned okeyb(unsigned x) { return x ^ ((unsigned)((int)x >> 31) | 0x80000000u); }
__device__ __forceinline__ float okeyh_inv(unsigned k) { const unsigned u = (k & 0x80000000u) ? (k ^ 0x80000000u) : ~k; return (float)__builtin_bit_cast(_Float16, (unsigned short)(u >> 16)); }
__device__ __forceinline__ void route8(const unsigned char* SC, int job, int lane, int* eidG, float* gtG, float* dsG, const float* DSC, const float* USC, LAS int* lk) {
    const int h = job & 7, tblk = job >> 3; const unsigned char* p = SC + ((size_t)(h * 256 + tblk) * 2048 + lane) * 16;
    unsigned k0[16], k1[16], kk[16];
#pragma unroll
    for (int s = 0; s < 16; ++s) { kk[s] = 0u; k0[s] = 0u; }
    v4u b0[4], b1[4], b2[4], b3[4];
#pragma unroll
    for (int i = 0; i < 4; ++i) { b0[i] = *(const v4u*)(p + 1024 * i); b1[i] = *(const v4u*)(p + 1024 * (4 + i)); b2[i] = *(const v4u*)(p + 1024 * (8 + i)); }
#define RT_STAGE(ld, off, pr, nb) { _Pragma("unroll") for (int i = 0; i < 4; ++i) ld[i] = *(const v4u*)(p + 1024 * ((off) + i)); \
        _Pragma("unroll") for (int i = 0; i < 4; ++i) _Pragma("unroll") for (int d = 0; d < 4; ++d) { const unsigned w = pr[i][d]; \
            ins16k(kk, (okeyb(w << 16) & ~0x7fu) | (unsigned)(127 - (nb) - 8 * i - 2 * d)); ins16k(kk, (okeyb(w & 0xffff0000u) & ~0x7fu) | (unsigned)(126 - (nb) - 8 * i - 2 * d)); } }
#pragma unroll 1
    for (int tr = 0; tr < 2; ++tr) {
        RT_STAGE(b3, 12, b0, 0)
        RT_STAGE(b0, 16, b1, 32)
        RT_STAGE(b1, 20, b2, 64)
        RT_STAGE(b2, 24, b3, 96)
        p += 16 * 1024;
        if (tr == 0) {
#pragma unroll
            for (int s = 0; s < 16; ++s) { k0[s] = kk[s]; kk[s] = 0u; } }
    }
#undef RT_STAGE
#pragma unroll
    for (int s = 0; s < 16; ++s) k1[s] = kk[s];
    float a0[16], a1[16];
#pragma unroll
    for (int s = 0; s < 16; ++s) { const int n0 = 127 - (int)(k0[s] & 0x7fu), n1 = 127 - (int)(k1[s] & 0x7fu); lk[s * 64 + lane] = n0; lk[1024 + s * 64 + lane] = n1; a0[s] = okeyh_inv(k0[s]); a1[s] = okeyh_inv(k1[s]); }
    unsigned ck[16];
#pragma unroll
    for (int s = 0; s < 16; ++s) ck[s] = 0u;
#pragma unroll
    for (int i = 0; i < 16; ++i)
#pragma unroll
        for (int j = 0; j < 16; ++j) if ((i + 1) * (j + 1) <= 16) ins16k(ck, (okey(a0[i] + a1[j]) & ~0xffu) | (unsigned)(255 - (i * 16 + j)));
    float cs[16]; float mx = -INFINITY;
#pragma unroll
    for (int s = 0; s < 16; ++s) { cs[s] = okey_inv((ck[s] & ~0xffu) | 0x80u); mx = fmaxf(mx, cs[s]); }
    float sum = 0.f;
#pragma unroll
    for (int s = 0; s < 16; ++s) { cs[s] = __expf(cs[s] - mx); sum += cs[s]; }
    const float rs = 1.0f / sum;
    int exv[16]; float usv[16], dsv[16];
#pragma unroll
    for (int s = 0; s < 16; ++s) { const int flat = 255 - (int)(ck[s] & 0xffu); const int i1 = lk[(flat >> 4) * 64 + lane], i2 = lk[1024 + (flat & 15) * 64 + lane]; exv[s] = i1 * NKEY + i2; }
#pragma unroll
    for (int s = 0; s < 16; ++s) { usv[s] = USC[exv[s]]; dsv[s] = DSC[exv[s]]; }
    const size_t oi0 = (size_t)(tblk * 64 + lane) * 128 + h * 16;
#pragma unroll
    for (int q = 0; q < 4; ++q) {
        *(v4u*)(eidG + oi0 + 4 * q) = (v4u){(unsigned)exv[4 * q], (unsigned)exv[4 * q + 1], (unsigned)exv[4 * q + 2], (unsigned)exv[4 * q + 3]};
        *(f32x4*)(gtG + oi0 + 4 * q) = (f32x4){cs[4 * q] * rs * usv[4 * q], cs[4 * q + 1] * rs * usv[4 * q + 1], cs[4 * q + 2] * rs * usv[4 * q + 2], cs[4 * q + 3] * rs * usv[4 * q + 3]};
        *(f32x4*)(dsG + oi0 + 4 * q) = (f32x4){dsv[4 * q], dsv[4 * q + 1], dsv[4 * q + 2], dsv[4 * q + 3]}; }
}
constexpr int QB = 6, NDW = 6;
constexpr float QMAXV = 7.5f;
constexpr int PIECE_B = 24, SLICE_ROW_B = 8 * PIECE_B;
constexpr size_t SLICE_B = (size_t)16384 * SLICE_ROW_B;
typedef unsigned u32x6 __attribute__((ext_vector_type(6)));
typedef float f32x32 __attribute__((ext_vector_type(32)));
struct QRow { v4u a; v2u b; };
__device__ __forceinline__ QRow qrow_load(const unsigned char* p, int j) { QRow r; r.a = *(const v4u*)(p + 16 * j); r.b = *(const v2u*)(p + 128 + 8 * j); return r; }
__device__ __forceinline__ f32x32 qrow_dec(const QRow& r) { const u32x6 v = {r.a.x, r.a.y, r.a.z, r.a.w, r.b.x, r.b.y}; return __builtin_amdgcn_cvt_scalef32_pk32_f32_fp6(v, 1.0f); }
typedef float f32x2p __attribute__((ext_vector_type(2)));
__device__ __forceinline__ float qdot(QRow r, const f32x2p (&x)[16], float dep) {
#if KN_CHAIN10
    r.a.x += (unsigned)(int)(dep * 0.0f);
#endif
    const f32x32 v = qrow_dec(r);
#if KN_PK10
    f32x2p s0 = {0.f, 0.f}, s1 = {0.f, 0.f};
#pragma unroll
    for (int i = 0; i < 16; i += 2) { const f32x2p v0 = {v[2 * i], v[2 * i + 1]}, v1 = {v[2 * i + 2], v[2 * i + 3]}; s0 = __builtin_elementwise_fma(v0, x[i], s0); s1 = __builtin_elementwise_fma(v1, x[i + 1], s1); }
    const f32x2p t = s0 + s1; return t.x + t.y;
#else
    float s0 = 0.f, s1 = 0.f, s2 = 0.f, s3 = 0.f;
#pragma unroll
    for (int i = 0; i < 16; i += 2) { s0 += v[2 * i] * x[i].x; s1 += v[2 * i + 1] * x[i].y; s2 += v[2 * i + 2] * x[i + 1].x; s3 += v[2 * i + 3] * x[i + 1].y; }
    return (s0 + s1) + (s2 + s3);
#endif
}
__device__ __forceinline__ void qaxpy(f32x2p (&a)[16], QRow r, float c) {
#if KN_CHAIN11
    r.a.x += (unsigned)(int)(a[15].y * 0.0f);
#endif
    const f32x32 v = qrow_dec(r);
#if KN_PK11
    const f32x2p c2 = {c, c};
#pragma unroll
    for (int i = 0; i < 16; ++i) { const f32x2p vi = {v[2 * i], v[2 * i + 1]}; a[i] = __builtin_elementwise_fma(c2, vi, a[i]); }
#else
#pragma unroll
    for (int i = 0; i < 16; ++i) { a[i].x += c * v[2 * i]; a[i].y += c * v[2 * i + 1]; }
#endif
}
__device__ __forceinline__ float reduce8(const float (&d)[8], int lane) {
    const bool h5 = (lane & 32) != 0, h4 = (lane & 16) != 0, h3 = (lane & 8) != 0;
    float e[4], f[2];
#pragma unroll
    for (int i = 0; i < 4; ++i) { const float keep = h5 ? d[i + 4] : d[i], send = h5 ? d[i] : d[i + 4]; e[i] = keep + __shfl_xor(send, 32); }
#pragma unroll
    for (int i = 0; i < 2; ++i) { const float keep = h4 ? e[i + 2] : e[i], send = h4 ? e[i] : e[i + 2]; f[i] = keep + __shfl_xor(send, 16); }
    float g = (h3 ? f[1] : f[0]) + __shfl_xor(h3 ? f[0] : f[1], 8);
    g += __shfl_xor(g, 4); g += __shfl_xor(g, 2); g += __shfl_xor(g, 1);
    return g;
}
__device__ __forceinline__ float reduce8j(const float (&d)[8], int lane) {
    const bool b2 = (lane & 4) != 0, b1 = (lane & 2) != 0, b0 = (lane & 1) != 0;
    float e[4], f[2];
#pragma unroll
    for (int i = 0; i < 4; ++i) { const float keep = b2 ? d[i + 4] : d[i], send = b2 ? d[i] : d[i + 4]; e[i] = keep + __shfl_xor(send, 4); }
#pragma unroll
    for (int i = 0; i < 2; ++i) { const float keep = b1 ? e[i + 2] : e[i], send = b1 ? e[i] : e[i + 2]; f[i] = keep + __shfl_xor(send, 2); }
    return (b0 ? f[1] : f[0]) + __shfl_xor(b0 ? f[0] : f[1], 1);
}
__device__ __forceinline__ float wave_maxf(float v) {
#pragma unroll
    for (int o = 1; o < 64; o <<= 1) v = fmaxf(v, __shfl_xor(v, o));
    return v;
}
__device__ __forceinline__ unsigned fp6_code(float y) {
    const float a = fabsf(y);
    const float c = a < 2.0f ? 8.0f * a : (a < 4.0f ? 8.0f + 4.0f * a : 16.0f + 2.0f * a);
    int code = (int)rintf(c); code = code > 31 ? 31 : code;
    return (unsigned)code | (y < 0.f ? 32u : 0u);
}
template <int I> struct QPack { static __device__ __forceinline__ void put(unsigned (&w)[NDW], const float (&v)[32], float inv) {
    constexpr int bit = QB * I, dw = bit >> 5, sh = bit & 31;
    const unsigned f = fp6_code(v[I] * inv);
    w[dw] |= f << sh; if constexpr (sh + QB > 32) w[dw + 1 < NDW ? dw + 1 : dw] |= f >> (32 - sh);
    QPack<I - 1>::put(w, v, inv); } };
template <> struct QPack<-1> { static __device__ __forceinline__ void put(unsigned (&)[NDW], const float (&)[32], float) {} };
__device__ __forceinline__ void quant_row(const float* src, unsigned char* dst, float* scale_out, int lane) {
    float v[32]; float mx = 0.f;
#pragma unroll
    for (int i = 0; i < 8; ++i) { const f32x4 t = *(const f32x4*)(src + 32 * lane + 4 * i); v[4 * i] = t.x; v[4 * i + 1] = t.y; v[4 * i + 2] = t.z; v[4 * i + 3] = t.w;
        mx = fmaxf(mx, fmaxf(fmaxf(fabsf(t.x), fabsf(t.y)), fmaxf(fabsf(t.z), fabsf(t.w)))); }
    mx = wave_maxf(mx);
    const float inv = mx > 0.f ? QMAXV / mx : 0.f;
    unsigned w[NDW];
#pragma unroll
    for (int i = 0; i < NDW; ++i) w[i] = 0u;
    QPack<31>::put(w, v, inv);
    unsigned char* pd = dst + (size_t)(lane >> 3) * SLICE_B;
    const v4u a = {w[0], w[1], w[2], w[3]}; const v2u b = {w[4], w[5]}; *(v4u*)(pd + 16 * (lane & 7)) = a; *(v2u*)(pd + 128 + 8 * (lane & 7)) = b;
    if (lane == 0) *scale_out = mx * (1.0f / QMAXV);
}

__device__ __forceinline__ void fold_tile(const float* base, size_t stride, LAS float* scr, int lane, f32x4 (&outv)[16]) {
    f32x4 tv[16];
#pragma unroll
    for (int i = 0; i < 16; ++i) tv[i] = *(const f32x4*)(base + (size_t)(2 * i + (lane >> 5)) * stride + 4 * (lane & 31));
#pragma unroll
    for (int i = 0; i < 16; ++i) *(LAS f32x4*)(scr + (2 * i + (lane >> 5)) * 132 + 4 * (lane & 31)) = tv[i];
    LDS_WAIT(); asm volatile("" ::: "memory");
#pragma unroll
    for (int i = 0; i < 16; ++i) outv[i] = *(LAS const f32x4*)(scr + (lane & 31) * 132 + 64 * (lane >> 5) + 4 * i);
    LDS_WAIT(); asm volatile("" ::: "memory");
}
struct Args { const float* in[17]; float* out; float* hbuf; unsigned char* ws; int ph_lo, ph_hi, li, pad; };

__global__ void __launch_bounds__(NWAVES * 64, 2) mk_fwd(Args args) {
    extern __shared__ __attribute__((aligned(16))) unsigned char lds_raw[];
    LAS unsigned char* lds = (LAS unsigned char*)lds_raw;
    volatile LAS unsigned* MISC = (volatile LAS unsigned*)(lds + MISC_OFF);
    const int tid = threadIdx.x, lane = tid & 63, wave = __builtin_amdgcn_readfirstlane(tid >> 6);
    const int G = gridDim.x, bx = blockIdx.x;
    const int vcu = (G % 8 == 0) ? (bx % 8) * (G / 8) + bx / 8 : bx;
    const int gw = vcu * NWAVES + wave, NGW = G * NWAVES;
    unsigned char* ws = args.ws;
    const float* x = args.in[0]; const float* cvec = args.in[1]; const float* ada_w = args.in[2]; const float* ada_b = args.in[3]; const float* norm1_g = args.in[4];
    const float* w_in = args.in[5]; const float* pool_mix = args.in[6]; const float* pool_scale = args.in[7]; const float* w_ab = args.in[8]; const float* w_pb = args.in[9];
    const float* w_out = args.in[10]; const float* norm2_g = args.in[11]; const float* wq = args.in[12]; const float* keys = args.in[13]; const float* wdn = args.in[14];
    const float* wup = args.in[15]; const float* final_g = args.in[16];
    float* out = args.out;
    float* mod = (float*)(ws + WS_MOD); float* invf = (float*)(ws + WS_INVF);
    bf16* WAB = (bf16*)(ws + WS_WAB); bf16* WPB = (bf16*)(ws + WS_WPB);
    bf16* WOUT = (bf16*)(ws + WS_WOUT); bf16* WQ = (bf16*)(ws + WS_WQ); bf16* WIN = (bf16*)(ws + WS_WIN); unsigned char* DOWN = ws + WS_DOWN; unsigned char* UP = ws + WS_UP; float* DSC = (float*)(ws + WS_DSC); float* USC = (float*)(ws + WS_USC);
    bf16* XN = (bf16*)(ws + WS_XN); bf16* OG = (bf16*)(ws + WS_OG); float* LSE = (float*)(ws + WS_LSE);
    bf16* Qb = (bf16*)(ws + WS_Q); bf16* Kb = (bf16*)(ws + WS_K); bf16* Vb = (bf16*)(ws + WS_V); bf16* PIN = (bf16*)(ws + WS_PIN); bf16* GA = (bf16*)(ws + WS_GA); bf16* GB = (bf16*)(ws + WS_GB);
    bf16* DPOOL = (bf16*)(ws + WS_DPOOL); bf16* ATTN = (bf16*)(ws + WS_ATTN); bf16* MERGED = (bf16*)(ws + WS_MERGED);
    unsigned char* SC = ws + WS_SC; unsigned char* XN8 = ws + WS_XN8; unsigned char* WIN8 = ws + WS_WIN8; float* CSUM = (float*)(ws + WS_CSUM); float* CVEC = (float*)(ws + WS_CVEC); float* RR = (float*)(ws + WS_RR); float* SSP = (float*)(ws + WS_SSP); float* G2S = (float*)(ws + WS_G2S); int* EID = (int*)(ws + WS_EID); float* GATE = (float*)(ws + WS_GATE); float* UPART = (float*)(ws + WS_UPART); float* SSQ = (float*)(ws + WS_SSQ); float* DSCT = (float*)(ws + WS_DSCT);
    bf16* VB = (bf16*)(ws + WS_VB);
    bf16* H = (bf16*)(ws + WS_HB);
    const float *shift1 = mod, *scale1 = mod + D, *gate1 = mod + 2 * D, *shift2 = mod + 3 * D, *scale2 = mod + 4 * D, *gate2 = mod + 5 * D;

    for (int u = tid; u < (LDS_BYTES - LDSCTL_OFF) / 4; u += NWAVES * 64) ((LAS unsigned*)(lds + LDSCTL_OFF))[u] = 0u;
    __syncthreads();
    XcdBarrier bar; bar.bar = (unsigned*)(ws + WS_CTL) + CW_BAR; bar.x = 0; bar.st = nullptr;
    if (MK_N_LAUNCHES == 1) bar = xcd_barrier_post((unsigned*)(ws + WS_CTL) + CW_BAR, MISC + 8);
    const int lo = args.ph_lo, hi = args.ph_hi;
#define IN(k) (lo <= (k) && (k) < hi)
#define SEAM(k) do { if (IN(k) && IN((k) + 1)) xcd_barrier(bar); } while (0)

    if (IN(0)) REP(0) {
        for (int chunk = bx; chunk < 6 * D / 48; chunk += G) {
            LAS float* red = (LAS float*)lds;
            const int cq = tid % 12, rg = tid / 12;
            if (rg < 32) {
                f32x4 a = {0.f, 0.f, 0.f, 0.f};
                const float* wp = ada_w + (size_t)(rg * 64) * (6 * D) + chunk * 48 + 4 * cq;
#pragma unroll 8
                for (int i = 0; i < 64; ++i) { const float ci = cvec[rg * 64 + i]; const float sl = ci / (1.0f + __expf(-ci)); a = a + *(const f32x4*)(wp + (size_t)i * (6 * D)) * sl; }
                *(LAS f32x4*)(red + rg * 48 + 4 * cq) = a;
            }
            __syncthreads();
            if (tid < 48) { float s = 0.f;
#pragma unroll 8
                for (int i = 0; i < 32; ++i) s += red[i * 48 + tid];
                mod[chunk * 48 + tid] = s + ada_b[chunk * 48 + tid]; }
            __syncthreads();
        }
        if (gw == 0) invf[lane] = (float)pow(10000.0, -(double)lane / 64.0);
        LAS float* scr = (LAS float*)(lds + wave * 16896);
        constexpr int I_IN = (D / 64) * (INW / 32), I_B = (AOW / 64) * (D / 32), I_O = (D / 64) * (D / 32);
        constexpr int NT_ITEMS = I_IN + I_B + I_O;
        for (int it = gw; it < NT_ITEMS; it += NGW) {
            int r = it;
            if (r < I_IN) { p0_transpose_item(w_in, D, INW, WIN, true, scr, r, lane, WIN8); continue; } r -= I_IN;
            if (r < I_B) { p0_transpose_item(w_ab, AOW, D, WAB, false, scr, r, lane); continue; } r -= I_B;
            p0_transpose_item(w_out, D, D, WOUT, false, scr, r, lane);
        }
        {
            typedef float f32x16 __attribute__((ext_vector_type(16)));
            const int li = lane & 31, hf = lane >> 5;
            for (int it = NGW - 1 - gw; it < 16 * 4 * 64; it += NGW) {
                const int hp = it >> 8, nt = (it >> 6) & 3, kt = it & 63;
                f32x4 av[16], bv[16];
                fold_tile(keys + ((size_t)(hp * 128 + nt * 32)) * 128, 128, scr, lane, av);
                fold_tile(wq + (size_t)(kt * 32) * D + hp * 128, D, scr, lane, bv);
                f32x16 c = {0.f, 0.f, 0.f, 0.f, 0.f, 0.f, 0.f, 0.f, 0.f, 0.f, 0.f, 0.f, 0.f, 0.f, 0.f, 0.f};
#pragma unroll
                for (int i = 0; i < 16; ++i)
#pragma unroll
                    for (int e = 0; e < 4; ++e) c = __builtin_amdgcn_mfma_f32_32x32x2f32(av[i][e], bv[i][e], c, 0, 0, 0);
#pragma unroll
                for (int r = 0; r < 16; ++r) { const int nn = (r & 3) + 8 * (r >> 2) + 4 * hf;
                    WQ[(size_t)(hp * 128 + nt * 32 + nn) * D + kt * 32 + li] = (bf16)(pk2(c[r], 0.f) & 0xffffu); }
            }
            for (int it = (NGW == 2048) ? 1023 - gw : gw; it >= 0 && it < 4 * 4 * 64; it += NGW) {
                const int g = it >> 8, ct = (it >> 6) & 3, ntl = it & 63;
                f32x4 av[16]; float bs[64];
                fold_tile(pool_mix + ((size_t)(g * 128 + ct * 32)) * 128, 128, scr, lane, av);
#pragma unroll
                for (int d = 0; d < 64; ++d) bs[d] = pool_scale[g * 128 + 64 * hf + d] * w_pb[(size_t)(g * 128 + 64 * hf + d) * D + ntl * 32 + li];
                f32x16 c = {0.f, 0.f, 0.f, 0.f, 0.f, 0.f, 0.f, 0.f, 0.f, 0.f, 0.f, 0.f, 0.f, 0.f, 0.f, 0.f};
#pragma unroll
                for (int i = 0; i < 16; ++i)
#pragma unroll
                    for (int e = 0; e < 4; ++e) c = __builtin_amdgcn_mfma_f32_32x32x2f32(av[i][e], bs[4 * i + e], c, 0, 0, 0);
#pragma unroll
                for (int q = 0; q < 4; ++q) { v2u o; o.x = pk2(c[4 * q], c[4 * q + 1]); o.y = pk2(c[4 * q + 2], c[4 * q + 3]);
                    *(v2u*)(WPB + (size_t)(ntl * 32 + li) * PW + g * 128 + ct * 32 + 8 * q + 4 * hf) = o; }
            }
        }
        for (int rowi = gw; rowi < 2 * 16384; rowi += NGW) { const int e = rowi & 16383;
            if (rowi < 16384) quant_row(wdn + (size_t)e * D, DOWN + (size_t)e * SLICE_ROW_B, DSC + e, lane); else quant_row(wup + (size_t)e * D, UP + (size_t)e * SLICE_ROW_B, USC + e, lane); }
    }
    SEAM(0);
    if (IN(1)) REP(1) {
        for (int m = gw; m < S; m += NGW) rmsmod_row(x + (size_t)m * D, norm1_g, scale1, shift1, XN + (size_t)m * D, lane, XN8 + (size_t)m * D);
        for (int n = gw * 64 + lane; n < D; n += NGW * 64) G2S[n] = norm2_g[n] * (1.f + scale2[n]);
        for (int n = gw; n < D; n += NGW) { float a = 0.f;
#pragma unroll
            for (int q = 0; q < 4; ++q) { const v4u p = *(const v4u*)(WQ + (size_t)n * D + 32 * lane + 8 * q); const f32x4 s0 = *(const f32x4*)(shift2 + 32 * lane + 8 * q), s1 = *(const f32x4*)(shift2 + 32 * lane + 8 * q + 4);
                a += (bflo(p.x) * s0.x + bfhi(p.x) * s0.y) + (bflo(p.y) * s0.z + bfhi(p.y) * s0.w) + (bflo(p.z) * s1.x + bfhi(p.z) * s1.y) + (bflo(p.w) * s1.z + bfhi(p.w) * s1.w); }
            a = wave_sum(a); if (lane == 0) CVEC[n] = a; }
        { float sh[32];
#pragma unroll
          for (int q = 0; q < 8; ++q) { const f32x4 t4 = *(const f32x4*)(shift2 + 32 * lane + 4 * q); sh[4 * q] = t4.x; sh[4 * q + 1] = t4.y; sh[4 * q + 2] = t4.z; sh[4 * q + 3] = t4.w; }
          for (int e0_ = gw; e0_ < 16384; e0_ += 8 * NGW) {
              QRow rr8[8];
#pragma unroll
              for (int q = 0; q < 8; ++q) { const int e = e0_ + q * NGW; rr8[q] = qrow_load(DOWN + (size_t)(lane >> 3) * SLICE_B + (size_t)(e < 16384 ? e : gw) * SLICE_ROW_B, lane & 7); }
#pragma unroll
              for (int q = 0; q < 8; ++q) { const int e = e0_ + q * NGW; const f32x32 v = qrow_dec(rr8[q]); float a = 0.f;
#pragma unroll
                  for (int i = 0; i < 32; ++i) a += v[i] * sh[i];
                  a = wave_sum(a); if (lane == 0 && e < 16384) CSUM[e] = a; }
          } }
    }
    SEAM(1);
    if (IN(2)) REP(2) {
        { pg8::Gemm g{XN, WIN, D, D, S, 3072, D, 0}; pg8::StaticOrder So; So.init(S, 3072, G, bx, 2);
          EpiInProj E{Qb, Kb, Vb, PIN, GA, GB, invf};
          pg8::gemm_phase<EpiInProj>(lds, g, So, E); }
        { pg8::Gemm g{(const bf16*)XN8, (const bf16*)WIN8, D / 2, D / 2, S, 6144, D / 2, 0}; pg8::StaticOrder So; So.init(S, 12288, G, bx, 4);
          EpiGates8n E{GA, GB, Vb, PIN};
          pg8::gemm_phase_f8n<EpiGates8n>(lds, g, So, E); }
    }
    SEAM(2);
    if (IN(3)) REP(3) {
        { AttnStage sg; if (bx < 1536) attn_load(sg, bx, Qb, Kb, Vb);
          for (int u = bx; u < 1536; u += G) attn_unit(lds, u, (u + G < 1536) ? u + G : -1, sg, Qb, Kb, Vb, OG, LSE); }
        for (int tb = 8 * gw; tb < S; tb += 8 * NGW) {
            v4u rows[23];
#pragma unroll
            for (int i = 0; i < 23; ++i) { const int tr = tb - 15 + i; rows[i] = *(const v4u*)(PIN + (size_t)(tr < 0 ? 0 : tr) * PW + 8 * lane); }
            asm volatile("" : "+v"(rows[0]), "+v"(rows[1]), "+v"(rows[2]), "+v"(rows[3]), "+v"(rows[4]), "+v"(rows[5]), "+v"(rows[6]), "+v"(rows[7]), "+v"(rows[8]), "+v"(rows[9]), "+v"(rows[10]), "+v"(rows[11]));
            asm volatile("" : "+v"(rows[12]), "+v"(rows[13]), "+v"(rows[14]), "+v"(rows[15]), "+v"(rows[16]), "+v"(rows[17]), "+v"(rows[18]), "+v"(rows[19]), "+v"(rows[20]), "+v"(rows[21]), "+v"(rows[22]));
#pragma unroll
            for (int i = 0; i < 15; ++i) { const v4u z = {0u, 0u, 0u, 0u}; rows[i] = (tb - 15 + i) < 0 ? z : rows[i]; }
            const int gsel = lane >> 4; const int wszi = 2 << gsel; const float wsz = (float)wszi;
            float sacc[8] = {0.f, 0.f, 0.f, 0.f, 0.f, 0.f, 0.f, 0.f};
#pragma unroll
            for (int i = 0; i < 16; ++i) { const bool in = i < wszi; const v4u rr = rows[15 - i];
#pragma unroll
                for (int c = 0; c < 4; ++c) { sacc[2 * c] += in ? bflo(rr[c]) : 0.f; sacc[2 * c + 1] += in ? bfhi(rr[c]) : 0.f; } }
#pragma unroll
            for (int q = 0; q < 8; ++q) {
                const int t = tb + q; const v4u cur = rows[15 + q];
                if (q > 0) { const v4u o2 = rows[13 + q], o4 = rows[11 + q], o8 = rows[7 + q], o16 = rows[q - 1 < 0 ? 0 : q - 1];
#pragma unroll
                    for (int c = 0; c < 4; ++c) { const unsigned od = gsel == 0 ? o2[c] : (gsel == 1 ? o4[c] : (gsel == 2 ? o8[c] : o16[c]));
                        sacc[2 * c] += bflo(cur[c]) - bflo(od); sacc[2 * c + 1] += bfhi(cur[c]) - bfhi(od); } }
                const float rn = 1.0f / fminf((float)(t + 1), wsz);
                v4u o;
#pragma unroll
                for (int c = 0; c < 4; ++c) o[c] = pk2(sacc[2 * c] * rn - bflo(cur[c]), sacc[2 * c + 1] * rn - bfhi(cur[c]));
                *(v4u*)(DPOOL + (size_t)t * PW + 8 * lane) = o;
            }
        }
    }
    SEAM(3);
    if (IN(4)) REP(4) {
        for (int t = gw; t < S; t += NGW) { const int j = lane >> 4;
            const float l0 = LSE[((size_t)0 * S + t) * 4 + j], l1 = LSE[((size_t)1 * S + t) * 4 + j], l2 = LSE[((size_t)2 * S + t) * 4 + j];
            const float m = fmaxf(l0, fmaxf(l1, l2)); float e0 = __expf(l0 - m), e1 = __expf(l1 - m), e2 = __expf(l2 - m); const float inv = 1.0f / (e0 + e1 + e2); e0 *= inv; e1 *= inv; e2 *= inv;
            const v4u a = *(const v4u*)(OG + ((size_t)0 * S + t) * AOW + 8 * lane), b = *(const v4u*)(OG + ((size_t)1 * S + t) * AOW + 8 * lane), c = *(const v4u*)(OG + ((size_t)2 * S + t) * AOW + 8 * lane);
            v4u o;
            o.x = pk2(e0 * bflo(a.x) + e1 * bflo(b.x) + e2 * bflo(c.x), e0 * bfhi(a.x) + e1 * bfhi(b.x) + e2 * bfhi(c.x));
            o.y = pk2(e0 * bflo(a.y) + e1 * bflo(b.y) + e2 * bflo(c.y), e0 * bfhi(a.y) + e1 * bfhi(b.y) + e2 * bfhi(c.y));
            o.z = pk2(e0 * bflo(a.z) + e1 * bflo(b.z) + e2 * bflo(c.z), e0 * bfhi(a.z) + e1 * bfhi(b.z) + e2 * bfhi(c.z));
            o.w = pk2(e0 * bflo(a.w) + e1 * bflo(b.w) + e2 * bflo(c.w), e0 * bfhi(a.w) + e1 * bfhi(b.w) + e2 * bfhi(c.w));
            *(v4u*)(ATTN + (size_t)t * AOW + 8 * lane) = o; }
    }
    SEAM(4);
    if (IN(5)) REP(5) {
        pg8::StaticOrder So; So.init(S, D, G, bx, 4);
        { pg8::Gemm g{ATTN, WAB, AOW, AOW, S, D, AOW, 0}; EpiGate E{MERGED, GA, 0}; pg8::gemm_phase<EpiGate>(lds, g, So, E); }
        { pg8::Gemm g{DPOOL, WPB, PW, PW, S, D, PW, 0}; EpiGate E{MERGED, GB, 1}; pg8::gemm_phase<EpiGate>(lds, g, So, E); }
    }
    SEAM(5);
    if (IN(6)) REP(6) {
        pg8::Gemm g{MERGED, WOUT, D, D, S, D, D, 0}; pg8::StaticOrder So; So.init(S, D, G, bx, 4);
        EpiResid2 E{H, x, gate1, XN, G2S, SSP};
        pg8::gemm_phase<EpiResid2>(lds, g, So, E);
    }
    SEAM(6);
    if (IN(8)) REP(8) {
        pg8::Gemm g{XN, WQ, D, D, S, D, D, 0}; pg8::StaticOrder So; So.init(S, D, G, bx, 4);
        LAS float* rrl = (LAS float*)(lds + 131072);
        pg8::Unit u0{0, 0}, u1{0, 0}; const bool h0 = So.next(0, u0), h1 = So.next(1, u1); if (!h1) u1 = u0;
        { const pg8::Unit uu = (tid < 256) ? u0 : u1; const int row = uu.pm * 256 + (tid & 255); float ss = 0.f;
#pragma unroll
          for (int q = 0; q < 8; ++q) { const f32x4 p = *(const f32x4*)(SSP + (size_t)row * 32 + 4 * q); ss += (p.x + p.y) + (p.z + p.w); }
          const float r = 1.0f / sqrtf(ss * (1.f / D) + EPS);
          rrl[tid] = r; if (h0 && uu.pn == 0 && (tid < 256 || h1)) RR[row] = r; }
        __syncthreads();
        EpiScores E{SC, CVEC, rrl, u0.pm};
        pg8::gemm_phase<EpiScores>(lds, g, So, E);
    }
    SEAM(8);
    if (IN(9)) {
        LAS int* lk = (LAS int*)(lds + wave * 16384);
        for (int job = gw; job < (S / 64) * 8; job += NGW) route8(SC, job, lane, EID, GATE, DSCT, DSC, USC, lk);
    }
    SEAM(9);
    if (IN(10)) {
        const int lane = (int)__builtin_amdgcn_mbcnt_hi(~0u, __builtin_amdgcn_mbcnt_lo(~0u, 0u));
        const int x = bx & 7, blk = bx >> 3, nblk = G >> 3, tpb = S / nblk, g = lane >> 3, j = lane & 7;
        const unsigned char* sub = DOWN + (size_t)x * SLICE_B; float* up = UPART + (size_t)x * S * 128;
        if ((G & 7) == 0) {
#define ROW1(EH, ST) qrow_load(sub + (unsigned)(__shfl(EH, 8 * ((ST) & 7) + g) * SLICE_ROW_B), j)
        int tt = wave; int t = blk * tpb + tt;
        const int tlast = blk * tpb + tpb - 1;
        v4u xr[4]; int e0 = 0, e1 = 0, e0n = 0, e1n = 0; QRow R[16];
        if (tt < tpb) {
            const int t1 = (t + NWAVES <= tlast) ? t + NWAVES : t;
#pragma unroll
            for (int q = 0; q < 4; ++q) xr[q] = *(const v4u*)(XN + (unsigned)(t * D + 256 * x + 32 * j + 8 * q));
            e0 = EID[(unsigned)(t * 128) + lane]; e1 = EID[(unsigned)(t * 128) + 64 + lane];
            e0n = EID[(unsigned)(t1 * 128) + lane]; e1n = EID[(unsigned)(t1 * 128) + 64 + lane];
#pragma unroll
            for (int st = 0; st < 16; ++st) R[st] = ROW1(st < 8 ? e0 : e1, st);
        }
        for (; tt < tpb; tt += NWAVES) {
            const int tn = (t + NWAVES <= tlast) ? t + NWAVES : t, tnn = (tn + NWAVES <= tlast) ? tn + NWAVES : tn;
            const int e0nn = EID[(unsigned)(tnn * 128) + lane], e1nn = EID[(unsigned)(tnn * 128) + 64 + lane];
            f32x2p xs[16];
#pragma unroll
            for (int q = 0; q < 4; ++q) { const v4u p = xr[q];
                xs[4 * q + 0] = (f32x2p){bflo(p.x), bfhi(p.x)}; xs[4 * q + 1] = (f32x2p){bflo(p.y), bfhi(p.y)}; xs[4 * q + 2] = (f32x2p){bflo(p.z), bfhi(p.z)}; xs[4 * q + 3] = (f32x2p){bflo(p.w), bfhi(p.w)}; }
#pragma unroll
            for (int q = 0; q < 4; ++q) xr[q] = *(const v4u*)(XN + (unsigned)(tn * D + 256 * x + 32 * j + 8 * q));
            float dd[8]; float dep = 0.f;
#pragma unroll
            for (int st = 0; st < 8; ++st) { dd[st] = qdot(R[st], xs, dep); dep = dd[st]; R[st] = ROW1(e0n, st); }
            const float kp0 = reduce8j(dd, lane);
#pragma unroll
            for (int st = 0; st < 8; ++st) { dd[st] = qdot(R[8 + st], xs, dep); dep = dd[st]; R[8 + st] = ROW1(e1n, st); }
            const float kp1 = reduce8j(dd, lane);
            up[(unsigned)(t * 128) + 8 * j + g] = kp0; up[(unsigned)(t * 128) + 64 + 8 * j + g] = kp1;
            e0n = e0nn; e1n = e1nn; t = tn;
        }
        }
    }
    SEAM(10);
    if (IN(11)) {
        const int lane = (int)__builtin_amdgcn_mbcnt_hi(~0u, __builtin_amdgcn_mbcnt_lo(~0u, 0u));
        for (int t = gw; t < S; t += NGW) {
            float u0 = 0.f, u1 = 0.f;
#pragma unroll
            for (int y = 0; y < 8; ++y) { u0 += UPART[(unsigned)((y * S + t) * 128 + lane)]; u1 += UPART[(unsigned)((y * S + t) * 128 + 64 + lane)]; }
            { const float rr = RR[t]; const int ea = EID[(unsigned)(t * 128) + lane], eb = EID[(unsigned)(t * 128) + 64 + lane];
              u0 = u0 * rr + CSUM[ea]; u1 = u1 * rr + CSUM[eb]; }
            u0 *= DSCT[(unsigned)(t * 128) + lane]; u1 *= DSCT[(unsigned)(t * 128) + 64 + lane];
            GATE[(unsigned)(t * 128) + lane] *= 0.5f * u0 * (1.0f + erff(u0 * 0.70710678118654752f));
            GATE[(unsigned)(t * 128) + 64 + lane] *= 0.5f * u1 * (1.0f + erff(u1 * 0.70710678118654752f));
        }
    }
    SEAM(11);
    if (IN(12)) {
        const int lane = (int)__builtin_amdgcn_mbcnt_hi(~0u, __builtin_amdgcn_mbcnt_lo(~0u, 0u));
        const int x = bx & 7, blk = bx >> 3, nblk = G >> 3, tpb = S / nblk, g = lane >> 3, j = lane & 7;
        const unsigned char* sub = UP + (size_t)x * SLICE_B;
        LAS float* red = (LAS float*)(lds + wave * 16384);
        if ((G & 7) == 0) {
        int tt = wave; int t = blk * tpb + tt;
        const int tlast = blk * tpb + tpb - 1;
        int e0 = 0, e1 = 0, e0n = 0, e1n = 0; float a0 = 0.f, a1 = 0.f; QRow R[16];
        const int c0 = 256 * x + 4 * lane;
        const f32x4 g2 = *(const f32x4*)(gate2 + (unsigned)c0);
        v2u hb = {0u, 0u};
#define P11_META(T, A0, A1) do { A0 = GATE[(unsigned)((T) * 128) + lane]; A1 = GATE[(unsigned)((T) * 128) + 64 + lane]; } while (0)
        if (tt < tpb) {
            const int t1 = (t + NWAVES <= tlast) ? t + NWAVES : t;
            P11_META(t, a0, a1);
            hb = *(const v2u*)(H + (unsigned)(t * D + c0));
            e0 = EID[(unsigned)(t * 128) + lane]; e1 = EID[(unsigned)(t * 128) + 64 + lane];
            e0n = EID[(unsigned)(t1 * 128) + lane]; e1n = EID[(unsigned)(t1 * 128) + 64 + lane];
#pragma unroll
            for (int st = 0; st < 16; ++st) R[st] = ROW1(st < 8 ? e0 : e1, st);
        }
        for (; tt < tpb; tt += NWAVES) {
            const int tn = (t + NWAVES <= tlast) ? t + NWAVES : t, tnn = (tn + NWAVES <= tlast) ? tn + NWAVES : tn;
            const int e0nn = EID[(unsigned)(tnn * 128) + lane], e1nn = EID[(unsigned)(tnn * 128) + 64 + lane];
            float a0n, a1n; P11_META(tn, a0n, a1n);
            f32x2p acc[16];
#pragma unroll
            for (int i = 0; i < 16; ++i) acc[i] = (f32x2p){0.f, 0.f};
#pragma unroll
            for (int st = 0; st < 8; ++st) { qaxpy(acc, R[st], __shfl(a0, 8 * st + g)); R[st] = ROW1(e0n, st); }
#pragma unroll
            for (int st = 0; st < 8; ++st) { qaxpy(acc, R[8 + st], __shfl(a1, 8 * st + g)); R[8 + st] = ROW1(e1n, st); }
            const f32x4 hh = {bflo(hb.x), bfhi(hb.x), bflo(hb.y), bfhi(hb.y)};
            LAS float* wp = red + (g * 8 + j) * 36;
#pragma unroll
            for (int q = 0; q < 8; ++q) *(LAS f32x4*)(wp + 4 * q) = (f32x4){acc[2 * q].x, acc[2 * q].y, acc[2 * q + 1].x, acc[2 * q + 1].y};
            LDS_WAIT(); asm volatile("" ::: "memory");
            f32x4 pe = {0.f, 0.f, 0.f, 0.f};
#pragma unroll
            for (int gg = 0; gg < 8; ++gg) pe = pe + *(LAS const f32x4*)(red + (gg * 8 + (lane >> 3)) * 36 + 4 * (lane & 7));
            LDS_WAIT(); asm volatile("" ::: "memory");
            const f32x4 v = hh + g2 * pe;
            { v2u vw; vw.x = pk2(v.x, v.y); vw.y = pk2(v.z, v.w); *(v2u*)(VB + (unsigned)(t * D + c0)) = vw; }
            hb = *(const v2u*)(H + (unsigned)(tn * D + c0));
            const float ss = wave_sum((v.x * v.x + v.y * v.y) + (v.z * v.z + v.w * v.w));
            if (lane == 0) SSQ[(unsigned)(t * 8 + x)] = ss;
            e0n = e0nn; e1n = e1nn; a0 = a0n; a1 = a1n; t = tn;
        }
#undef P11_META
#undef ROW1
        }
    }
    SEAM(12);
    if (IN(13)) {
        const int lane = (int)__builtin_amdgcn_mbcnt_hi(~0u, __builtin_amdgcn_mbcnt_lo(~0u, 0u));
        f32x4 fgv[8];
#pragma unroll
        for (int q = 0; q < 8; ++q) fgv[q] = *((const f32x4*)final_g + lane + 64 * q);
        v2u cur[8]; float sq[8];
        int t = gw;
        if (t < S) {
#pragma unroll
            for (int q = 0; q < 8; ++q) { cur[q] = *((const v2u*)(VB + (size_t)t * D) + lane + 64 * q); sq[q] = SSQ[(size_t)t * 8 + q]; } }
        for (; t < S; t += NGW) {
            const int tn = (t + NGW < S) ? t + NGW : t;
            v2u nxt[8]; float sqn[8];
#pragma unroll
            for (int q = 0; q < 8; ++q) { nxt[q] = *((const v2u*)(VB + (size_t)tn * D) + lane + 64 * q); sqn[q] = SSQ[(size_t)tn * 8 + q]; }
            float ss = 0.f;
#pragma unroll
            for (int y = 0; y < 8; ++y) ss += sq[y];
            const float rr = 1.0f / sqrtf(ss * (1.f / D) + EPS);
            f32x4* orow = (f32x4*)(out + (size_t)t * D) + lane;
#pragma unroll
            for (int q = 0; q < 8; ++q) { const f32x4 c = {bflo(cur[q].x), bfhi(cur[q].x), bflo(cur[q].y), bfhi(cur[q].y)}; orow[64 * q] = c * rr * fgv[q]; }
#pragma unroll
            for (int q = 0; q < 8; ++q) { cur[q] = nxt[q]; sq[q] = sqn[q]; }
        }
    }
#undef IN
#undef SEAM
}

extern "C" void kernel_launch(void* const* d_in, const int* in_sizes, int n_in, void* d_out, int out_size, void* d_ws, size_t ws_size, hipStream_t stream) {
    static int grid = 0;
    if (grid == 0) {
        if (n_in != 17 || out_size != S * D || ws_size < WS_END) { fprintf(stderr, "kernel_launch: unexpected shapes (n_in %d, out %d, ws %zu); nothing launched\n", n_in, out_size, ws_size); grid = -1; return; }
        int dev = 0, cus = 0, per_cu = 0;
        if (hipGetDevice(&dev) != hipSuccess || hipDeviceGetAttribute(&cus, hipDeviceAttributeMultiprocessorCount, dev) != hipSuccess) { grid = -1; return; }
        if (hipFuncSetAttribute((const void*)mk_fwd, hipFuncAttributeMaxDynamicSharedMemorySize, LDS_BYTES) != hipSuccess) { fprintf(stderr, "kernel_launch: hipFuncSetAttribute failed\n"); grid = -1; return; }
        if (hipOccupancyMaxActiveBlocksPerMultiprocessor(&per_cu, (const void*)mk_fwd, NWAVES * 64, LDS_BYTES) != hipSuccess || per_cu < 1) { fprintf(stderr, "kernel_launch: occupancy query says %d blocks per CU\n", per_cu); per_cu = 1; }
        (void)hipGetLastError();
        grid = 1; while (grid * 2 <= cus) grid *= 2;
    }
    if (grid < 0) return;
    (void)hipMemsetAsync((char*)d_ws + WS_CTL, 0, CTL_ZERO_BYTES, stream);
    Args a{};
    for (int i = 0; i < 17; ++i) a.in[i] = (const float*)d_in[i];
    a.out = (float*)d_out; a.hbuf = (float*)d_out; a.ws = (unsigned char*)d_ws;
    if (MK_N_LAUNCHES == 1 && !HOST_SPLIT) {
        a.ph_lo = 0; a.ph_hi = N_PHASES; a.li = 0;
        void* kargs[] = {&a};
        hipError_t e = hipLaunchCooperativeKernel((const void*)mk_fwd, dim3(grid), dim3(NWAVES * 64), kargs, LDS_BYTES, stream);
        if (e != hipSuccess) fprintf(stderr, "kernel_launch: cooperative launch failed: %s (grid %d)\n", hipGetErrorString(e), grid);
    } else {
        for (int li = 0; li < N_PHASES; ++li) { a.ph_lo = li; a.ph_hi = li + 1; a.li = li;
#ifdef DUP_PHASE
            if (li == DUP_PHASE) { Args b = a; if (li == 99) b.out = (float*)((char*)d_ws + 412 * MiB); hipLaunchKernelGGL(mk_fwd, dim3(grid), dim3(NWAVES * 64), LDS_BYTES, stream, b); }
#endif
            hipLaunchKernelGGL(mk_fwd, dim3(grid), dim3(NWAVES * 64), LDS_BYTES, stream, a); }
    }
}
```
